# Optimizing an MI355X kernel written in HIP

```python
import math
import jax
import jax.numpy as jnp
from jax import lax
import numpy as np

D_MODEL = 1024
BATCH = 4
SEQ = 4096
DEPTH = 4

HEAD_DIM = 64
ROPE_DIM = HEAD_DIM // 4
ROPE_THETA = 500000.0
NORM_EPS = 1e-6
NEG_INF = -1e30
FORCE_SCORE = 1e6

MOBA_HEADS = D_MODEL // (2 * HEAD_DIM)
MOBA_BLOCK = 256
MOBA_TOPK = 3
MOBA_QCHUNK = 32
DIFF_HEADS = D_MODEL // (4 * HEAD_DIM)
DIFF_VDIM = 2 * HEAD_DIM
DIFF_QCHUNK = 128
MOBA_W = MOBA_HEADS * HEAD_DIM
DIFF_QK_W = DIFF_HEADS * 2 * HEAD_DIM
DIFF_V_W = DIFF_HEADS * DIFF_VDIM
EVEN_IN = 3 * MOBA_W + 2 * DIFF_QK_W + DIFF_V_W
EVEN_MIX = MOBA_W + DIFF_V_W

NSA_HEADS = D_MODEL // HEAD_DIM
NSA_GROUP = 4
NSA_KV_HEADS = NSA_HEADS // NSA_GROUP
CMP_BLOCK = 32
CMP_STRIDE = 16
CMP_HIDDEN = 256
SLC_BLOCK = 64
SLC_TOPN = 16
WINDOW = 512
NSA_QCHUNK = 16
NSA_Q_W = NSA_HEADS * HEAD_DIM
NSA_KV_W = NSA_KV_HEADS * HEAD_DIM
ODD_IN = NSA_Q_W + 6 * NSA_KV_W + 3 * NSA_HEADS
ODD_MIX = NSA_Q_W

MOE_GROUPS = 4
MOE_PER_GROUP = 4
MOE_EXPERTS = MOE_GROUPS * MOE_PER_GROUP
MOE_TOPK = 2
MOE_FF = 256

N_EVEN = (DEPTH + 1) // 2
N_ODD = DEPTH // 2

kernel_name = 'hybrid_moba_diff_nsa_hmoe'


def rms_norm(x, g):
    xf = x.astype(jnp.float32)
    y = xf * lax.rsqrt(jnp.mean(xf * xf, axis=-1, keepdims=True) + NORM_EPS)
    return (y * g.astype(jnp.float32)).astype(x.dtype)


def rope_tables(seq):
    pos = jnp.arange(seq, dtype=jnp.float32)
    inv = ROPE_THETA ** (-jnp.arange(0, ROPE_DIM, 2, dtype=jnp.float32) / ROPE_DIM)
    ang = pos[:, None] * inv[None, :]
    return jnp.cos(ang), jnp.sin(ang)


def apply_rope(t, cos, sin):
    half = ROPE_DIM // 2
    c = cos.astype(t.dtype)
    s = sin.astype(t.dtype)
    t1 = t[..., :half]
    t2 = t[..., half:ROPE_DIM]
    return jnp.concatenate([t1 * c - t2 * s, t2 * c + t1 * s, t[..., ROPE_DIM:]], axis=-1)


def split_heads(t, n):
    b, s, _ = t.shape
    return t.reshape(b, s, n, -1).transpose(0, 2, 1, 3)


def merge_heads(t):
    b, h, s, d = t.shape
    return t.transpose(0, 2, 1, 3).reshape(b, s, h * d)


def gather_blocks(blocks, idx):
    return jax.vmap(jax.vmap(lambda bl, ix: bl[ix]))(blocks, idx)


def moba_attention(q, k, v):
    b, h, s, d = q.shape
    nb = -(-s // MOBA_BLOCK)
    pad = nb * MOBA_BLOCK - s
    kp = jnp.pad(k, ((0, 0), (0, 0), (0, pad), (0, 0)))
    vp = jnp.pad(v, ((0, 0), (0, 0), (0, pad), (0, 0)))
    kb = kp.reshape(b, h, nb, MOBA_BLOCK, d)
    vb = vp.reshape(b, h, nb, MOBA_BLOCK, d)
    kmean = jnp.mean(kb.astype(jnp.float32), axis=3)
    ksel = max(1, min(MOBA_TOPK, nb - 1))
    scale = d ** -0.5
    nq = s // MOBA_QCHUNK
    qc = jnp.moveaxis(q.reshape(b, h, nq, MOBA_QCHUNK, d), 2, 0)

    def chunk(args):
        qi, ci = args
        q0 = ci * MOBA_QCHUNK
        qpos = q0 + jnp.arange(MOBA_QCHUNK)
        own = q0 // MOBA_BLOCK
        gs = jnp.einsum('bhqd,bhnd->bhqn', qi.astype(jnp.float32), kmean)
        gs = jnp.where(jnp.arange(nb) < own, gs, NEG_INF)
        _, idx = lax.top_k(gs, ksel)
        valid = idx < own
        k_sel = gather_blocks(kb, idx)
        v_sel = gather_blocks(vb, idx)
        s_sel = jnp.einsum('bhqd,bhqnld->bhqnl', qi, k_sel).astype(jnp.float32) * scale
        s_sel = jnp.where(valid[..., None], s_sel, NEG_INF).reshape(b, h, MOBA_QCHUNK, ksel * MOBA_BLOCK)
        k_own = lax.dynamic_slice_in_dim(kp, own * MOBA_BLOCK, MOBA_BLOCK, axis=2)
        v_own = lax.dynamic_slice_in_dim(vp, own * MOBA_BLOCK, MOBA_BLOCK, axis=2)
        kpos = own * MOBA_BLOCK + jnp.arange(MOBA_BLOCK)
        s_own = jnp.einsum('bhqd,bhld->bhql', qi, k_own).astype(jnp.float32) * scale
        s_own = jnp.where(kpos[None, :] <= qpos[:, None], s_own, NEG_INF)
        p = jax.nn.softmax(jnp.concatenate([s_sel, s_own], axis=-1), axis=-1).astype(v.dtype)
        p_sel = p[..., :ksel * MOBA_BLOCK].reshape(b, h, MOBA_QCHUNK, ksel, MOBA_BLOCK)
        p_own = p[..., ksel * MOBA_BLOCK:]
        return (jnp.einsum('bhqnl,bhqnld->bhqd', p_sel, v_sel)
                + jnp.einsum('bhql,bhld->bhqd', p_own, v_own))

    o = lax.map(chunk, (qc, jnp.arange(nq)))
    return jnp.moveaxis(o, 0, 2).reshape(b, h, s, d)


def diff_attention(q, k, v, lam):
    b, h, _, s, d = q.shape
    nq = s // DIFF_QCHUNK
    scale = d ** -0.5
    kpos = jnp.arange(s)
    qc = jnp.moveaxis(q.reshape(b, h, 2, nq, DIFF_QCHUNK, d), 3, 0)

    def chunk(args):
        qi, ci = args
        qpos = ci * DIFF_QCHUNK + jnp.arange(DIFF_QCHUNK)
        sc = jnp.einsum('bhmqd,bhmkd->bhmqk', qi, k).astype(jnp.float32) * scale
        sc = jnp.where(kpos[None, :] <= qpos[:, None], sc, NEG_INF)
        p = jax.nn.softmax(sc, axis=-1)
        w = p[:, :, 0] - lam * p[:, :, 1]
        return jnp.einsum('bhqk,bhke->bhqe', w.astype(v.dtype), v)

    o = lax.map(chunk, (qc, jnp.arange(nq)))
    return jnp.moveaxis(o, 0, 2).reshape(b, h, s, -1)


def compress_blocks(t, pos_emb, w1, b1, w2, b2):
    b, g, s, d = t.shape
    nc = (s - CMP_BLOCK) // CMP_STRIDE + 1
    idx = jnp.arange(nc)[:, None] * CMP_STRIDE + jnp.arange(CMP_BLOCK)[None, :]
    blocks = t[:, :, idx, :] + pos_emb.astype(t.dtype)
    hid = jax.nn.gelu(jnp.einsum('bgnld,ldf->bgnf', blocks, w1.reshape(CMP_BLOCK, d, -1)) + b1)
    return jnp.einsum('bgnf,fe->bgne', hid, w2) + b2


def nsa_attention(q, kc, vc, ks, vs, kw, vw, gates):
    b, hq, s, d = q.shape
    g = NSA_KV_HEADS
    r = NSA_GROUP
    nc = kc.shape[2]
    ns = s // SLC_BLOCK
    nsel = min(SLC_TOPN, ns)
    scale = d ** -0.5
    cmp_start = jnp.arange(nc) * CMP_STRIDE
    cmp_end = cmp_start + CMP_BLOCK - 1
    slc_start = jnp.arange(ns) * SLC_BLOCK
    overlap = ((cmp_start[:, None] <= slc_start[None, :] + SLC_BLOCK - 1)
               & (cmp_end[:, None] >= slc_start[None, :])).astype(jnp.float32)
    ksb = ks.reshape(b, g, ns, SLC_BLOCK, d)
    vsb = vs.reshape(b, g, ns, SLC_BLOCK, d)
    kwp = jnp.pad(kw, ((0, 0), (0, 0), (WINDOW, 0), (0, 0)))
    vwp = jnp.pad(vw, ((0, 0), (0, 0), (WINDOW, 0), (0, 0)))
    nq = s // NSA_QCHUNK
    qc = jnp.moveaxis(q.reshape(b, hq, nq, NSA_QCHUNK, d), 2, 0)
    gc = jnp.moveaxis(gates.reshape(b, hq, nq, NSA_QCHUNK, 3), 2, 0)
    blk = jnp.arange(ns)

    def chunk(args):
        qi, gi, ci = args
        q0 = ci * NSA_QCHUNK
        qpos = q0 + jnp.arange(NSA_QCHUNK)
        qg = qi.reshape(b, g, r, NSA_QCHUNK, d)
        s_c = jnp.einsum('bgrqd,bgnd->bgrqn', qg, kc).astype(jnp.float32) * scale
        s_c = jnp.where(cmp_end[None, :] <= qpos[:, None], s_c, NEG_INF)
        p_c = jax.nn.softmax(s_c, axis=-1)
        p_c = jnp.where((qpos >= CMP_BLOCK - 1)[:, None], p_c, 0.0)
        o_c = jnp.einsum('bgrqn,bgnd->bgrqd', p_c.astype(vc.dtype), vc)
        imp = jnp.einsum('bgrqn,nj->bgqj', p_c, overlap)
        own = qpos // SLC_BLOCK
        started = slc_start[None, :] <= qpos[:, None]
        forced = (blk[None, :] == 0) | (blk[None, :] == own[:, None]) | (blk[None, :] == own[:, None] - 1)
        imp = jnp.where(started, jnp.where(forced, FORCE_SCORE, imp), NEG_INF)
        _, sidx = lax.top_k(imp, nsel)
        k_sel = gather_blocks(ksb, sidx)
        v_sel = gather_blocks(vsb, sidx)
        s_s = jnp.einsum('bgrqd,bgqnld->bgrqnl', qg, k_sel).astype(jnp.float32) * scale
        tok = sidx[..., None] * SLC_BLOCK + jnp.arange(SLC_BLOCK)
        s_s = jnp.where((tok <= qpos[:, None, None])[:, :, None], s_s, NEG_INF)
        p_s = jax.nn.softmax(s_s.reshape(b, g, r, NSA_QCHUNK, -1), axis=-1).reshape(s_s.shape)
        o_s = jnp.einsum('bgrqnl,bgqnld->bgrqd', p_s.astype(v_sel.dtype), v_sel)
        k_w = lax.dynamic_slice_in_dim(kwp, q0, WINDOW + NSA_QCHUNK, axis=2)
        v_w = lax.dynamic_slice_in_dim(vwp, q0, WINDOW + NSA_QCHUNK, axis=2)
        kpos = q0 - WINDOW + jnp.arange(WINDOW + NSA_QCHUNK)
        band = ((kpos[None, :] <= qpos[:, None]) & (kpos[None, :] > qpos[:, None] - WINDOW)
                & (kpos[None, :] >= 0))
        s_w = jnp.einsum('bgrqd,bgkd->bgrqk', qg, k_w).astype(jnp.float32) * scale
        p_w = jax.nn.softmax(jnp.where(band, s_w, NEG_INF), axis=-1)
        o_w = jnp.einsum('bgrqk,bgkd->bgrqd', p_w.astype(v_w.dtype), v_w)
        gt = gi.reshape(b, g, r, NSA_QCHUNK, 3).astype(o_c.dtype)
        o = gt[..., 0:1] * o_c + gt[..., 1:2] * o_s + gt[..., 2:3] * o_w
        return o.reshape(b, hq, NSA_QCHUNK, d)

    o = lax.map(chunk, (qc, gc, jnp.arange(nq)))
    return jnp.moveaxis(o, 0, 2).reshape(b, hq, s, d)


def even_mixer(h, w_in, w_out, lam_p, subln_g, lambda_init, cos, sin):
    b, s, _ = h.shape
    p = h @ w_in
    c1 = MOBA_W
    c2 = 2 * MOBA_W
    c3 = 3 * MOBA_W
    c4 = c3 + DIFF_QK_W
    c5 = c4 + DIFF_QK_W
    qa, ka, va, qb, kb, vb = jnp.split(p, [c1, c2, c3, c4, c5], axis=-1)
    qa = apply_rope(split_heads(qa, MOBA_HEADS), cos, sin)
    ka = apply_rope(split_heads(ka, MOBA_HEADS), cos, sin)
    oa = moba_attention(qa, ka, split_heads(va, MOBA_HEADS))
    qb = apply_rope(qb.reshape(b, s, DIFF_HEADS, 2, HEAD_DIM).transpose(0, 2, 3, 1, 4), cos, sin)
    kb = apply_rope(kb.reshape(b, s, DIFF_HEADS, 2, HEAD_DIM).transpose(0, 2, 3, 1, 4), cos, sin)
    lp = lam_p.astype(jnp.float32)
    lam = jnp.exp(jnp.sum(lp[0] * lp[1])) - jnp.exp(jnp.sum(lp[2] * lp[3])) + lambda_init
    ob = diff_attention(qb, kb, split_heads(vb, DIFF_HEADS), lam)
    ob = rms_norm(ob, subln_g) * (1.0 - lambda_init)
    o = jnp.concatenate([merge_heads(oa), merge_heads(ob)], axis=-1)
    return o @ w_out


def odd_mixer(h, w_in, w_out, cmp_pos, cmp_w1, cmp_b1, cmp_w2, cmp_b2, cos, sin):
    b, s, _ = h.shape
    p = h @ w_in
    cuts = [NSA_Q_W + i * NSA_KV_W for i in range(7)]
    q, kc, vc, ks, vs, kw, vw, gl = jnp.split(p, cuts, axis=-1)
    q = apply_rope(split_heads(q, NSA_HEADS), cos, sin)
    kc = apply_rope(split_heads(kc, NSA_KV_HEADS), cos, sin)
    ks = apply_rope(split_heads(ks, NSA_KV_HEADS), cos, sin)
    kw = apply_rope(split_heads(kw, NSA_KV_HEADS), cos, sin)
    vc = split_heads(vc, NSA_KV_HEADS)
    vs = split_heads(vs, NSA_KV_HEADS)
    vw = split_heads(vw, NSA_KV_HEADS)
    gates = jax.nn.sigmoid(gl.astype(jnp.float32)).reshape(b, s, NSA_HEADS, 3).transpose(0, 2, 1, 3)
    k_cmp = compress_blocks(kc, cmp_pos[0], cmp_w1[0], cmp_b1[0], cmp_w2[0], cmp_b2[0])
    v_cmp = compress_blocks(vc, cmp_pos[1], cmp_w1[1], cmp_b1[1], cmp_w2[1], cmp_b2[1])
    o = nsa_attention(q, k_cmp, v_cmp, ks, vs, kw, vw, gates)
    return merge_heads(o) @ w_out


def hier_moe(h, wg, bg, we, be, w_gate, w_up, w_down):
    b, s, d = h.shape
    t = h.reshape(-1, d)
    n = t.shape[0]
    gl = (t @ wg + bg).astype(jnp.float32)
    gp = jax.nn.softmax(gl, axis=-1)
    _, gsel = lax.top_k(gl, 1)
    g_oh = jax.nn.one_hot(gsel[:, 0], MOE_GROUPS, dtype=jnp.float32)
    gw = jnp.sum(gp * g_oh, axis=-1, keepdims=True)
    el = (t @ we + be).astype(jnp.float32).reshape(n, MOE_GROUPS, MOE_PER_GROUP)
    el_g = jnp.sum(el * g_oh[:, :, None], axis=1)
    tv, ti = lax.top_k(el_g, MOE_TOPK)
    tw = jax.nn.softmax(tv, axis=-1)
    w_grp = jnp.sum(jax.nn.one_hot(ti, MOE_PER_GROUP, dtype=jnp.float32) * tw[..., None], axis=1)
    comb = ((g_oh * gw)[:, :, None] * w_grp[:, None, :]).reshape(n, MOE_EXPERTS)
    a = jax.nn.silu(jnp.einsum('td,edf->tef', t, w_gate)) * jnp.einsum('td,edf->tef', t, w_up)
    y = jnp.einsum('tef,efd->td', a * comb[:, :, None].astype(a.dtype), w_down)
    return y.reshape(b, s, d)


def setup_inputs(seed: int = 0) -> dict:
    key = jax.random.key(seed)
    ks = jax.random.split(key, 28)
    D = D_MODEL

    def nrm(k, shape, std):
        return jax.random.normal(k, shape, jnp.float32) * std

    return {
        'x': nrm(ks[0], (BATCH, SEQ, D), 1.0),
        'c': nrm(ks[1], (BATCH, D), 1.0),
        'norm1_g': 1.0 + nrm(ks[2], (DEPTH, D), 0.02),
        'norm2_g': 1.0 + nrm(ks[3], (DEPTH, D), 0.02),
        'final_g': 1.0 + nrm(ks[4], (D,), 0.02),
        'ada_w': nrm(ks[5], (DEPTH, D, 6 * D), 0.5 * D ** -0.5),
        'ada_b': nrm(ks[6], (DEPTH, 6 * D), 0.02),
        'ev_w_in': nrm(ks[7], (N_EVEN, D, EVEN_IN), D ** -0.5),
        'ev_w_out': nrm(ks[8], (N_EVEN, EVEN_MIX, D), EVEN_MIX ** -0.5),
        'ev_lambda': nrm(ks[9], (N_EVEN, 4, HEAD_DIM), 0.1),
        'ev_subln_g': 1.0 + nrm(ks[10], (N_EVEN, DIFF_VDIM), 0.02),
        'od_w_in': nrm(ks[11], (N_ODD, D, ODD_IN), D ** -0.5),
        'od_w_out': nrm(ks[12], (N_ODD, ODD_MIX, D), ODD_MIX ** -0.5),
        'od_cmp_pos': nrm(ks[13], (N_ODD, 2, CMP_BLOCK, HEAD_DIM), 0.1),
        'od_cmp_w1': nrm(ks[14], (N_ODD, 2, CMP_BLOCK * HEAD_DIM, CMP_HIDDEN), (CMP_BLOCK * HEAD_DIM) ** -0.5),
        'od_cmp_b1': nrm(ks[15], (N_ODD, 2, CMP_HIDDEN), 0.01),
        'od_cmp_w2': nrm(ks[16], (N_ODD, 2, CMP_HIDDEN, HEAD_DIM), CMP_HIDDEN ** -0.5),
        'od_cmp_b2': nrm(ks[17], (N_ODD, 2, HEAD_DIM), 0.01),
        'moe_wg': nrm(ks[18], (DEPTH, D, MOE_GROUPS), D ** -0.5),
        'moe_bg': nrm(ks[19], (DEPTH, MOE_GROUPS), 0.01),
        'moe_we': nrm(ks[20], (DEPTH, D, MOE_EXPERTS), D ** -0.5),
        'moe_be': nrm(ks[21], (DEPTH, MOE_EXPERTS), 0.01),
        'moe_w_gate': nrm(ks[22], (DEPTH, MOE_EXPERTS, D, MOE_FF), D ** -0.5),
        'moe_w_up': nrm(ks[23], (DEPTH, MOE_EXPERTS, D, MOE_FF), D ** -0.5),
        'moe_w_down': nrm(ks[24], (DEPTH, MOE_EXPERTS, MOE_FF, D), MOE_FF ** -0.5),
    }


def reference(x, c, norm1_g, norm2_g, final_g, ada_w, ada_b, ev_w_in, ev_w_out, ev_lambda,
              ev_subln_g, od_w_in, od_w_out, od_cmp_pos, od_cmp_w1, od_cmp_b1, od_cmp_w2,
              od_cmp_b2, moe_wg, moe_bg, moe_we, moe_be, moe_w_gate, moe_w_up, moe_w_down):
    s = x.shape[1]
    cos, sin = rope_tables(s)
    cs = jax.nn.silu(c)
    for l in range(DEPTH):
        mod = (cs @ ada_w[l] + ada_b[l])[:, None, :]
        sh1, sc1, g1, sh2, sc2, g2 = jnp.split(mod, 6, axis=-1)
        h = rms_norm(x, norm1_g[l]) * (1.0 + sc1) + sh1
        if l % 2 == 0:
            i = l // 2
            lambda_init = 0.8 - 0.6 * math.exp(-0.3 * l)
            y = even_mixer(h, ev_w_in[i], ev_w_out[i], ev_lambda[i], ev_subln_g[i], lambda_init, cos, sin)
        else:
            i = l // 2
            y = odd_mixer(h, od_w_in[i], od_w_out[i], od_cmp_pos[i], od_cmp_w1[i], od_cmp_b1[i],
                          od_cmp_w2[i], od_cmp_b2[i], cos, sin)
        x = x + g1 * y
        h = rms_norm(x, norm2_g[l]) * (1.0 + sc2) + sh2
        x = x + g2 * hier_moe(h, moe_wg[l], moe_bg[l], moe_we[l], moe_be[l],
                              moe_w_gate[l], moe_w_up[l], moe_w_down[l])
    return rms_norm(x, final_g)
```

```cpp
#include <hip/hip_runtime.h>
#include <stdint.h>
#include <stdio.h>
#include <string.h>

typedef unsigned short bf16_t;
typedef unsigned long long u64;

constexpr int NB = 4, SEQ = 4096, DM = 1024, NT = NB * SEQ, DEPTH = 4;
constexpr int PW = 2048;
constexpr float C2 = 0.125f * 1.4426950408889634f;
constexpr float NEGBIG = -1e30f;
constexpr float LINIT0 = 0.2f, LINIT1 = 0.47071301834358416f;

constexpr size_t MiB = 1u << 20;
constexpr size_t WS_CTL = 0;
constexpr size_t WS_MOD = 1 * MiB;
constexpr size_t WS_ROPE = 2 * MiB;
constexpr size_t WS_MISC = 3 * MiB;
constexpr size_t WS_KMEAN = 3 * MiB + 65536;
constexpr size_t WS_MMASK = 4 * MiB;
constexpr size_t WS_SMASK = 5 * MiB;
constexpr size_t WS_KCMP = 6 * MiB;
constexpr size_t WS_VCMPT = 6 * MiB + 524288;
constexpr size_t WS_CH = 7 * MiB;
constexpr size_t WS_ROUTE = 11 * MiB;
constexpr size_t WS_X = 16 * MiB;
constexpr size_t WS_H = 80 * MiB;
constexpr size_t WS_R = 112 * MiB;
constexpr size_t WS_P = WS_R;
constexpr size_t WS_VT = WS_R + 64 * MiB;
constexpr size_t WS_O = WS_R + 96 * MiB;
constexpr size_t WS_DT = WS_R + 128 * MiB;
constexpr size_t WS_PF = WS_R + 64 * MiB;
constexpr size_t WS_END = 304 * MiB;

constexpr int CW_CNT = 64;

__device__ __forceinline__ bf16_t f2bf(float f) { unsigned u = __float_as_uint(f); u = (u + 0x7fffu + ((u >> 16) & 1u)) >> 16; return (bf16_t)u; }
__device__ __forceinline__ float bf2f(bf16_t h) { return __uint_as_float(((unsigned)h) << 16); }
__device__ __forceinline__ float wave_sum(float v) {
#pragma unroll
    for (int o = 32; o >= 1; o >>= 1) v += __shfl_xor(v, o);
    return v;
}

__global__ void k_mod(const float* __restrict__ c, const float* __restrict__ ada_w, const float* __restrict__ ada_b, float* __restrict__ mod) {
    __shared__ float cs[4][1024];
    for (int i = threadIdx.x; i < 4096; i += 256) { float v = c[i]; cs[i >> 10][i & 1023] = v / (1.f + expf(-v)); }
    __syncthreads();
    const int j = blockIdx.x * 256 + threadIdx.x, l = blockIdx.y;
    const float* w = ada_w + (size_t)l * 1024 * 6144 + j;
    float a0 = 0.f, a1 = 0.f, a2 = 0.f, a3 = 0.f;
#pragma unroll 8
    for (int i = 0; i < 1024; ++i) { const float wv = w[(size_t)i * 6144]; a0 += cs[0][i] * wv; a1 += cs[1][i] * wv; a2 += cs[2][i] * wv; a3 += cs[3][i] * wv; }
    const float bb = ada_b[l * 6144 + j];
    mod[(l * 4 + 0) * 6144 + j] = a0 + bb; mod[(l * 4 + 1) * 6144 + j] = a1 + bb; mod[(l * 4 + 2) * 6144 + j] = a2 + bb; mod[(l * 4 + 3) * 6144 + j] = a3 + bb;
}

__global__ void k_rope(float* __restrict__ tab) {
    const int i = blockIdx.x * 256 + threadIdx.x;
    if (i < SEQ * 8) {
        const int pos = i >> 3, j = i & 7;
        const float inv = (float)pow(500000.0, -(double)j / 8.0);
        const float ang = (float)pos * inv;
        tab[i] = (float)cos((double)ang); tab[SEQ * 8 + i] = (float)sin((double)ang);
    }
}

__global__ void k_misc(const float* __restrict__ ev_lambda, float* __restrict__ misc) {
    const int lane = threadIdx.x;
    for (int i = 0; i < 2; ++i) {
        const float* lp = ev_lambda + i * 256;
        const float s1 = wave_sum(lp[lane] * lp[64 + lane]), s2 = wave_sum(lp[128 + lane] * lp[192 + lane]);
        if (lane == 0) misc[i] = expf(s1) - expf(s2) + (i == 0 ? LINIT0 : LINIT1);
    }
}

template <int MODE>
__global__ void __launch_bounds__(256) k_norm(const float* __restrict__ xin, const float* __restrict__ g, const float* __restrict__ modl, int sc_chunk, int sh_chunk,
                                              bf16_t* __restrict__ H, float* __restrict__ outf,
                                              const float* __restrict__ wg, const float* __restrict__ bg, const float* __restrict__ we, const float* __restrict__ be,
                                              int* __restrict__ tok_e, float* __restrict__ tok_w, int* __restrict__ tok_rank, unsigned* __restrict__ cnt) {
    const int lane = threadIdx.x & 63, t = blockIdx.x * 4 + (threadIdx.x >> 6), b = t / SEQ;
    const float* xr = xin + (size_t)t * DM;
    float4 xv[4]; float ss = 0.f;
#pragma unroll
    for (int i = 0; i < 4; ++i) { xv[i] = *(const float4*)(xr + i * 256 + lane * 4); ss += xv[i].x * xv[i].x + xv[i].y * xv[i].y + xv[i].z * xv[i].z + xv[i].w * xv[i].w; }
    ss = wave_sum(ss);
    const float rs = rsqrtf(ss * (1.f / DM) + 1e-6f);
    float hv[4][4];
#pragma unroll
    for (int i = 0; i < 4; ++i) {
        const int idx = i * 256 + lane * 4;
        const float4 gv = *(const float4*)(g + idx);
        float y0 = xv[i].x * rs * gv.x, y1 = xv[i].y * rs * gv.y, y2 = xv[i].z * rs * gv.z, y3 = xv[i].w * rs * gv.w;
        if (MODE == 2) { *(float4*)(outf + (size_t)t * DM + idx) = make_float4(y0, y1, y2, y3); }
        else {
            const float4 sc = *(const float4*)(modl + b * 6144 + sc_chunk * 1024 + idx), sh = *(const float4*)(modl + b * 6144 + sh_chunk * 1024 + idx);
            y0 = y0 * (1.f + sc.x) + sh.x; y1 = y1 * (1.f + sc.y) + sh.y; y2 = y2 * (1.f + sc.z) + sh.z; y3 = y3 * (1.f + sc.w) + sh.w;
            hv[i][0] = y0; hv[i][1] = y1; hv[i][2] = y2; hv[i][3] = y3;
            ushort4 o; o.x = f2bf(y0); o.y = f2bf(y1); o.z = f2bf(y2); o.w = f2bf(y3);
            *(ushort4*)(H + (size_t)t * DM + idx) = o;
        }
    }
    if (MODE == 1) {
        float acc[20];
#pragma unroll
        for (int q = 0; q < 20; ++q) acc[q] = 0.f;
#pragma unroll
        for (int i = 0; i < 4; ++i)
#pragma unroll
            for (int e = 0; e < 4; ++e) {
                const int idx = i * 256 + lane * 4 + e; const float h = hv[i][e];
                const float4 a = *(const float4*)(wg + idx * 4);
                acc[0] += h * a.x; acc[1] += h * a.y; acc[2] += h * a.z; acc[3] += h * a.w;
#pragma unroll
                for (int q = 0; q < 4; ++q) { const float4 w4 = *(const float4*)(we + idx * 16 + q * 4); acc[4 + q * 4] += h * w4.x; acc[5 + q * 4] += h * w4.y; acc[6 + q * 4] += h * w4.z; acc[7 + q * 4] += h * w4.w; }
            }
#pragma unroll
        for (int q = 0; q < 20; ++q) acc[q] = wave_sum(acc[q]);
        if (lane == 0) {
            float gl[4];
#pragma unroll
            for (int j = 0; j < 4; ++j) gl[j] = acc[j] + bg[j];
            int gs = 0; float gm = gl[0];
#pragma unroll
            for (int j = 1; j < 4; ++j) if (gl[j] > gm) { gm = gl[j]; gs = j; }
            float den = 0.f;
#pragma unroll
            for (int j = 0; j < 4; ++j) den += expf(gl[j] - gm);
            const float gw = 1.f / den;
            float el[4] = {0.f, 0.f, 0.f, 0.f};
#pragma unroll
            for (int gg = 0; gg < 4; ++gg)
#pragma unroll
                for (int j = 0; j < 4; ++j) if (gs == gg) el[j] = acc[4 + gg * 4 + j] + be[gg * 4 + j];
            int i1 = 0; float v1 = el[0];
#pragma unroll
            for (int j = 1; j < 4; ++j) if (el[j] > v1) { v1 = el[j]; i1 = j; }
            int i2 = -1; float v2 = -3.0e38f;
#pragma unroll
            for (int j = 0; j < 4; ++j) if (j != i1 && el[j] > v2) { v2 = el[j]; i2 = j; }
            const float t1 = 1.f / (1.f + expf(v2 - v1)), t2 = 1.f - t1;
            const int e1 = gs * 4 + i1, e2 = gs * 4 + i2;
            tok_e[t * 2] = e1; tok_e[t * 2 + 1] = e2; tok_w[t * 2] = gw * t1; tok_w[t * 2 + 1] = gw * t2;
            tok_rank[t * 2] = (int)atomicAdd(cnt + e1, 1u); tok_rank[t * 2 + 1] = (int)atomicAdd(cnt + e2, 1u);
        }
    }
}

struct ColMap { int nsec; int out0[8]; int src0[8]; int len[8]; };
__device__ __forceinline__ int cm_src(const ColMap& cm, int n) {
    int r = -1;
#pragma unroll
    for (int s = 0; s < 8; ++s) if (s < cm.nsec && n >= cm.out0[s] && n < cm.out0[s] + cm.len[s]) r = cm.src0[s] + (n - cm.out0[s]);
    return r;
}
template <int EPI>
__global__ void __launch_bounds__(256) k_gemm_naive(const bf16_t* __restrict__ A, int lda, const float* __restrict__ W, int ldw, ColMap cm, int K,
                                                    float* __restrict__ C, int ldc, const float* __restrict__ xin, const float* __restrict__ modg) {
    __shared__ float As[16][68], Bs[16][68];
    const int tid = threadIdx.x, tx = tid & 15, ty = tid >> 4;
    const int m0 = blockIdx.y * 64, n0 = blockIdx.x * 64;
    const int ar = tid >> 2, ak = (tid & 3) * 4;
    const int bk = tid >> 4, bn = (tid & 15) * 4;
    int sc[4];
#pragma unroll
    for (int j = 0; j < 4; ++j) sc[j] = cm_src(cm, n0 + bn + j);
    float acc[4][4];
#pragma unroll
    for (int i = 0; i < 4; ++i)
#pragma unroll
        for (int j = 0; j < 4; ++j) acc[i][j] = 0.f;
    for (int k0 = 0; k0 < K; k0 += 16) {
        const ushort4 av = *(const ushort4*)(A + (size_t)(m0 + ar) * lda + k0 + ak);
        As[ak + 0][ar] = bf2f(av.x); As[ak + 1][ar] = bf2f(av.y); As[ak + 2][ar] = bf2f(av.z); As[ak + 3][ar] = bf2f(av.w);
#pragma unroll
        for (int j = 0; j < 4; ++j) Bs[bk][bn + j] = sc[j] >= 0 ? W[(size_t)(k0 + bk) * ldw + sc[j]] : 0.f;
        __syncthreads();
#pragma unroll
        for (int k = 0; k < 16; ++k) {
            float a[4], bb[4];
#pragma unroll
            for (int i = 0; i < 4; ++i) a[i] = As[k][ty * 4 + i];
#pragma unroll
            for (int j = 0; j < 4; ++j) bb[j] = Bs[k][tx * 4 + j];
#pragma unroll
            for (int i = 0; i < 4; ++i)
#pragma unroll
                for (int j = 0; j < 4; ++j) acc[i][j] += a[i] * bb[j];
        }
        __syncthreads();
    }
#pragma unroll
    for (int i = 0; i < 4; ++i) {
        const int m = m0 + ty * 4 + i;
#pragma unroll
        for (int j = 0; j < 4; ++j) {
            const int n = n0 + tx * 4 + j;
            if (EPI == 0) C[(size_t)m * ldc + n] = acc[i][j];
            else C[(size_t)m * ldc + n] = xin[(size_t)m * ldc + n] + modg[(m / SEQ) * 6144 + n] * acc[i][j];
        }
    }
}

__global__ void k_ropeconv(const float* __restrict__ PF, bf16_t* __restrict__ P, const float* __restrict__ rope, int rope_cols, int qa0, int qa1, int qb0, int qb1) {
    const size_t i = (size_t)blockIdx.x * 256 + threadIdx.x;
    const int t = (int)(i / PW), n = (int)(i % PW), d = n & 63, pos = t % SEQ;
    float v = PF[i];
    if (n < rope_cols && d < 16) {
        const int j = d & 7; const float c = rope[pos * 8 + j], s = rope[SEQ * 8 + pos * 8 + j];
        const float p = PF[d < 8 ? i + 8 : i - 8];
        v = d < 8 ? v * c - p * s : v * c + p * s;
    }
    if ((n >= qa0 && n < qa1) || (n >= qb0 && n < qb1)) v *= C2;
    P[i] = f2bf(v);
}
__global__ void k_vtconv(const float* __restrict__ PF, int ld, int nf, bf16_t* __restrict__ VT) {
    const size_t i = (size_t)blockIdx.x * 256 + threadIdx.x;
    const int f = (int)(i / NT), t = (int)(i % NT);
    if (f < nf) VT[i] = f2bf(PF[(size_t)t * ld + f]);
}

__global__ void k_moba_kmean(const bf16_t* __restrict__ P, float* __restrict__ kmean) {
    const int d = threadIdx.x, blk = blockIdx.x & 15, h = (blockIdx.x >> 4) & 7, b = blockIdx.x >> 7;
    const bf16_t* kp = P + (size_t)(b * SEQ + blk * 256) * PW + 512 + h * 64 + d;
    float s = 0.f;
    for (int i = 0; i < 256; ++i) s += bf2f(kp[(size_t)i * PW]);
    kmean[((b * 8 + h) * 16 + blk) * 64 + d] = s * (1.f / 256.f);
}
__global__ void k_moba_gate(const bf16_t* __restrict__ P, const float* __restrict__ kmean, u64* __restrict__ mmask) {
    const int i = blockIdx.x * 256 + threadIdx.x;
    const int t = i % SEQ, h = (i / SEQ) & 7, b = i / (SEQ * 8);
    const int own = t >> 8;
    const bf16_t* qp = P + (size_t)(b * SEQ + t) * PW + h * 64;
    float q[64];
#pragma unroll
    for (int d = 0; d < 64; ++d) q[d] = bf2f(qp[d]);
    const float* km = kmean + (size_t)(b * 8 + h) * 16 * 64;
    float g0 = NEGBIG, g1 = NEGBIG, g2 = NEGBIG; int i0 = -1, i1 = -1, i2 = -1;
    for (int blk = 0; blk < own; ++blk) {
        float s = 0.f;
#pragma unroll
        for (int d = 0; d < 64; ++d) s += q[d] * km[blk * 64 + d];
        if (s > g0) { g2 = g1; i2 = i1; g1 = g0; i1 = i0; g0 = s; i0 = blk; }
        else if (s > g1) { g2 = g1; i2 = i1; g1 = s; i1 = blk; }
        else if (s > g2) { g2 = s; i2 = blk; }
    }
    u64 m = 0xFull << (4 * own);
    if (i0 >= 0) m |= 0xFull << (4 * i0);
    if (i1 >= 0) m |= 0xFull << (4 * i1);
    if (i2 >= 0) m |= 0xFull << (4 * i2);
    mmask[i] = m;
}

struct AttnN {
    const bf16_t* Kb; int kpitch; int kcol0; int kdiv; size_t kbatch; size_t khead;
    const bf16_t* Vb; int vpitch; int vrow0; int vdiv; size_t vbatch; int dv; size_t vhead;
    const bf16_t* Q; int qcol0;
    const u64* mask; int mdiv; int nmh;
    int window; int cmp;
    int nheads; int nchunk;
    int outmode; bf16_t* Ob; float* Of; int opitch; int ocol0;
    const bf16_t* gate; int grow0; int gidx;
};
__global__ void __launch_bounds__(256) k_attn_naive(AttnN a) {
    const int i = blockIdx.x * 256 + threadIdx.x;
    const int t = i % SEQ; int r = i / SEQ; const int ch = r % a.nchunk; r /= a.nchunk; const int h = r % a.nheads, b = r / a.nheads;
    const bf16_t* qp = a.Q + (size_t)(b * SEQ + t) * PW + a.qcol0 + h * 64;
    float q[64];
#pragma unroll
    for (int d = 0; d < 64; ++d) q[d] = bf2f(qp[d]);
    const bf16_t* kb = a.Kb + (size_t)b * a.kbatch + (size_t)(h / a.kdiv) * a.khead + a.kcol0;
    const bf16_t* vb = a.Vb + (size_t)b * a.vbatch + (size_t)(h / a.vdiv) * a.vhead + (size_t)(a.vrow0 + ch * 32) * a.vpitch;
    const u64 mk = a.mask ? a.mask[(size_t)(b * a.nmh + h / a.mdiv) * SEQ + t] : ~0ull;
    int lo, hi;
    if (a.cmp) { lo = 0; hi = t >= 31 ? (t - 31) / 16 : -1; }
    else { lo = t - a.window + 1; if (lo < 0) lo = 0; hi = t; }
    float m = NEGBIG, l = 0.f, o[32];
#pragma unroll
    for (int e = 0; e < 32; ++e) o[e] = 0.f;
    for (int key = lo; key <= hi; ++key) {
        if (!a.cmp && !((mk >> (key >> 6)) & 1ull)) { key |= 63; continue; }
        const bf16_t* kp = kb + (size_t)key * a.kpitch;
        float s = 0.f;
#pragma unroll
        for (int d = 0; d < 64; ++d) s += q[d] * bf2f(kp[d]);
        if (s > m) { const float c = exp2f(m - s); l *= c;
#pragma unroll
            for (int e = 0; e < 32; ++e) o[e] *= c;
            m = s; }
        const float p = exp2f(s - m);
        l += p;
#pragma unroll
        for (int e = 0; e < 32; ++e) o[e] += p * bf2f(vb[(size_t)e * a.vpitch + key]);
    }
    const float il = l > 0.f ? 1.f / l : 0.f;
    float gt = 1.f;
    if (a.outmode >= 2) { const float gl = bf2f(a.gate[(size_t)(a.grow0 + h * 3 + a.gidx) * NT + b * SEQ + t]); gt = 1.f / (1.f + expf(-gl)); }
    const size_t ob = (size_t)(b * SEQ + t) * a.opitch + a.ocol0 + h * a.dv + ch * 32;
#pragma unroll
    for (int e = 0; e < 32; ++e) {
        const float v = o[e] * il;
        if (a.outmode == 0) a.Ob[ob + e] = f2bf(v);
        else if (a.outmode == 1) a.Of[ob + e] = v;
        else if (a.outmode == 2) a.Of[ob + e] += gt * v;
        else a.Of[ob + e] = gt * v;
    }
}

__global__ void __launch_bounds__(256) k_diff_combine(const float* __restrict__ DT, const float* __restrict__ misc, int li, const float* __restrict__ subg, bf16_t* __restrict__ O) {
    const int lane = threadIdx.x & 63, w = blockIdx.x * 4 + (threadIdx.x >> 6), t = w >> 2, hd = w & 3;
    const float lam = misc[li], linit = li == 0 ? LINIT0 : LINIT1;
    const float* p0 = DT + (size_t)t * 1024 + (hd * 2) * 128, * p1 = p0 + 128;
    const float v0 = p0[lane] - lam * p1[lane], v1 = p0[64 + lane] - lam * p1[64 + lane];
    const float ss = wave_sum(v0 * v0 + v1 * v1);
    const float rs = rsqrtf(ss * (1.f / 128.f) + 1e-6f) * (1.f - linit);
    O[(size_t)t * 1024 + 512 + hd * 128 + lane] = f2bf(v0 * rs * subg[lane]);
    O[(size_t)t * 1024 + 512 + hd * 128 + 64 + lane] = f2bf(v1 * rs * subg[64 + lane]);
}
__global__ void k_f32_to_bf16(const float* __restrict__ src, bf16_t* __restrict__ dst) {
    const size_t i = (size_t)blockIdx.x * 256 + threadIdx.x; dst[i] = f2bf(src[i]);
}

__device__ __forceinline__ float gelu_tanh(float x) { return 0.5f * x * (1.f + tanhf(0.7978845608028654f * (x + 0.044715f * x * x * x))); }
__global__ void __launch_bounds__(256) k_cmp1(const bf16_t* __restrict__ P, const float* __restrict__ pos, const float* __restrict__ w1, const float* __restrict__ b1, bf16_t* __restrict__ CH) {
    const int f = threadIdx.x, r = blockIdx.x & 1023, g = (blockIdx.x >> 10) & 3, br = blockIdx.x >> 12;
    const int n = r & 255;
    __shared__ float xs[2048];
    const int col = (br == 0 ? 1024 : 1792) + g * 64;
    const float* pe = pos + br * 2048;
    for (int i = threadIdx.x; i < 2048; i += 256) { const int l = i >> 6, d = i & 63; const int tok = 16 * r + l;
        xs[i] = (n < 255) ? bf2f(P[(size_t)tok * PW + col + d]) + pe[i] : 0.f; }
    __syncthreads();
    const float* w = w1 + (size_t)br * 2048 * 256 + f;
    float s = 0.f;
    for (int i = 0; i < 2048; ++i) s += xs[i] * w[(size_t)i * 256];
    s += b1[br * 256 + f];
    CH[((size_t)(br * 4 + g) * 1024 + r) * 256 + f] = f2bf(n < 255 ? gelu_tanh(s) : 0.f);
}
__global__ void __launch_bounds__(64) k_cmp2(const bf16_t* __restrict__ CH, const float* __restrict__ w2, const float* __restrict__ b2, bf16_t* __restrict__ KCMP, bf16_t* __restrict__ VCMPT) {
    const int e = threadIdx.x, r = blockIdx.x & 1023, g = (blockIdx.x >> 10) & 3, br = blockIdx.x >> 12;
    const int b = r >> 8, n = r & 255;
    const bf16_t* hp = CH + ((size_t)(br * 4 + g) * 1024 + r) * 256;
    const float* w = w2 + (size_t)br * 256 * 64 + e;
    float s = b2[br * 64 + e];
    for (int f = 0; f < 256; ++f) s += bf2f(hp[f]) * w[f * 64];
    if (n == 255) s = 0.f;
    if (br == 0) KCMP[((size_t)(b * 4 + g) * 256 + n) * 64 + e] = f2bf(s);
    else VCMPT[((size_t)(b * 4 + g) * 64 + e) * 256 + n] = f2bf(s);
}
__global__ void __launch_bounds__(64) k_nsa_select(const bf16_t* __restrict__ P, const bf16_t* __restrict__ KCMP, u64* __restrict__ smask) {
    __shared__ float imp[64][65];
    const int lane = threadIdx.x, i = blockIdx.x * 64 + lane;
    const int t = i % SEQ, g = (i / SEQ) & 3, b = i / (SEQ * 4);
    for (int j = 0; j < 64; ++j) imp[j][lane] = 0.f;
    const int nmax = t >= 31 ? (t - 31) / 16 : -1;
    const bf16_t* kb = KCMP + (size_t)(b * 4 + g) * 256 * 64;
    for (int r = 0; r < 4; ++r) {
        const bf16_t* qp = P + (size_t)(b * SEQ + t) * PW + (g * 4 + r) * 64;
        float q[64];
#pragma unroll
        for (int d = 0; d < 64; ++d) q[d] = bf2f(qp[d]);
        float m = NEGBIG, l = 0.f;
        for (int n = 0; n <= nmax; ++n) {
            float s = 0.f;
#pragma unroll
            for (int d = 0; d < 64; ++d) s += q[d] * bf2f(kb[n * 64 + d]);
            if (s > m) { l *= exp2f(m - s); m = s; }
            l += exp2f(s - m);
        }
        const float il = l > 0.f ? 1.f / l : 0.f;
        for (int n = 0; n <= nmax; ++n) {
            float s = 0.f;
#pragma unroll
            for (int d = 0; d < 64; ++d) s += q[d] * bf2f(kb[n * 64 + d]);
            const float p = exp2f(s - m) * il;
            imp[n >> 2][lane] += p;
            if ((n & 3) == 3 && (n >> 2) + 1 < 64) imp[(n >> 2) + 1][lane] += p;
        }
    }
    const int own = t >> 6;
    u64 sel = 0ull;
    for (int j = 0; j < 64; ++j) {
        float v = imp[j][lane];
        if (j > own) v = NEGBIG; else if (j == 0 || j == own || j == own - 1) v = 1e6f;
        imp[j][lane] = v;
    }
    for (int k = 0; k < 16; ++k) {
        int bi = -1; float bv = -3.0e38f;
        for (int j = 0; j < 64; ++j) { const float v = imp[j][lane]; if (v > bv) { bv = v; bi = j; } }
        sel |= 1ull << bi; imp[bi][lane] = -3.4e38f;
    }
    smask[i] = sel;
}

__global__ void __launch_bounds__(256) k_moe_hidden(const bf16_t* __restrict__ H, const int* __restrict__ tok_e, const float* __restrict__ tok_w,
                                                    const float* __restrict__ wgate, const float* __restrict__ wup, float* __restrict__ HID) {
    const int f = threadIdx.x, ts = blockIdx.x, t = ts >> 1;
    __shared__ float hs[1024];
    for (int i = f; i < 1024; i += 256) hs[i] = bf2f(H[(size_t)t * DM + i]);
    __syncthreads();
    const int e = tok_e[ts];
    const float* wg = wgate + (size_t)e * 1024 * 256 + f, * wu = wup + (size_t)e * 1024 * 256 + f;
    float sg = 0.f, su = 0.f;
#pragma unroll 4
    for (int k = 0; k < 1024; ++k) { const float h = hs[k]; sg += h * wg[(size_t)k * 256]; su += h * wu[(size_t)k * 256]; }
    HID[(size_t)ts * 256 + f] = sg / (1.f + expf(-sg)) * su * tok_w[ts];
}
__global__ void __launch_bounds__(256) k_moe_down(const float* __restrict__ HID, const int* __restrict__ tok_e, const float* __restrict__ wdown,
                                                  const float* __restrict__ modg, float* __restrict__ X) {
    const int t = blockIdx.x, b = t / SEQ;
    __shared__ float hs[512];
    for (int i = threadIdx.x; i < 512; i += 256) hs[i] = HID[(size_t)t * 512 + i];
    __syncthreads();
    float y[4] = {0.f, 0.f, 0.f, 0.f};
    for (int sl = 0; sl < 2; ++sl) {
        const int e = tok_e[t * 2 + sl];
        const float* w = wdown + (size_t)e * 256 * 1024 + threadIdx.x;
        for (int f = 0; f < 256; ++f) { const float h = hs[sl * 256 + f];
#pragma unroll
            for (int j = 0; j < 4; ++j) y[j] += h * w[(size_t)f * 1024 + j * 256]; }
    }
#pragma unroll
    for (int j = 0; j < 4; ++j) { const int d = threadIdx.x + j * 256; X[(size_t)t * DM + d] += modg[b * 6144 + d] * y[j]; }
}

static ColMap mk_map(int nsec, const int (*s)[3]) { ColMap c; memset(&c, 0, sizeof(c)); c.nsec = nsec; for (int i = 0; i < 8; ++i) { c.out0[i] = c.src0[i] = c.len[i] = 0; } for (int i = 0; i < nsec; ++i) { c.out0[i] = s[i][0]; c.src0[i] = s[i][1]; c.len[i] = s[i][2]; } return c; }

extern "C" void kernel_launch(void* const* d_in, const int* in_sizes, int n_in, void* d_out, int out_size, void* d_ws, size_t ws_size, hipStream_t stream) {
    if (ws_size < WS_END) { fprintf(stderr, "workspace too small: %zu < %zu\n", ws_size, (size_t)WS_END); return; }
    const float* x = (const float*)d_in[0]; const float* c = (const float*)d_in[1];
    const float* norm1_g = (const float*)d_in[2]; const float* norm2_g = (const float*)d_in[3]; const float* final_g = (const float*)d_in[4];
    const float* ada_w = (const float*)d_in[5]; const float* ada_b = (const float*)d_in[6];
    const float* ev_w_in = (const float*)d_in[7]; const float* ev_w_out = (const float*)d_in[8]; const float* ev_lambda = (const float*)d_in[9]; const float* ev_subln = (const float*)d_in[10];
    const float* od_w_in = (const float*)d_in[11]; const float* od_w_out = (const float*)d_in[12]; const float* od_pos = (const float*)d_in[13];
    const float* od_w1 = (const float*)d_in[14]; const float* od_b1 = (const float*)d_in[15]; const float* od_w2 = (const float*)d_in[16]; const float* od_b2 = (const float*)d_in[17];
    const float* moe_wg = (const float*)d_in[18]; const float* moe_bg = (const float*)d_in[19]; const float* moe_we = (const float*)d_in[20]; const float* moe_be = (const float*)d_in[21];
    const float* moe_wgate = (const float*)d_in[22]; const float* moe_wup = (const float*)d_in[23]; const float* moe_wdown = (const float*)d_in[24];
    unsigned char* ws = (unsigned char*)d_ws;
    unsigned* ctl = (unsigned*)(ws + WS_CTL); float* mod = (float*)(ws + WS_MOD); float* rope = (float*)(ws + WS_ROPE); float* misc = (float*)(ws + WS_MISC);
    float* kmean = (float*)(ws + WS_KMEAN); u64* mmask = (u64*)(ws + WS_MMASK); u64* smask = (u64*)(ws + WS_SMASK);
    bf16_t* KCMP = (bf16_t*)(ws + WS_KCMP); bf16_t* VCMPT = (bf16_t*)(ws + WS_VCMPT); bf16_t* CH = (bf16_t*)(ws + WS_CH);
    int* tok_e = (int*)(ws + WS_ROUTE); float* tok_w = (float*)(ws + WS_ROUTE + 131072); int* tok_rank = (int*)(ws + WS_ROUTE + 262144);
    float* X = (float*)(ws + WS_X); bf16_t* H = (bf16_t*)(ws + WS_H); bf16_t* P = (bf16_t*)(ws + WS_P); bf16_t* VT = (bf16_t*)(ws + WS_VT);
    bf16_t* O = (bf16_t*)(ws + WS_O); float* DT = (float*)(ws + WS_DT); float* PF = (float*)(ws + WS_PF);
    float* HID = (float*)(ws + WS_P);

    hipMemsetAsync(ctl, 0, 1 * MiB, stream);
    k_mod<<<dim3(24, 4), 256, 0, stream>>>(c, ada_w, ada_b, mod);
    k_rope<<<128, 256, 0, stream>>>(rope);
    k_misc<<<1, 64, 0, stream>>>(ev_lambda, misc);

    for (int l = 0; l < DEPTH; ++l) {
        const float* modl = mod + (size_t)l * 4 * 6144;
        const float* xin = (l == 0) ? x : X;
        const int li = l >> 1;
        k_norm<0><<<NT / 4, 256, 0, stream>>>(xin, norm1_g + l * DM, modl, 1, 0, H, nullptr, nullptr, nullptr, nullptr, nullptr, nullptr, nullptr, nullptr, nullptr);
        if ((l & 1) == 0) {
            const float* w_in = ev_w_in + (size_t)li * 1024 * 3072;
            { const int s[4][3] = {{0, 0, 512}, {512, 512, 512}, {1024, 1536, 512}, {1536, 2048, 512}}; ColMap cm = mk_map(4, s);
              k_gemm_naive<0><<<dim3(PW / 64, NT / 64), 256, 0, stream>>>(H, DM, w_in, 3072, cm, 1024, PF, PW, nullptr, nullptr); }
            k_ropeconv<<<(unsigned)((size_t)NT * PW / 256), 256, 0, stream>>>(PF, P, rope, 2048, 0, 512, 1024, 1536);
            { const int s[2][3] = {{0, 1024, 512}, {512, 2560, 512}}; ColMap cm = mk_map(2, s);
              k_gemm_naive<0><<<dim3(1024 / 64, NT / 64), 256, 0, stream>>>(H, DM, w_in, 3072, cm, 1024, DT, 1024, nullptr, nullptr); }
            k_vtconv<<<(unsigned)((size_t)1024 * NT / 256), 256, 0, stream>>>(DT, 1024, 1024, VT);
            k_moba_kmean<<<NB * 8 * 16, 64, 0, stream>>>(P, kmean);
            k_moba_gate<<<NB * 8 * SEQ / 256, 256, 0, stream>>>(P, kmean, mmask);
            { AttnN a; memset(&a, 0, sizeof(a)); a.khead = 64; a.Kb = P; a.kpitch = PW; a.kcol0 = 512; a.kdiv = 1; a.kbatch = (size_t)SEQ * PW;
              a.Vb = VT; a.vpitch = NT; a.vrow0 = 0; a.vdiv = 1; a.vbatch = SEQ; a.dv = 64; a.vhead = (size_t)64 * NT;
              a.Q = P; a.qcol0 = 0; a.mask = mmask; a.mdiv = 1; a.nmh = 8; a.window = 1 << 30; a.cmp = 0; a.nheads = 8; a.nchunk = 2;
              a.outmode = 0; a.Ob = O; a.Of = nullptr; a.opitch = 1024; a.ocol0 = 0; a.gate = nullptr; a.grow0 = 0; a.gidx = 0;
              k_attn_naive<<<NB * 8 * 2 * SEQ / 256, 256, 0, stream>>>(a); }
            { AttnN a; memset(&a, 0, sizeof(a)); a.khead = 64; a.Kb = P; a.kpitch = PW; a.kcol0 = 1536; a.kdiv = 1; a.kbatch = (size_t)SEQ * PW;
              a.Vb = VT; a.vpitch = NT; a.vrow0 = 512; a.vdiv = 2; a.vbatch = SEQ; a.dv = 128; a.vhead = (size_t)128 * NT;
              a.Q = P; a.qcol0 = 1024; a.mask = nullptr; a.mdiv = 1; a.nmh = 1; a.window = 1 << 30; a.cmp = 0; a.nheads = 8; a.nchunk = 4;
              a.outmode = 1; a.Ob = nullptr; a.Of = DT; a.opitch = 1024; a.ocol0 = 0; a.gate = nullptr; a.grow0 = 0; a.gidx = 0;
              k_attn_naive<<<NB * 8 * 4 * SEQ / 256, 256, 0, stream>>>(a); }
            k_diff_combine<<<NT * 4 / 4, 256, 0, stream>>>(DT, misc, li, ev_subln + li * 128, O);
            { const int s[1][3] = {{0, 0, 1024}}; ColMap cm = mk_map(1, s);
              k_gemm_naive<1><<<dim3(1024 / 64, NT / 64), 256, 0, stream>>>(O, 1024, ev_w_out + (size_t)li * 1024 * 1024, 1024, cm, 1024, X, 1024, xin, modl + 2 * 1024); }
        } else {
            const float* w_in = od_w_in + (size_t)li * 1024 * 2608;
            { const int s[5][3] = {{0, 0, 1024}, {1024, 1024, 256}, {1280, 1536, 256}, {1536, 2048, 256}, {1792, 1280, 256}}; ColMap cm = mk_map(5, s);
              k_gemm_naive<0><<<dim3(PW / 64, NT / 64), 256, 0, stream>>>(H, DM, w_in, 2608, cm, 1024, PF, PW, nullptr, nullptr); }
            k_ropeconv<<<(unsigned)((size_t)NT * PW / 256), 256, 0, stream>>>(PF, P, rope, 1792, 0, 1024, 0, 0);
            { const int s[3][3] = {{0, 1792, 256}, {256, 2304, 256}, {512, 2560, 48}}; ColMap cm = mk_map(3, s);
              k_gemm_naive<0><<<dim3(576 / 64, NT / 64), 256, 0, stream>>>(H, DM, w_in, 2608, cm, 1024, DT, 576, nullptr, nullptr); }
            k_vtconv<<<(unsigned)((size_t)576 * NT / 256), 256, 0, stream>>>(DT, 576, 576, VT);
            k_cmp1<<<2 * 4 * 1024, 256, 0, stream>>>(P, od_pos + (size_t)li * 2 * 2048, od_w1 + (size_t)li * 2 * 2048 * 256, od_b1 + li * 2 * 256, CH);
            k_cmp2<<<2 * 4 * 1024, 64, 0, stream>>>(CH, od_w2 + (size_t)li * 2 * 256 * 64, od_b2 + li * 2 * 64, KCMP, VCMPT);
            k_nsa_select<<<NB * 4 * SEQ / 64, 64, 0, stream>>>(P, KCMP, smask);
            AttnN a; memset(&a, 0, sizeof(a)); a.khead = 64; a.Q = P; a.qcol0 = 0; a.nheads = 16; a.nchunk = 2; a.dv = 64; a.Ob = nullptr; a.Of = DT; a.opitch = 1024; a.ocol0 = 0; a.gate = VT; a.grow0 = 512;
            a.Kb = P; a.kpitch = PW; a.kcol0 = 1536; a.kdiv = 4; a.kbatch = (size_t)SEQ * PW;
            a.Vb = VT; a.vpitch = NT; a.vrow0 = 256; a.vdiv = 4; a.vbatch = SEQ; a.vhead = (size_t)64 * NT;
            a.mask = nullptr; a.mdiv = 4; a.nmh = 4; a.window = 512; a.cmp = 0; a.outmode = 3; a.gidx = 2;
            k_attn_naive<<<NB * 16 * 2 * SEQ / 256, 256, 0, stream>>>(a);
            a.Kb = KCMP; a.kpitch = 64; a.kcol0 = 0; a.kdiv = 4; a.kbatch = (size_t)4 * 256 * 64; a.khead = (size_t)256 * 64;
            a.Vb = VCMPT; a.vpitch = 256; a.vrow0 = 0; a.vdiv = 4; a.vbatch = (size_t)4 * 64 * 256; a.vhead = (size_t)64 * 256;
            a.mask = nullptr; a.window = 1 << 30; a.cmp = 1; a.outmode = 2; a.gidx = 0;
            k_attn_naive<<<NB * 16 * 2 * SEQ / 256, 256, 0, stream>>>(a);
            a.Kb = P; a.kpitch = PW; a.kcol0 = 1280; a.kdiv = 4; a.kbatch = (size_t)SEQ * PW; a.khead = 64;
            a.Vb = VT; a.vpitch = NT; a.vrow0 = 0; a.vdiv = 4; a.vbatch = SEQ; a.vhead = (size_t)64 * NT;
            a.mask = smask; a.mdiv = 4; a.nmh = 4; a.window = 1 << 30; a.cmp = 0; a.outmode = 2; a.gidx = 1;
            k_attn_naive<<<NB * 16 * 2 * SEQ / 256, 256, 0, stream>>>(a);
            k_f32_to_bf16<<<(unsigned)((size_t)NT * 1024 / 256), 256, 0, stream>>>(DT, O);
            { const int s[1][3] = {{0, 0, 1024}}; ColMap cm = mk_map(1, s);
              k_gemm_naive<1><<<dim3(1024 / 64, NT / 64), 256, 0, stream>>>(O, 1024, od_w_out + (size_t)li * 1024 * 1024, 1024, cm, 1024, X, 1024, xin, modl + 2 * 1024); }
        }
        k_norm<1><<<NT / 4, 256, 0, stream>>>(X, norm2_g + l * DM, modl, 4, 3, H, nullptr, moe_wg + (size_t)l * 1024 * 4, moe_bg + l * 4, moe_we + (size_t)l * 1024 * 16, moe_be + l * 16,
                                              tok_e, tok_w, tok_rank, ctl + CW_CNT + l * 16);
        k_moe_hidden<<<NT * 2, 256, 0, stream>>>(H, tok_e, tok_w, moe_wgate + (size_t)l * 16 * 1024 * 256, moe_wup + (size_t)l * 16 * 1024 * 256, HID);
        k_moe_down<<<NT, 256, 0, stream>>>(HID, tok_e, moe_wdown + (size_t)l * 16 * 256 * 1024, modl + 5 * 1024, X);
    }
    k_norm<2><<<NT / 4, 256, 0, stream>>>(X, final_g, nullptr, 0, 0, nullptr, (float*)d_out, nullptr, nullptr, nullptr, nullptr, nullptr, nullptr, nullptr, nullptr);
}
```

```cpp
#include <hip/hip_runtime.h>
#include <stdint.h>
#include <stdio.h>
#include <string.h>

typedef unsigned short bf16_t;
typedef unsigned long long u64;

constexpr int NB = 4, SEQ = 4096, DM = 1024, NT = NB * SEQ, DEPTH = 4;
constexpr int PW = 2048;
constexpr float C2 = 0.125f * 1.4426950408889634f;
constexpr float NEGBIG = -1e30f;
constexpr float LINIT0 = 0.2f, LINIT1 = 0.47071301834358416f;

constexpr size_t MiB = 1u << 20;
constexpr size_t WS_CTL = 0;
constexpr size_t WS_MOD = 1 * MiB;
constexpr size_t WS_ROPE = 2 * MiB;
constexpr size_t WS_MISC = 3 * MiB;
constexpr size_t WS_KMEAN = 3 * MiB + 65536;
constexpr size_t WS_MMASK = 4 * MiB;
constexpr size_t WS_SMASK = 5 * MiB;
constexpr size_t WS_KCMP = 6 * MiB;
constexpr size_t WS_VCMPT = 6 * MiB + 524288;
constexpr size_t WS_CH = 7 * MiB;
constexpr size_t WS_ROUTE = 11 * MiB;
constexpr size_t WS_X = 16 * MiB;
constexpr size_t WS_H = 80 * MiB;
constexpr size_t WS_R = 112 * MiB;
constexpr size_t WS_P = WS_R;
constexpr size_t WS_VT = WS_R + 64 * MiB;
constexpr size_t WS_O = WS_R + 96 * MiB;
constexpr size_t WS_DT = WS_R + 128 * MiB;
constexpr size_t WS_PF = WS_R + 64 * MiB;
constexpr size_t WS_END = 304 * MiB;

constexpr int CW_CNT = 64;

__device__ __forceinline__ bf16_t f2bf(float f) { unsigned u = __float_as_uint(f); u = (u + 0x7fffu + ((u >> 16) & 1u)) >> 16; return (bf16_t)u; }
__device__ __forceinline__ float bf2f(bf16_t h) { return __uint_as_float(((unsigned)h) << 16); }
__device__ __forceinline__ float wave_sum(float v) {
#pragma unroll
    for (int o = 32; o >= 1; o >>= 1) v += __shfl_xor(v, o);
    return v;
}

__global__ void k_mod(const float* __restrict__ c, const float* __restrict__ ada_w, const float* __restrict__ ada_b, float* __restrict__ mod) {
    __shared__ float cs[4][1024];
    for (int i = threadIdx.x; i < 4096; i += 256) { float v = c[i]; cs[i >> 10][i & 1023] = v / (1.f + expf(-v)); }
    __syncthreads();
    const int j = blockIdx.x * 256 + threadIdx.x, l = blockIdx.y;
    const float* w = ada_w + (size_t)l * 1024 * 6144 + j;
    float a0 = 0.f, a1 = 0.f, a2 = 0.f, a3 = 0.f;
#pragma unroll 8
    for (int i = 0; i < 1024; ++i) { const float wv = w[(size_t)i * 6144]; a0 += cs[0][i] * wv; a1 += cs[1][i] * wv; a2 += cs[2][i] * wv; a3 += cs[3][i] * wv; }
    const float bb = ada_b[l * 6144 + j];
    mod[(l * 4 + 0) * 6144 + j] = a0 + bb; mod[(l * 4 + 1) * 6144 + j] = a1 + bb; mod[(l * 4 + 2) * 6144 + j] = a2 + bb; mod[(l * 4 + 3) * 6144 + j] = a3 + bb;
}

__global__ void k_rope(float* __restrict__ tab) {
    const int i = blockIdx.x * 256 + threadIdx.x;
    if (i < SEQ * 8) {
        const int pos = i >> 3, j = i & 7;
        const float inv = (float)pow(500000.0, -(double)j / 8.0);
        const float ang = (float)pos * inv;
        tab[i] = (float)cos((double)ang); tab[SEQ * 8 + i] = (float)sin((double)ang);
    }
}

__global__ void k_misc(const float* __restrict__ ev_lambda, float* __restrict__ misc) {
    const int lane = threadIdx.x;
    for (int i = 0; i < 2; ++i) {
        const float* lp = ev_lambda + i * 256;
        const float s1 = wave_sum(lp[lane] * lp[64 + lane]), s2 = wave_sum(lp[128 + lane] * lp[192 + lane]);
        if (lane == 0) misc[i] = expf(s1) - expf(s2) + (i == 0 ? LINIT0 : LINIT1);
    }
}

template <int MODE>
__global__ void __launch_bounds__(256) k_norm(const float* __restrict__ xin, const float* __restrict__ g, const float* __restrict__ modl, int sc_chunk, int sh_chunk,
                                              bf16_t* __restrict__ H, float* __restrict__ outf,
                                              const float* __restrict__ wg, const float* __restrict__ bg, const float* __restrict__ we, const float* __restrict__ be,
                                              int* __restrict__ tok_e, float* __restrict__ tok_w, int* __restrict__ tok_rank, unsigned* __restrict__ cnt) {
    const int lane = threadIdx.x & 63, t = blockIdx.x * 4 + (threadIdx.x >> 6), b = t / SEQ;
    const float* xr = xin + (size_t)t * DM;
    float4 xv[4]; float ss = 0.f;
#pragma unroll
    for (int i = 0; i < 4; ++i) { xv[i] = *(const float4*)(xr + i * 256 + lane * 4); ss += xv[i].x * xv[i].x + xv[i].y * xv[i].y + xv[i].z * xv[i].z + xv[i].w * xv[i].w; }
    ss = wave_sum(ss);
    const float rs = rsqrtf(ss * (1.f / DM) + 1e-6f);
    float hv[4][4];
#pragma unroll
    for (int i = 0; i < 4; ++i) {
        const int idx = i * 256 + lane * 4;
        const float4 gv = *(const float4*)(g + idx);
        float y0 = xv[i].x * rs * gv.x, y1 = xv[i].y * rs * gv.y, y2 = xv[i].z * rs * gv.z, y3 = xv[i].w * rs * gv.w;
        if (MODE == 2) { *(float4*)(outf + (size_t)t * DM + idx) = make_float4(y0, y1, y2, y3); }
        else {
            const float4 sc = *(const float4*)(modl + b * 6144 + sc_chunk * 1024 + idx), sh = *(const float4*)(modl + b * 6144 + sh_chunk * 1024 + idx);
            y0 = y0 * (1.f + sc.x) + sh.x; y1 = y1 * (1.f + sc.y) + sh.y; y2 = y2 * (1.f + sc.z) + sh.z; y3 = y3 * (1.f + sc.w) + sh.w;
            hv[i][0] = y0; hv[i][1] = y1; hv[i][2] = y2; hv[i][3] = y3;
            ushort4 o; o.x = f2bf(y0); o.y = f2bf(y1); o.z = f2bf(y2); o.w = f2bf(y3);
            *(ushort4*)(H + (size_t)t * DM + idx) = o;
        }
    }
    if (MODE == 1) {
        float acc[20];
#pragma unroll
        for (int q = 0; q < 20; ++q) acc[q] = 0.f;
#pragma unroll
        for (int i = 0; i < 4; ++i)
#pragma unroll
            for (int e = 0; e < 4; ++e) {
                const int idx = i * 256 + lane * 4 + e; const float h = hv[i][e];
                const float4 a = *(const float4*)(wg + idx * 4);
                acc[0] += h * a.x; acc[1] += h * a.y; acc[2] += h * a.z; acc[3] += h * a.w;
#pragma unroll
                for (int q = 0; q < 4; ++q) { const float4 w4 = *(const float4*)(we + idx * 16 + q * 4); acc[4 + q * 4] += h * w4.x; acc[5 + q * 4] += h * w4.y; acc[6 + q * 4] += h * w4.z; acc[7 + q * 4] += h * w4.w; }
            }
#pragma unroll
        for (int q = 0; q < 20; ++q) acc[q] = wave_sum(acc[q]);
        if (lane == 0) {
            float gl[4];
#pragma unroll
            for (int j = 0; j < 4; ++j) gl[j] = acc[j] + bg[j];
            int gs = 0; float gm = gl[0];
#pragma unroll
            for (int j = 1; j < 4; ++j) if (gl[j] > gm) { gm = gl[j]; gs = j; }
            float den = 0.f;
#pragma unroll
            for (int j = 0; j < 4; ++j) den += expf(gl[j] - gm);
            const float gw = 1.f / den;
            float el[4] = {0.f, 0.f, 0.f, 0.f};
#pragma unroll
            for (int gg = 0; gg < 4; ++gg)
#pragma unroll
                for (int j = 0; j < 4; ++j) if (gs == gg) el[j] = acc[4 + gg * 4 + j] + be[gg * 4 + j];
            int i1 = 0; float v1 = el[0];
#pragma unroll
            for (int j = 1; j < 4; ++j) if (el[j] > v1) { v1 = el[j]; i1 = j; }
            int i2 = -1; float v2 = -3.0e38f;
#pragma unroll
            for (int j = 0; j < 4; ++j) if (j != i1 && el[j] > v2) { v2 = el[j]; i2 = j; }
            const float t1 = 1.f / (1.f + expf(v2 - v1)), t2 = 1.f - t1;
            const int e1 = gs * 4 + i1, e2 = gs * 4 + i2;
            tok_e[t * 2] = e1; tok_e[t * 2 + 1] = e2; tok_w[t * 2] = gw * t1; tok_w[t * 2 + 1] = gw * t2;
            tok_rank[t * 2] = (int)atomicAdd(cnt + e1, 1u); tok_rank[t * 2 + 1] = (int)atomicAdd(cnt + e2, 1u);
        }
    }
}

struct ColMap { int nsec; int out0[8]; int src0[8]; int len[8]; };
__device__ __forceinline__ int cm_src(const ColMap& cm, int n) {
    int r = -1;
#pragma unroll
    for (int s = 0; s < 8; ++s) if (s < cm.nsec && n >= cm.out0[s] && n < cm.out0[s] + cm.len[s]) r = cm.src0[s] + (n - cm.out0[s]);
    return r;
}
template <int EPI>
__global__ void __launch_bounds__(256) k_gemm_naive(const bf16_t* __restrict__ A, int lda, const float* __restrict__ W, int ldw, ColMap cm, int K,
                                                    float* __restrict__ C, int ldc, const float* __restrict__ xin, const float* __restrict__ modg) {
    __shared__ float As[16][68], Bs[16][68];
    const int tid = threadIdx.x, tx = tid & 15, ty = tid >> 4;
    const int m0 = blockIdx.y * 64, n0 = blockIdx.x * 64;
    const int ar = tid >> 2, ak = (tid & 3) * 4;
    const int bk = tid >> 4, bn = (tid & 15) * 4;
    int sc[4];
#pragma unroll
    for (int j = 0; j < 4; ++j) sc[j] = cm_src(cm, n0 + bn + j);
    float acc[4][4];
#pragma unroll
    for (int i = 0; i < 4; ++i)
#pragma unroll
        for (int j = 0; j < 4; ++j) acc[i][j] = 0.f;
    for (int k0 = 0; k0 < K; k0 += 16) {
        const ushort4 av = *(const ushort4*)(A + (size_t)(m0 + ar) * lda + k0 + ak);
        As[ak + 0][ar] = bf2f(av.x); As[ak + 1][ar] = bf2f(av.y); As[ak + 2][ar] = bf2f(av.z); As[ak + 3][ar] = bf2f(av.w);
#pragma unroll
        for (int j = 0; j < 4; ++j) Bs[bk][bn + j] = sc[j] >= 0 ? W[(size_t)(k0 + bk) * ldw + sc[j]] : 0.f;
        __syncthreads();
#pragma unroll
        for (int k = 0; k < 16; ++k) {
            float a[4], bb[4];
#pragma unroll
            for (int i = 0; i < 4; ++i) a[i] = As[k][ty * 4 + i];
#pragma unroll
            for (int j = 0; j < 4; ++j) bb[j] = Bs[k][tx * 4 + j];
#pragma unroll
            for (int i = 0; i < 4; ++i)
#pragma unroll
                for (int j = 0; j < 4; ++j) acc[i][j] += a[i] * bb[j];
        }
        __syncthreads();
    }
#pragma unroll
    for (int i = 0; i < 4; ++i) {
        const int m = m0 + ty * 4 + i;
#pragma unroll
        for (int j = 0; j < 4; ++j) {
            const int n = n0 + tx * 4 + j;
            if (EPI == 0) C[(size_t)m * ldc + n] = acc[i][j];
            else C[(size_t)m * ldc + n] = xin[(size_t)m * ldc + n] + modg[(m / SEQ) * 6144 + n] * acc[i][j];
        }
    }
}

__global__ void k_ropeconv(const float* __restrict__ PF, bf16_t* __restrict__ P, const float* __restrict__ rope, int rope_cols, int qa0, int qa1, int qb0, int qb1) {
    const size_t i = (size_t)blockIdx.x * 256 + threadIdx.x;
    const int t = (int)(i / PW), n = (int)(i % PW), d = n & 63, pos = t % SEQ;
    float v = PF[i];
    if (n < rope_cols && d < 16) {
        const int j = d & 7; const float c = rope[pos * 8 + j], s = rope[SEQ * 8 + pos * 8 + j];
        const float p = PF[d < 8 ? i + 8 : i - 8];
        v = d < 8 ? v * c - p * s : v * c + p * s;
    }
    if ((n >= qa0 && n < qa1) || (n >= qb0 && n < qb1)) v *= C2;
    P[i] = f2bf(v);
}
__global__ void k_vtconv(const float* __restrict__ PF, int ld, int nf, bf16_t* __restrict__ VT) {
    const size_t i = (size_t)blockIdx.x * 256 + threadIdx.x;
    const int f = (int)(i / NT), t = (int)(i % NT);
    if (f < nf) VT[i] = f2bf(PF[(size_t)t * ld + f]);
}

__global__ void k_moba_kmean(const bf16_t* __restrict__ P, float* __restrict__ kmean) {
    const int d = threadIdx.x, blk = blockIdx.x & 15, h = (blockIdx.x >> 4) & 7, b = blockIdx.x >> 7;
    const bf16_t* kp = P + (size_t)(b * SEQ + blk * 256) * PW + 512 + h * 64 + d;
    float s = 0.f;
    for (int i = 0; i < 256; ++i) s += bf2f(kp[(size_t)i * PW]);
    kmean[((b * 8 + h) * 16 + blk) * 64 + d] = s * (1.f / 256.f);
}
__global__ void k_moba_gate(const bf16_t* __restrict__ P, const float* __restrict__ kmean, u64* __restrict__ mmask) {
    const int i = blockIdx.x * 256 + threadIdx.x;
    const int t = i % SEQ, h = (i / SEQ) & 7, b = i / (SEQ * 8);
    const int own = t >> 8;
    const bf16_t* qp = P + (size_t)(b * SEQ + t) * PW + h * 64;
    float q[64];
#pragma unroll
    for (int d = 0; d < 64; ++d) q[d] = bf2f(qp[d]);
    const float* km = kmean + (size_t)(b * 8 + h) * 16 * 64;
    float g0 = NEGBIG, g1 = NEGBIG, g2 = NEGBIG; int i0 = -1, i1 = -1, i2 = -1;
    for (int blk = 0; blk < own; ++blk) {
        float s = 0.f;
#pragma unroll
        for (int d = 0; d < 64; ++d) s += q[d] * km[blk * 64 + d];
        if (s > g0) { g2 = g1; i2 = i1; g1 = g0; i1 = i0; g0 = s; i0 = blk; }
        else if (s > g1) { g2 = g1; i2 = i1; g1 = s; i1 = blk; }
        else if (s > g2) { g2 = s; i2 = blk; }
    }
    u64 m = 0xFull << (4 * own);
    if (i0 >= 0) m |= 0xFull << (4 * i0);
    if (i1 >= 0) m |= 0xFull << (4 * i1);
    if (i2 >= 0) m |= 0xFull << (4 * i2);
    mmask[i] = m;
}

struct AttnN {
    const bf16_t* Kb; int kpitch; int kcol0; int kdiv; size_t kbatch; size_t khead;
    const bf16_t* Vb; int vpitch; int vrow0; int vdiv; size_t vbatch; int dv; size_t vhead;
    const bf16_t* Q; int qcol0;
    const u64* mask; int mdiv; int nmh;
    int window; int cmp;
    int nheads; int nchunk;
    int outmode; bf16_t* Ob; float* Of; int opitch; int ocol0;
    const bf16_t* gate; int grow0; int gidx;
};
__global__ void __launch_bounds__(256) k_attn_naive(AttnN a) {
    const int i = blockIdx.x * 256 + threadIdx.x;
    const int t = i % SEQ; int r = i / SEQ; const int ch = r % a.nchunk; r /= a.nchunk; const int h = r % a.nheads, b = r / a.nheads;
    const bf16_t* qp = a.Q + (size_t)(b * SEQ + t) * PW + a.qcol0 + h * 64;
    float q[64];
#pragma unroll
    for (int d = 0; d < 64; ++d) q[d] = bf2f(qp[d]);
    const bf16_t* kb = a.Kb + (size_t)b * a.kbatch + (size_t)(h / a.kdiv) * a.khead + a.kcol0;
    const bf16_t* vb = a.Vb + (size_t)b * a.vbatch + (size_t)(h / a.vdiv) * a.vhead + (size_t)(a.vrow0 + ch * 32) * a.vpitch;
    const u64 mk = a.mask ? a.mask[(size_t)(b * a.nmh + h / a.mdiv) * SEQ + t] : ~0ull;
    int lo, hi;
    if (a.cmp) { lo = 0; hi = t >= 31 ? (t - 31) / 16 : -1; }
    else { lo = t - a.window + 1; if (lo < 0) lo = 0; hi = t; }
    float m = NEGBIG, l = 0.f, o[32];
#pragma unroll
    for (int e = 0; e < 32; ++e) o[e] = 0.f;
    for (int key = lo; key <= hi; ++key) {
        if (!a.cmp && !((mk >> (key >> 6)) & 1ull)) { key |= 63; continue; }
        const bf16_t* kp = kb + (size_t)key * a.kpitch;
        float s = 0.f;
#pragma unroll
        for (int d = 0; d < 64; ++d) s += q[d] * bf2f(kp[d]);
        if (s > m) { const float c = exp2f(m - s); l *= c;
#pragma unroll
            for (int e = 0; e < 32; ++e) o[e] *= c;
            m = s; }
        const float p = exp2f(s - m);
        l += p;
#pragma unroll
        for (int e = 0; e < 32; ++e) o[e] += p * bf2f(vb[(size_t)e * a.vpitch + key]);
    }
    const float il = l > 0.f ? 1.f / l : 0.f;
    float gt = 1.f;
    if (a.outmode >= 2) { const float gl = bf2f(a.gate[(size_t)(a.grow0 + h * 3 + a.gidx) * NT + b * SEQ + t]); gt = 1.f / (1.f + expf(-gl)); }
    const size_t ob = (size_t)(b * SEQ + t) * a.opitch + a.ocol0 + h * a.dv + ch * 32;
#pragma unroll
    for (int e = 0; e < 32; ++e) {
        const float v = o[e] * il;
        if (a.outmode == 0) a.Ob[ob + e] = f2bf(v);
        else if (a.outmode == 1) a.Of[ob + e] = v;
        else if (a.outmode == 2) a.Of[ob + e] += gt * v;
        else a.Of[ob + e] = gt * v;
    }
}

__global__ void __launch_bounds__(256) k_diff_combine(const float* __restrict__ DT, const float* __restrict__ misc, int li, const float* __restrict__ subg, bf16_t* __restrict__ O) {
    const int lane = threadIdx.x & 63, w = blockIdx.x * 4 + (threadIdx.x >> 6), t = w >> 2, hd = w & 3;
    const float lam = misc[li], linit = li == 0 ? LINIT0 : LINIT1;
    const float* p0 = DT + (size_t)t * 1024 + (hd * 2) * 128, * p1 = p0 + 128;
    const float v0 = p0[lane] - lam * p1[lane], v1 = p0[64 + lane] - lam * p1[64 + lane];
    const float ss = wave_sum(v0 * v0 + v1 * v1);
    const float rs = rsqrtf(ss * (1.f / 128.f) + 1e-6f) * (1.f - linit);
    O[(size_t)t * 1024 + 512 + hd * 128 + lane] = f2bf(v0 * rs * subg[lane]);
    O[(size_t)t * 1024 + 512 + hd * 128 + 64 + lane] = f2bf(v1 * rs * subg[64 + lane]);
}
__global__ void k_f32_to_bf16(const float* __restrict__ src, bf16_t* __restrict__ dst) {
    const size_t i = (size_t)blockIdx.x * 256 + threadIdx.x; dst[i] = f2bf(src[i]);
}

__device__ __forceinline__ float gelu_tanh(float x) { return 0.5f * x * (1.f + tanhf(0.7978845608028654f * (x + 0.044715f * x * x * x))); }
__global__ void __launch_bounds__(256) k_cmp1(const bf16_t* __restrict__ P, const float* __restrict__ pos, const float* __restrict__ w1, const float* __restrict__ b1, bf16_t* __restrict__ CH) {
    const int f = threadIdx.x, r = blockIdx.x & 1023, g = (blockIdx.x >> 10) & 3, br = blockIdx.x >> 12;
    const int n = r & 255;
    __shared__ float xs[2048];
    const int col = (br == 0 ? 1024 : 1792) + g * 64;
    const float* pe = pos + br * 2048;
    for (int i = threadIdx.x; i < 2048; i += 256) { const int l = i >> 6, d = i & 63; const int tok = 16 * r + l;
        xs[i] = (n < 255) ? bf2f(P[(size_t)tok * PW + col + d]) + pe[i] : 0.f; }
    __syncthreads();
    const float* w = w1 + (size_t)br * 2048 * 256 + f;
    float s = 0.f;
    for (int i = 0; i < 2048; ++i) s += xs[i] * w[(size_t)i * 256];
    s += b1[br * 256 + f];
    CH[((size_t)(br * 4 + g) * 1024 + r) * 256 + f] = f2bf(n < 255 ? gelu_tanh(s) : 0.f);
}
__global__ void __launch_bounds__(64) k_cmp2(const bf16_t* __restrict__ CH, const float* __restrict__ w2, const float* __restrict__ b2, bf16_t* __restrict__ KCMP, bf16_t* __restrict__ VCMPT) {
    const int e = threadIdx.x, r = blockIdx.x & 1023, g = (blockIdx.x >> 10) & 3, br = blockIdx.x >> 12;
    const int b = r >> 8, n = r & 255;
    const bf16_t* hp = CH + ((size_t)(br * 4 + g) * 1024 + r) * 256;
    const float* w = w2 + (size_t)br * 256 * 64 + e;
    float s = b2[br * 64 + e];
    for (int f = 0; f < 256; ++f) s += bf2f(hp[f]) * w[f * 64];
    if (n == 255) s = 0.f;
    if (br == 0) KCMP[((size_t)(b * 4 + g) * 256 + n) * 64 + e] = f2bf(s);
    else VCMPT[((size_t)(b * 4 + g) * 64 + e) * 256 + n] = f2bf(s);
}
__global__ void __launch_bounds__(64) k_nsa_select(const bf16_t* __restrict__ P, const bf16_t* __restrict__ KCMP, u64* __restrict__ smask) {
    __shared__ float imp[64][65];
    const int lane = threadIdx.x, i = blockIdx.x * 64 + lane;
    const int t = i % SEQ, g = (i / SEQ) & 3, b = i / (SEQ * 4);
    for (int j = 0; j < 64; ++j) imp[j][lane] = 0.f;
    const int nmax = t >= 31 ? (t - 31) / 16 : -1;
    const bf16_t* kb = KCMP + (size_t)(b * 4 + g) * 256 * 64;
    for (int r = 0; r < 4; ++r) {
        const bf16_t* qp = P + (size_t)(b * SEQ + t) * PW + (g * 4 + r) * 64;
        float q[64];
#pragma unroll
        for (int d = 0; d < 64; ++d) q[d] = bf2f(qp[d]);
        float m = NEGBIG, l = 0.f;
        for (int n = 0; n <= nmax; ++n) {
            float s = 0.f;
#pragma unroll
            for (int d = 0; d < 64; ++d) s += q[d] * bf2f(kb[n * 64 + d]);
            if (s > m) { l *= exp2f(m - s); m = s; }
            l += exp2f(s - m);
        }
        const float il = l > 0.f ? 1.f / l : 0.f;
        for (int n = 0; n <= nmax; ++n) {
            float s = 0.f;
#pragma unroll
            for (int d = 0; d < 64; ++d) s += q[d] * bf2f(kb[n * 64 + d]);
            const float p = exp2f(s - m) * il;
            imp[n >> 2][lane] += p;
            if ((n & 3) == 3 && (n >> 2) + 1 < 64) imp[(n >> 2) + 1][lane] += p;
        }
    }
    const int own = t >> 6;
    u64 sel = 0ull;
    for (int j = 0; j < 64; ++j) {
        float v = imp[j][lane];
        if (j > own) v = NEGBIG; else if (j == 0 || j == own || j == own - 1) v = 1e6f;
        imp[j][lane] = v;
    }
    for (int k = 0; k < 16; ++k) {
        int bi = -1; float bv = -3.0e38f;
        for (int j = 0; j < 64; ++j) { const float v = imp[j][lane]; if (v > bv) { bv = v; bi = j; } }
        sel |= 1ull << bi; imp[bi][lane] = -3.4e38f;
    }
    smask[i] = sel;
}

__global__ void __launch_bounds__(256) k_moe_hidden(const bf16_t* __restrict__ H, const int* __restrict__ tok_e, const float* __restrict__ tok_w,
                                                    const float* __restrict__ wgate, const float* __restrict__ wup, float* __restrict__ HID) {
    const int f = threadIdx.x, ts = blockIdx.x, t = ts >> 1;
    __shared__ float hs[1024];
    for (int i = f; i < 1024; i += 256) hs[i] = bf2f(H[(size_t)t * DM + i]);
    __syncthreads();
    const int e = tok_e[ts];
    const float* wg = wgate + (size_t)e * 1024 * 256 + f, * wu = wup + (size_t)e * 1024 * 256 + f;
    float sg = 0.f, su = 0.f;
#pragma unroll 4
    for (int k = 0; k < 1024; ++k) { const float h = hs[k]; sg += h * wg[(size_t)k * 256]; su += h * wu[(size_t)k * 256]; }
    HID[(size_t)ts * 256 + f] = sg / (1.f + expf(-sg)) * su * tok_w[ts];
}
__global__ void __launch_bounds__(256) k_moe_down(const float* __restrict__ HID, const int* __restrict__ tok_e, const float* __restrict__ wdown,
                                                  const float* __restrict__ modg, float* __restrict__ X) {
    const int t = blockIdx.x, b = t / SEQ;
    __shared__ float hs[512];
    for (int i = threadIdx.x; i < 512; i += 256) hs[i] = HID[(size_t)t * 512 + i];
    __syncthreads();
    float y[4] = {0.f, 0.f, 0.f, 0.f};
    for (int sl = 0; sl < 2; ++sl) {
        const int e = tok_e[t * 2 + sl];
        const float* w = wdown + (size_t)e * 256 * 1024 + threadIdx.x;
        for (int f = 0; f < 256; ++f) { const float h = hs[sl * 256 + f];
#pragma unroll
            for (int j = 0; j < 4; ++j) y[j] += h * w[(size_t)f * 1024 + j * 256]; }
    }
#pragma unroll
    for (int j = 0; j < 4; ++j) { const int d = threadIdx.x + j * 256; X[(size_t)t * DM + d] += modg[b * 6144 + d] * y[j]; }
}


#define LAS __attribute__((address_space(3)))
typedef short bf16x8 __attribute__((ext_vector_type(8)));
typedef float f32x4 __attribute__((ext_vector_type(4)));
typedef float f32x16 __attribute__((ext_vector_type(16)));
typedef unsigned u32x4 __attribute__((ext_vector_type(4)));
typedef unsigned u32x2 __attribute__((ext_vector_type(2)));

constexpr int NWAVES = 8, NTHR = 512;
constexpr int LDS_BYTES = 147456;
constexpr size_t WS_WIN = 304 * MiB;
constexpr size_t WS_WOUT = 328 * MiB;
constexpr size_t WS_W1T = 336 * MiB;
constexpr size_t WS_WGU = 340 * MiB;
constexpr size_t WS_WD = 356 * MiB;
constexpr size_t WS_END2 = 364 * MiB;
constexpr size_t WS_VCX = 12 * MiB;
constexpr size_t WS_FOLD = WS_MISC + 1024;
constexpr int MP_ROWS = 36864;
constexpr size_t WS_APERM = WS_R;
constexpr size_t WS_HIDP = WS_R + 72 * MiB;
constexpr size_t WS_Y = WS_R + 96 * MiB;
constexpr size_t WS_POS = WS_ROUTE + 393216;
constexpr size_t WS_WPERM = WS_ROUTE + 524288;
constexpr size_t WS_TILEX = WS_ROUTE + 786432;

struct Params { const float* in[25]; float* out; unsigned char* ws; };

__device__ __forceinline__ unsigned pk2(float lo, float hi) { return (unsigned)f2bf(lo) | ((unsigned)f2bf(hi) << 16); }
__device__ __forceinline__ unsigned cvt_pk_bf16(float lo, float hi) { unsigned r; asm volatile("v_cvt_pk_bf16_f32 %0, %1, %2" : "=v"(r) : "v"(lo), "v"(hi)); return r; }

__device__ __forceinline__ void conv_item(const float* W, int ldw, int col0, int nvalid, int K, bf16_t* WT, int row0, int rmul, LAS float* scr, int item, int nblk, int lane) {
    const int kb = item / nblk, nb = item % nblk, k0 = 64 * kb, n0 = 32 * nb;
    const int nn = n0 + (lane & 31);
#pragma unroll 8
    for (int i = 0; i < 32; ++i) { const int kk = 2 * i + (lane >> 5); scr[kk * 33 + (lane & 31)] = (nn < nvalid) ? W[(size_t)(k0 + kk) * ldw + col0 + nn] : 0.f; }
    asm volatile("s_waitcnt lgkmcnt(0)" ::: "memory");
    const int c = lane & 7;
#pragma unroll
    for (int j = 0; j < 4; ++j) { const int n = (lane >> 3) + 8 * j; const LAS float* s = scr + (8 * c) * 33 + n;
        u32x4 o; o.x = pk2(s[0 * 33], s[1 * 33]); o.y = pk2(s[2 * 33], s[3 * 33]); o.z = pk2(s[4 * 33], s[5 * 33]); o.w = pk2(s[6 * 33], s[7 * 33]);
        *(u32x4*)(WT + (size_t)(row0 + (n0 + n) * rmul) * K + k0 + 8 * c) = o; }
    asm volatile("s_waitcnt lgkmcnt(0)" ::: "memory");
}
struct ConvCtx { LAS float* scr; int gw, NGW, lane, base; };
__device__ __forceinline__ void conv_job(ConvCtx& cx, const float* W, int ldw, int col0, int ncols, int nvalid, int K, bf16_t* WT, int row0, int rmul) {
    const int nblk = ncols / 32, nitems = (K / 64) * nblk;
    int it = cx.gw - (cx.base % cx.NGW); if (it < 0) it += cx.NGW;
    for (; it < nitems; it += cx.NGW) conv_item(W, ldw, col0, nvalid, K, WT, row0, rmul, cx.scr, it, nblk, cx.lane);
    cx.base += nitems;
}
__device__ __forceinline__ void ph_conv_static(const Params& p, LAS unsigned char* lds, int vcu, int G) {
    const int tid = threadIdx.x, lane = tid & 63, wave = tid >> 6;
    ConvCtx cx; cx.scr = (LAS float*)(lds + wave * 16384); cx.gw = vcu * NWAVES + wave; cx.NGW = G * NWAVES; cx.lane = lane; cx.base = 0;
    for (int l = 0; l < DEPTH; ++l) {
        const int li = l >> 1;
        bf16_t* win = (bf16_t*)(p.ws + WS_WIN) + (size_t)l * 3072 * 1024;
        bf16_t* wout = (bf16_t*)(p.ws + WS_WOUT) + (size_t)l * 1024 * 1024;
        if ((l & 1) == 0) {
            const float* w = p.in[7] + (size_t)li * 1024 * 3072;
            conv_job(cx, w, 3072, 0, 512, 512, 1024, win, 0, 1);
            conv_job(cx, w, 3072, 512, 512, 512, 1024, win, 512, 1);
            conv_job(cx, w, 3072, 1536, 512, 512, 1024, win, 1024, 1);
            conv_job(cx, w, 3072, 2048, 512, 512, 1024, win, 1536, 1);
            conv_job(cx, w, 3072, 1024, 512, 512, 1024, win, 2048, 1);
            conv_job(cx, w, 3072, 2560, 512, 512, 1024, win, 2560, 1);
            conv_job(cx, p.in[8] + (size_t)li * 1024 * 1024, 1024, 0, 1024, 1024, 1024, wout, 0, 1);
        } else {
            const float* w = p.in[11] + (size_t)li * 1024 * 2608;
            conv_job(cx, w, 2608, 0, 1024, 1024, 1024, win, 0, 1);
            conv_job(cx, w, 2608, 1024, 256, 256, 1024, win, 1024, 1);
            conv_job(cx, w, 2608, 1536, 256, 256, 1024, win, 1280, 1);
            conv_job(cx, w, 2608, 2048, 256, 256, 1024, win, 1536, 1);
            conv_job(cx, w, 2608, 1280, 256, 256, 1024, win, 1792, 1);
            conv_job(cx, w, 2608, 1792, 256, 256, 1024, win, 2048, 1);
            conv_job(cx, w, 2608, 2304, 256, 256, 1024, win, 2304, 1);
            conv_job(cx, w, 2608, 2560, 256, 48, 1024, win, 2560, 1);
            conv_job(cx, p.in[12] + (size_t)li * 1024 * 1024, 1024, 0, 1024, 1024, 1024, wout, 0, 1);
            bf16_t* w1t = (bf16_t*)(p.ws + WS_W1T) + (size_t)li * 2 * 256 * 2048;
            conv_job(cx, p.in[14] + (size_t)(li * 2 + 0) * 2048 * 256, 256, 0, 256, 256, 2048, w1t, 0, 1);
            conv_job(cx, p.in[14] + (size_t)(li * 2 + 1) * 2048 * 256, 256, 0, 256, 256, 2048, w1t + (size_t)256 * 2048, 0, 1);
        }
    }
}
__device__ __forceinline__ void ph_conv_moe(const Params& p, LAS unsigned char* lds, int l, int vcu, int G) {
    const int tid = threadIdx.x, lane = tid & 63, wave = tid >> 6;
    ConvCtx cx; cx.scr = (LAS float*)(lds + wave * 16384); cx.gw = vcu * NWAVES + wave; cx.NGW = G * NWAVES; cx.lane = lane; cx.base = 0;
    bf16_t* wgu = (bf16_t*)(p.ws + WS_WGU); bf16_t* wd = (bf16_t*)(p.ws + WS_WD);
    for (int e = 0; e < 16; ++e) {
        conv_job(cx, p.in[22] + (size_t)(l * 16 + e) * 1024 * 256, 256, 0, 256, 256, 1024, wgu + (size_t)e * 512 * 1024, 0, 2);
        conv_job(cx, p.in[23] + (size_t)(l * 16 + e) * 1024 * 256, 256, 0, 256, 256, 1024, wgu + (size_t)e * 512 * 1024, 1, 2);
        conv_job(cx, p.in[24] + (size_t)(l * 16 + e) * 256 * 1024, 1024, 0, 1024, 1024, 256, wd + (size_t)e * 1024 * 256, 0, 1);
    }
}

namespace pg8 {
constexpr int BM = 256, BK = 64, HALF = 128, HTB = HALF * BK * 2, STAGE_BYTES = 8 * HTB, NXCD = 8, WGM = 8;
__host__ __device__ __forceinline__ int lds_byte(int r, int c) { const int st = (r >> 4) * 2 + (c >> 5), rr = r & 15, cc = c & 31, ob = rr * 64 + cc * 2; return st * 1024 + (ob ^ (((ob >> 9) & 1) << 5)); }
__host__ __device__ __forceinline__ void stage_rc(int b, int& R, int& C) { const int st = b / 1024, sb = b % 1024, swz = sb ^ (((sb >> 9) & 1) << 5); R = (st >> 1) * 16 + swz / 64; C = (st & 1) * 32 + (swz % 64) / 2; }
__host__ __device__ __forceinline__ int perm32(int rho) { const int n = rho >> 4, i = rho & 15; return 8 * (i >> 2) + 4 * n + (i & 3); }
struct Unit { int pm, pn; };
struct Gemm { const bf16_t* A; const bf16_t* Bt; int K; unsigned lda_b; unsigned kstepA; };
struct StaticOrder {
    int nM, nN, nwg, G, c;
    __host__ __device__ void init(int M, int N, int G_, int c_) { nM = M / BM; nN = N / BM; nwg = nM * nN; G = G_; c = c_; }
    __host__ __device__ bool next(int i, Unit& u) const {
        const long L = (long)i * G + c; if (L >= nwg) return false;
        int wgid = (int)L; { const int q = nwg / NXCD, r = nwg % NXCD, xcd = wgid % NXCD, off = wgid / NXCD; wgid = (xcd < r ? xcd * (q + 1) : r * (q + 1) + (xcd - r) * q) + off; }
        const int nig = WGM * nN, gid = wgid / nig, fm = gid * WGM, gsz = (nM - fm) < WGM ? (nM - fm) : WGM;
        u.pm = fm + ((wgid % nig) % gsz); u.pn = (wgid % nig) / gsz; return true;
    }
    __host__ __device__ size_t aoff(const Unit& u, size_t tstepA) const { return (size_t)u.pm * tstepA; }
};
template <class Epi, class Sched>
__device__ __forceinline__ void gemm_phase(LAS unsigned char* lds, const Gemm g, const Sched& S, const Epi& E) {
    const int tid = threadIdx.x, wid = __builtin_amdgcn_readfirstlane(tid >> 6), lane = tid & 63, wr = wid >> 2, wc = wid & 3, fr = lane & 15, fq = lane >> 4;
    const int K = g.K, nt = K / BK;
    unsigned voffA[2], voffB[2];
#pragma unroll
    for (int i = 0; i < 2; ++i) { int R, C; stage_rc(tid * 16 + i * 8192, R, C); const int Rb = (R & ~31) + perm32(R & 31);
        voffA[i] = (unsigned)R * g.lda_b + (unsigned)C * 2u; voffB[i] = (unsigned)(Rb * K + C) * 2u; }
    const size_t kstepA = g.kstepA, kstepB = (size_t)(BK * 2);
    const size_t hstepA = (size_t)HALF * g.lda_b, hstepB = (size_t)HALF * K * 2;
    const size_t tstepA = 2 * hstepA, tstepB = 2 * hstepB;
    const unsigned ldsw = (unsigned)wid * 1024u;
    const int aoff = lds_byte(wr * 64 + fr, fq * 8), boff = lds_byte(wc * 32 + fr, fq * 8);
#define PG8_SA(b, h) (((b) * 2 + (h)) * HTB)
#define PG8_SB(b, h) ((4 + (b) * 2 + (h)) * HTB)
#define PG8_STAGE(bufoff, gbase, voff) do { _Pragma("unroll") for (int _i = 0; _i < 2; ++_i) \
        __builtin_amdgcn_global_load_lds((const unsigned*)((const char*)(gbase) + (voff)[_i]), (LAS unsigned*)(lds + (bufoff) + ldsw + _i * 8192), 16, 0, 0); } while (0)
#define PG8_LDA(dst, b, h) do { _Pragma("unroll") for (int m = 0; m < 4; ++m) _Pragma("unroll") for (int k = 0; k < 2; ++k) dst[m][k] = *(const LAS bf16x8*)(lds + PG8_SA(b, h) + aoff + m * 2048 + k * 1024); } while (0)
#define PG8_LDB(dst, b, h) do { _Pragma("unroll") for (int n = 0; n < 2; ++n) _Pragma("unroll") for (int k = 0; k < 2; ++k) dst[n][k] = *(const LAS bf16x8*)(lds + PG8_SB(b, h) + boff + n * 2048 + k * 1024); } while (0)
#define PG8_MMA(ai, bj, At, Bt) do { __builtin_amdgcn_s_setprio(1); _Pragma("unroll") for (int m = 0; m < 4; ++m) _Pragma("unroll") for (int n = 0; n < 2; ++n) _Pragma("unroll") for (int k = 0; k < 2; ++k) \
        acc[ai][bj][m][n] = __builtin_amdgcn_mfma_f32_16x16x32_bf16(Bt[n][k], At[m][k], acc[ai][bj][m][n], 0, 0, 0); __builtin_amdgcn_s_setprio(0); } while (0)
#define PG8_WAIT_V(n) asm volatile("s_waitcnt vmcnt(" #n ")" ::: "memory")
#define PG8_WAIT_L(n) asm volatile("s_waitcnt lgkmcnt(" #n ")" ::: "memory")
#define PG8_BAR __builtin_amdgcn_s_barrier()
#define PG8_SCHED __builtin_amdgcn_sched_barrier(0)
    Unit cur, nxt; int ui = 0;
    if (!S.next(0, cur)) return;
    f32x4 acc[2][2][4][2];
#pragma unroll
    for (int a = 0; a < 2; ++a)
#pragma unroll
        for (int b = 0; b < 2; ++b)
#pragma unroll
            for (int m = 0; m < 4; ++m)
#pragma unroll
                for (int n = 0; n < 2; ++n) acc[a][b][m][n] = (f32x4){0.f, 0.f, 0.f, 0.f};
    bf16x8 At[4][2], B0[2][2], B1[2][2];
    const char* cA = (const char*)g.A + S.aoff(cur, tstepA); const char* cB = (const char*)g.Bt + (size_t)cur.pn * tstepB;
    {
        PG8_STAGE(PG8_SB(0, 0), cB, voffB); PG8_STAGE(PG8_SB(0, 1), cB + hstepB, voffB); PG8_STAGE(PG8_SA(0, 0), cA, voffA); PG8_STAGE(PG8_SA(0, 1), cA + hstepA, voffA);
        if (wr == 1) PG8_BAR;
        PG8_WAIT_V(2); PG8_BAR;
        PG8_STAGE(PG8_SB(1, 0), cB + kstepB, voffB); PG8_STAGE(PG8_SA(1, 0), cA + kstepA, voffA); PG8_STAGE(PG8_SB(1, 1), cB + hstepB + kstepB, voffB);
        PG8_WAIT_V(6); PG8_BAR;
    }
    for (;;) {
        const bool has_next = S.next(ui + 1, nxt);
        const char* nA = has_next ? (const char*)g.A + S.aoff(nxt, tstepA) : cA; const char* nB = has_next ? (const char*)g.Bt + (size_t)nxt.pn * tstepB : cB;
#pragma unroll 1
        for (int t = 0; t < nt; t += 2) {
            const bool last = (t == nt - 2);
            const char* a1 = cA + (size_t)(t + 1) * kstepA;
            const char* a2 = last ? nA : cA + (size_t)(t + 2) * kstepA; const char* b2 = last ? nB : cB + (size_t)(t + 2) * kstepB;
            const char* a3 = a2 + kstepA; const char* b3 = b2 + kstepB;
            PG8_LDB(B0, 0, 0); PG8_LDB(B1, 0, 1); PG8_SCHED; PG8_LDA(At, 0, 0); PG8_STAGE(PG8_SA(1, 1), a1 + hstepA, voffA);
            PG8_WAIT_V(8); PG8_WAIT_L(0); PG8_BAR; PG8_MMA(0, 0, At, B0); PG8_MMA(0, 1, At, B1); PG8_BAR; PG8_SCHED;
            PG8_LDA(At, 0, 1); PG8_STAGE(PG8_SB(0, 0), b2, voffB); PG8_STAGE(PG8_SB(0, 1), b2 + hstepB, voffB); PG8_STAGE(PG8_SA(0, 0), a2, voffA);
            PG8_WAIT_V(8); PG8_WAIT_L(0); PG8_BAR; PG8_MMA(1, 0, At, B0); PG8_MMA(1, 1, At, B1); PG8_BAR; PG8_SCHED;
            PG8_LDB(B0, 1, 0); PG8_LDB(B1, 1, 1); PG8_SCHED; PG8_LDA(At, 1, 0); PG8_STAGE(PG8_SA(0, 1), a2 + hstepA, voffA);
            PG8_WAIT_V(8); PG8_WAIT_L(0); PG8_BAR; PG8_MMA(0, 0, At, B0); PG8_MMA(0, 1, At, B1); PG8_BAR; PG8_SCHED;
            PG8_LDA(At, 1, 1); PG8_STAGE(PG8_SB(1, 0), b3, voffB); PG8_STAGE(PG8_SB(1, 1), b3 + hstepB, voffB); PG8_STAGE(PG8_SA(1, 0), a3, voffA);
            PG8_WAIT_V(8); PG8_WAIT_L(0); PG8_BAR; PG8_MMA(1, 0, At, B0); PG8_MMA(1, 1, At, B1); PG8_BAR; PG8_SCHED;
        }
        if (wr == 0) PG8_BAR;
        E(acc, cur, wr, wc, fr, fq);
        if (!has_next) break;
#pragma unroll
        for (int a = 0; a < 2; ++a)
#pragma unroll
            for (int b = 0; b < 2; ++b)
#pragma unroll
                for (int m = 0; m < 4; ++m)
#pragma unroll
                    for (int n = 0; n < 2; ++n) acc[a][b][m][n] = (f32x4){0.f, 0.f, 0.f, 0.f};
        cur = nxt; cA = nA; cB = nB; ++ui;
        if (wr == 1) PG8_BAR;
    }
    PG8_WAIT_V(0);
    PG8_BAR;
#undef PG8_SA
#undef PG8_SB
#undef PG8_STAGE
#undef PG8_LDA
#undef PG8_LDB
#undef PG8_MMA
#undef PG8_WAIT_V
#undef PG8_WAIT_L
#undef PG8_BAR
#undef PG8_SCHED
}
}

typedef f32x4 AccT[2][2][4][2];
struct EpiProj {
    bf16_t* P; const float* rope; int rope_tiles; unsigned qmask;
    __device__ __forceinline__ void operator()(const AccT& acc, const pg8::Unit& u, int wr, int wc, int fr, int fq) const {
        const int row0 = u.pm * 256 + wr * 64 + fr, col0 = u.pn * 256 + wc * 32 + 8 * fq;
        const bool do_rope = (u.pn < rope_tiles) && ((wc & 1) == 0);
        const float sc = ((qmask >> u.pn) & 1u) ? C2 : 1.f;
#pragma unroll
        for (int ai = 0; ai < 2; ++ai)
#pragma unroll
            for (int m = 0; m < 4; ++m) {
                const int row = row0 + ai * 128 + m * 16, pos = row & (SEQ - 1);
                f32x4 c0 = {1.f, 1.f, 1.f, 1.f}, c1 = c0, s0 = {0.f, 0.f, 0.f, 0.f}, s1 = s0;
                if (do_rope) { c0 = *(const f32x4*)(rope + pos * 8); c1 = *(const f32x4*)(rope + pos * 8 + 4); s0 = *(const f32x4*)(rope + SEQ * 8 + pos * 8); s1 = *(const f32x4*)(rope + SEQ * 8 + pos * 8 + 4); }
#pragma unroll
                for (int bj = 0; bj < 2; ++bj) {
                    f32x4 v0 = acc[ai][bj][m][0], v1 = acc[ai][bj][m][1];
                    if (do_rope) {
                        f32x4 p0, p1;
#pragma unroll
                        for (int e = 0; e < 4; ++e) { p0[e] = __shfl_xor(v0[e], 16); p1[e] = __shfl_xor(v1[e], 16); }
                        const f32x4 a0 = v0 * c0 - p0 * s0, a1 = v1 * c1 - p1 * s1, b0 = v0 * c0 + p0 * s0, b1 = v1 * c1 + p1 * s1;
                        v0 = fq == 0 ? a0 : (fq == 1 ? b0 : v0); v1 = fq == 0 ? a1 : (fq == 1 ? b1 : v1);
                    }
                    v0 = v0 * sc; v1 = v1 * sc;
                    u32x4 w; w.x = cvt_pk_bf16(v0[0], v0[1]); w.y = cvt_pk_bf16(v0[2], v0[3]); w.z = cvt_pk_bf16(v1[0], v1[1]); w.w = cvt_pk_bf16(v1[2], v1[3]);
                    *(u32x4*)(P + (size_t)row * PW + col0 + bj * 128) = w;
                }
            }
    }
};
struct EpiBf16 {
    bf16_t* O; int ldc; int pnmask;
    __device__ __forceinline__ void operator()(const AccT& acc, const pg8::Unit& u, int wr, int wc, int fr, int fq) const {
        const int row0 = u.pm * 256 + wr * 64 + fr, col0 = (u.pn & pnmask) * 256 + wc * 32 + 8 * fq;
#pragma unroll
        for (int ai = 0; ai < 2; ++ai)
#pragma unroll
            for (int m = 0; m < 4; ++m) {
                bf16_t* rowp = O + (size_t)(row0 + ai * 128 + m * 16) * ldc + col0;
#pragma unroll
                for (int bj = 0; bj < 2; ++bj) { const f32x4 v0 = acc[ai][bj][m][0], v1 = acc[ai][bj][m][1];
                    u32x4 w; w.x = cvt_pk_bf16(v0[0], v0[1]); w.y = cvt_pk_bf16(v0[2], v0[3]); w.z = cvt_pk_bf16(v1[0], v1[1]); w.w = cvt_pk_bf16(v1[2], v1[3]);
                    *(u32x4*)(rowp + bj * 128) = w; }
            }
    }
};
struct EpiResid {
    const float* xin; float* xout; const float* g;
    __device__ __forceinline__ void operator()(const AccT& acc, const pg8::Unit& u, int wr, int wc, int fr, int fq) const {
        const int row0 = u.pm * 256 + wr * 64 + fr, col0 = u.pn * 256 + wc * 32 + 8 * fq;
        const float* gb = g + (u.pm / 16) * 6144;
#pragma unroll
        for (int bj = 0; bj < 2; ++bj) {
            const f32x4 g0 = *(const f32x4*)(gb + col0 + bj * 128), g1 = *(const f32x4*)(gb + col0 + bj * 128 + 4);
#pragma unroll
            for (int ai = 0; ai < 2; ++ai)
#pragma unroll
                for (int m = 0; m < 4; ++m) {
                    const size_t off = (size_t)(row0 + ai * 128 + m * 16) * DM + col0 + bj * 128;
                    const f32x4 x0 = *(const f32x4*)(xin + off), x1 = *(const f32x4*)(xin + off + 4);
                    *(f32x4*)(xout + off) = x0 + g0 * acc[ai][bj][m][0]; *(f32x4*)(xout + off + 4) = x1 + g1 * acc[ai][bj][m][1];
                }
        }
    }
};

__device__ __forceinline__ void ph_inproj(const Params& p, LAS unsigned char* lds, int l, int bx, int G) {
    const bf16_t* H = (const bf16_t*)(p.ws + WS_H);
    const bf16_t* win = (const bf16_t*)(p.ws + WS_WIN) + (size_t)l * 3072 * 1024;
    const bool even = (l & 1) == 0;
    {
        pg8::Gemm g{H, win, 1024, 2048u, 128u}; pg8::StaticOrder S; S.init(NT, PW, G, bx);
        EpiProj E{(bf16_t*)(p.ws + WS_P), (const float*)(p.ws + WS_ROPE), even ? 8 : 7, even ? 0x33u : 0x0Fu};
        pg8::gemm_phase<EpiProj, pg8::StaticOrder>(lds, g, S, E);
    }
    {
        pg8::Gemm g{win + (size_t)2048 * 1024, H, 1024, 2048u, 128u}; pg8::StaticOrder S; S.init(even ? 1024 : 768, NT, G, bx);
        EpiBf16 E{(bf16_t*)(p.ws + WS_VT), NT, 0x7fffffff};
        pg8::gemm_phase<EpiBf16, pg8::StaticOrder>(lds, g, S, E);
    }
}
__device__ __forceinline__ void ph_outproj(const Params& p, LAS unsigned char* lds, int l, int bx, int G) {
    const bf16_t* O = (const bf16_t*)(p.ws + WS_O);
    const bf16_t* wout = (const bf16_t*)(p.ws + WS_WOUT) + (size_t)l * 1024 * 1024;
    float* X = (float*)(p.ws + WS_X);
    pg8::Gemm g{O, wout, 1024, 2048u, 128u}; pg8::StaticOrder S; S.init(NT, DM, G, bx);
    EpiResid E{l == 0 ? p.in[0] : X, X, (const float*)(p.ws + WS_MOD) + (size_t)l * 4 * 6144 + 2 * 1024};
    pg8::gemm_phase<EpiResid, pg8::StaticOrder>(lds, g, S, E);
}


typedef float f32x2_t __attribute__((ext_vector_type(2))); typedef __bf16 bf16x2_t __attribute__((ext_vector_type(2)));
__device__ __forceinline__ unsigned cvtpk_s(float lo, float hi) { f32x2_t v = {lo, hi}; bf16x2_t b = __builtin_convertvector(v, bf16x2_t); return __builtin_bit_cast(unsigned, b); }
#define MFMA32(a, b, c) __builtin_amdgcn_mfma_f32_32x32x16_bf16((a), (b), (c), 0, 0, 0)
constexpr int AT_KB = 64 * 144, AT_VB = 128 * 136;
constexpr int AT_KOFF = 0, AT_VOFF = 2 * AT_KB;
constexpr int AT_MASK = AT_VOFF + 2 * AT_VB;
constexpr int AT_RED = AT_MASK + 2048;
constexpr int AT_KM = AT_RED + 1024;
constexpr int AT_IMP = 61440;
static_assert(AT_IMP + 4 * 64 * 65 * 4 <= 131072, "attention LDS map");

template <int DVB>
__device__ __forceinline__ void attn_run(LAS unsigned char* lds, const bf16_t* __restrict__ Kg, int kpitch, const bf16_t* __restrict__ Vg, int vpitch,
                                         u64 tmask, u64 mymask, int klim, int kmin, const bf16x8 (&qf)[4], f32x16 (&o)[DVB], float& m, float& l) {
    const int tid = threadIdx.x, lane = tid & 63, r = lane & 31, hi = lane >> 5;
    const int lrow = tid >> 3, lch = tid & 7;
    if (tmask == 0ull) return;
    int j = __builtin_ctzll(tmask); tmask &= tmask - 1ull;
    {
        const u32x4 kreg = *(const u32x4*)(Kg + (size_t)(j * 64 + lrow) * kpitch + lch * 8);
        u32x4 vreg[DVB / 2];
#pragma unroll
        for (int i = 0; i < DVB / 2; ++i) vreg[i] = *(const u32x4*)(Vg + (size_t)(lrow + 64 * i) * vpitch + j * 64 + lch * 8);
        *(LAS u32x4*)(lds + AT_KOFF + lrow * 144 + lch * 16) = kreg;
#pragma unroll
        for (int i = 0; i < DVB / 2; ++i) { LAS unsigned char* vp = lds + AT_VOFF + (lrow + 64 * i) * 136 + lch * 16;
            *(LAS u32x2*)vp = (u32x2){vreg[i].x, vreg[i].y}; *(LAS u32x2*)(vp + 8) = (u32x2){vreg[i].z, vreg[i].w}; }
    }
    __syncthreads();
    int cur = 0;
    for (;;) {
        int jn = -1; if (tmask != 0ull) { jn = __builtin_ctzll(tmask); tmask &= tmask - 1ull; }
        u32x4 kreg = {0u, 0u, 0u, 0u}; u32x4 vreg[DVB / 2];
#pragma unroll
        for (int i = 0; i < DVB / 2; ++i) vreg[i] = (u32x4){0u, 0u, 0u, 0u};
        if (jn >= 0) {
            kreg = *(const u32x4*)(Kg + (size_t)(jn * 64 + lrow) * kpitch + lch * 8);
#pragma unroll
            for (int i = 0; i < DVB / 2; ++i) vreg[i] = *(const u32x4*)(Vg + (size_t)(lrow + 64 * i) * vpitch + jn * 64 + lch * 8);
        }
        {
            const int k0 = j * 64;
            const bool bit = ((mymask >> j) & 1ull) != 0ull;
            const bool any = bit && (k0 <= klim) && (k0 + 63 >= kmin);
            if (__ballot(any) != 0ull) {
                const bool full = bit && (k0 + 63 <= klim) && (k0 >= kmin);
                const bool allfull = (__ballot(full) == ~0ull);
                const LAS unsigned char* kb = lds + AT_KOFF + cur * AT_KB + r * 144 + hi * 16;
                f32x16 p0, p1;
#pragma unroll
                for (int i = 0; i < 16; ++i) { p0[i] = 0.f; p1[i] = 0.f; }
#pragma unroll
                for (int ks = 0; ks < 4; ++ks) {
                    const bf16x8 ka = *(const LAS bf16x8*)(kb + ks * 32), kb2 = *(const LAS bf16x8*)(kb + 32 * 144 + ks * 32);
                    p0 = MFMA32(ka, qf[ks], p0); p1 = MFMA32(kb2, qf[ks], p1);
                }
                if (!allfull) {
#pragma unroll
                    for (int i = 0; i < 16; ++i) { const int key = k0 + (i & 3) + 8 * (i >> 2) + 4 * hi;
                        const bool ok0 = bit && (key <= klim) && (key >= kmin), ok1 = bit && (key + 32 <= klim) && (key + 32 >= kmin);
                        p0[i] = ok0 ? p0[i] : NEGBIG; p1[i] = ok1 ? p1[i] : NEGBIG; }
                }
                float mx = fmaxf(p0[0], p1[0]);
#pragma unroll
                for (int i = 1; i < 16; ++i) mx = fmaxf(mx, fmaxf(p0[i], p1[i]));
                mx = fmaxf(mx, __shfl_xor(mx, 32));
                const float mnew = fmaxf(m, mx);
                const float alpha = __builtin_amdgcn_exp2f(m - mnew);
                float ls = 0.f;
#pragma unroll
                for (int i = 0; i < 16; ++i) {
                    float e0 = __builtin_amdgcn_exp2f(p0[i] - mnew), e1 = __builtin_amdgcn_exp2f(p1[i] - mnew);
                    if (!allfull) { e0 = (p0[i] <= -5e29f) ? 0.f : e0; e1 = (p1[i] <= -5e29f) ? 0.f : e1; }
                    p0[i] = e0; p1[i] = e1; ls += e0 + e1;
                }
                l = l * alpha + ls; m = mnew;
#pragma unroll
                for (int d = 0; d < DVB; ++d) o[d] = o[d] * alpha;
                bf16x8 pb[2][2];
#pragma unroll
                for (int s2 = 0; s2 < 2; ++s2) {
                    u32x4 w0, w1;
                    w0.x = cvtpk_s(p0[8 * s2 + 0], p0[8 * s2 + 1]); w0.y = cvtpk_s(p0[8 * s2 + 2], p0[8 * s2 + 3]); w0.z = cvtpk_s(p0[8 * s2 + 4], p0[8 * s2 + 5]); w0.w = cvtpk_s(p0[8 * s2 + 6], p0[8 * s2 + 7]);
                    w1.x = cvtpk_s(p1[8 * s2 + 0], p1[8 * s2 + 1]); w1.y = cvtpk_s(p1[8 * s2 + 2], p1[8 * s2 + 3]); w1.z = cvtpk_s(p1[8 * s2 + 4], p1[8 * s2 + 5]); w1.w = cvtpk_s(p1[8 * s2 + 6], p1[8 * s2 + 7]);
                    pb[0][s2] = __builtin_bit_cast(bf16x8, w0); pb[1][s2] = __builtin_bit_cast(bf16x8, w1);
                }
                const LAS unsigned char* vb = lds + AT_VOFF + cur * AT_VB + r * 136 + hi * 8;
#pragma unroll
                for (int d = 0; d < DVB; ++d)
#pragma unroll
                    for (int kg = 0; kg < 2; ++kg)
#pragma unroll
                        for (int s2 = 0; s2 < 2; ++s2) {
                            const LAS unsigned char* vp = vb + d * 32 * 136 + (kg * 32 + s2 * 16) * 2;
                            const u32x2 lo = *(const LAS u32x2*)vp, h2 = *(const LAS u32x2*)(vp + 16);
                            const bf16x8 va = __builtin_bit_cast(bf16x8, (u32x4){lo.x, lo.y, h2.x, h2.y});
                            o[d] = MFMA32(va, pb[kg][s2], o[d]);
                        }
            }
        }
        if (jn >= 0) {
            const int nb = cur ^ 1;
            *(LAS u32x4*)(lds + AT_KOFF + nb * AT_KB + lrow * 144 + lch * 16) = kreg;
#pragma unroll
            for (int i = 0; i < DVB / 2; ++i) { LAS unsigned char* vp = lds + AT_VOFF + nb * AT_VB + (lrow + 64 * i) * 136 + lch * 16;
                *(LAS u32x2*)vp = (u32x2){vreg[i].x, vreg[i].y}; *(LAS u32x2*)(vp + 8) = (u32x2){vreg[i].z, vreg[i].w}; }
        }
        __syncthreads();
        if (jn < 0) break;
        j = jn; cur ^= 1;
    }
}
__device__ __forceinline__ u64 tile_range_mask(int lo, int hi) {
    const u64 up = (hi >= 63) ? ~0ull : ((1ull << (hi + 1)) - 1ull);
    return up & ~((1ull << lo) - 1ull);
}

__device__ __forceinline__ void ph_moba_kmean(const Params& p, LAS unsigned char* lds, int bx, int G) {
    const int tid = threadIdx.x, lane = tid & 63, w = tid >> 6;
    const bf16_t* P = (const bf16_t*)(p.ws + WS_P); float* kmean = (float*)(p.ws + WS_KMEAN);
    LAS float* red = (LAS float*)lds;
    for (int it = bx; it < NB * 8 * 16; it += G) {
        const int blk = it & 15, h = (it >> 4) & 7, b = it >> 7;
        const bf16_t* kp = P + (size_t)(b * SEQ + blk * 256 + w * 32) * PW + 512 + h * 64 + lane;
        float s = 0.f;
#pragma unroll 8
        for (int i = 0; i < 32; ++i) s += bf2f(kp[(size_t)i * PW]);
        red[w * 64 + lane] = s;
        __syncthreads();
        if (w == 0) { float t = 0.f;
#pragma unroll
            for (int i = 0; i < 8; ++i) t += red[i * 64 + lane];
            kmean[((b * 8 + h) * 16 + blk) * 64 + lane] = t * (1.f / 256.f); }
        __syncthreads();
    }
}
__device__ __forceinline__ void ph_attn_even(const Params& p, LAS unsigned char* lds, int bx, int G) {
    const int tid = threadIdx.x, lane = tid & 63, w = tid >> 6, r = lane & 31, hi = lane >> 5;
    const bf16_t* P = (const bf16_t*)(p.ws + WS_P); const bf16_t* VT = (const bf16_t*)(p.ws + WS_VT);
    const float* kmean = (const float*)(p.ws + WS_KMEAN);
    bf16_t* O = (bf16_t*)(p.ws + WS_O); float* DT = (float*)(p.ws + WS_DT);
    LAS float* kml = (LAS float*)(lds + AT_KM);
    for (int c = bx; c < 256; c += G) {
        const int bh = c & 31, qtp = c >> 5;
#pragma unroll 1
        for (int uu = 0; uu < 4; ++uu) {
            const int kind = uu >> 1, qt = (uu & 1) ? (15 - qtp) : qtp;
            const int b = bh >> 3, hh = bh & 7;
            const int qpos = qt * 256 + w * 32 + r;
            const size_t tok = (size_t)b * SEQ + qpos;
            if (kind == 0) {
                const bf16_t* qp = P + tok * PW + hh * 64 + hi * 8;
                bf16x8 qf[4];
#pragma unroll
                for (int ks = 0; ks < 4; ++ks) qf[ks] = *(const bf16x8*)(qp + ks * 16);
                __syncthreads();
                for (int i = tid; i < 1024; i += NTHR) kml[i] = kmean[(size_t)(b * 8 + hh) * 1024 + i];
                __syncthreads();
                const int own = qt;
                float g0 = NEGBIG, g1 = NEGBIG, g2 = NEGBIG; int i0 = -1, i1 = -1, i2 = -1;
                for (int blk = 0; blk < own; ++blk) {
                    float s = 0.f;
#pragma unroll
                    for (int ks = 0; ks < 4; ++ks)
#pragma unroll
                        for (int e = 0; e < 8; ++e) s += bf2f((bf16_t)qf[ks][e]) * kml[blk * 64 + ks * 16 + hi * 8 + e];
                    s += __shfl_xor(s, 32);
                    if (s > g0) { g2 = g1; i2 = i1; g1 = g0; i1 = i0; g0 = s; i0 = blk; }
                    else if (s > g1) { g2 = g1; i2 = i1; g1 = s; i1 = blk; }
                    else if (s > g2) { g2 = s; i2 = blk; }
                }
                u64 mk = 0xFull << (4 * own);
                if (i0 >= 0) mk |= 0xFull << (4 * i0);
                if (i1 >= 0) mk |= 0xFull << (4 * i1);
                if (i2 >= 0) mk |= 0xFull << (4 * i2);
                f32x16 o[2];
#pragma unroll
                for (int d = 0; d < 2; ++d)
#pragma unroll
                    for (int i = 0; i < 16; ++i) o[d][i] = 0.f;
                float m = NEGBIG, l = 0.f;
                attn_run<2>(lds, P + (size_t)b * SEQ * PW + 512 + hh * 64, PW, VT + (size_t)(hh * 64) * NT + (size_t)b * SEQ, NT,
                            tile_range_mask(0, 4 * qt + 3), mk, qpos, 0, qf, o, m, l);
                l += __shfl_xor(l, 32);
                const float il = l > 0.f ? 1.f / l : 0.f;
                bf16_t* op = O + tok * 1024 + hh * 64 + 4 * hi;
#pragma unroll
                for (int d = 0; d < 2; ++d)
#pragma unroll
                    for (int cc = 0; cc < 4; ++cc) {
                        u32x2 wv; wv.x = cvtpk_s(o[d][4 * cc] * il, o[d][4 * cc + 1] * il); wv.y = cvtpk_s(o[d][4 * cc + 2] * il, o[d][4 * cc + 3] * il);
                        *(u32x2*)(op + 32 * d + 8 * cc) = wv;
                    }
            } else {
                const bf16_t* qp = P + tok * PW + 1024 + hh * 64 + hi * 8;
                bf16x8 qf[4];
#pragma unroll
                for (int ks = 0; ks < 4; ++ks) qf[ks] = *(const bf16x8*)(qp + ks * 16);
                f32x16 o[4];
#pragma unroll
                for (int d = 0; d < 4; ++d)
#pragma unroll
                    for (int i = 0; i < 16; ++i) o[d][i] = 0.f;
                float m = NEGBIG, l = 0.f;
                attn_run<4>(lds, P + (size_t)b * SEQ * PW + 1536 + hh * 64, PW, VT + (size_t)(512 + (hh >> 1) * 128) * NT + (size_t)b * SEQ, NT,
                            tile_range_mask(0, 4 * qt + 3), ~0ull, qpos, 0, qf, o, m, l);
                l += __shfl_xor(l, 32);
                const float il = l > 0.f ? 1.f / l : 0.f;
                float* op = DT + tok * 1024 + hh * 128 + 4 * hi;
#pragma unroll
                for (int d = 0; d < 4; ++d)
#pragma unroll
                    for (int cc = 0; cc < 4; ++cc)
                        *(f32x4*)(op + 32 * d + 8 * cc) = (f32x4){o[d][4 * cc] * il, o[d][4 * cc + 1] * il, o[d][4 * cc + 2] * il, o[d][4 * cc + 3] * il};
            }
        }
    }
}
__device__ __forceinline__ void ph_diff_combine(const Params& p, int l, int bx, int G) {
    const int tid = threadIdx.x, lane = tid & 63, w = tid >> 6;
    const float* DT = (const float*)(p.ws + WS_DT); bf16_t* O = (bf16_t*)(p.ws + WS_O);
    const int li = l >> 1;
    const float lam = ((const float*)(p.ws + WS_MISC))[li], linit = li == 0 ? LINIT0 : LINIT1;
    const float* subg = p.in[10] + li * 128;
    const float sg0 = subg[lane], sg1 = subg[64 + lane];
    for (int it = bx * NWAVES + w; it < NT * 4; it += G * NWAVES) {
        const int t = it >> 2, hd = it & 3;
        const float* p0 = DT + (size_t)t * 1024 + (hd * 2) * 128, * p1 = p0 + 128;
        const float v0 = p0[lane] - lam * p1[lane], v1 = p0[64 + lane] - lam * p1[64 + lane];
        const float ss = wave_sum(v0 * v0 + v1 * v1);
        const float rs = rsqrtf(ss * (1.f / 128.f) + 1e-6f) * (1.f - linit);
        O[(size_t)t * 1024 + 512 + hd * 128 + lane] = f2bf(v0 * rs * sg0);
        O[(size_t)t * 1024 + 512 + hd * 128 + 64 + lane] = f2bf(v1 * rs * sg1);
    }
}


__device__ __forceinline__ void ph_misc(const Params& p, int bx, int G) {
    const int tid = threadIdx.x;
    float* misc = (float*)(p.ws + WS_MISC); float* fold = (float*)(p.ws + WS_FOLD);
    if (bx == 0 && tid < 64) {
        for (int i = 0; i < 2; ++i) { const float* lp = p.in[9] + i * 256;
            const float s1 = wave_sum(lp[tid] * lp[64 + tid]), s2 = wave_sum(lp[128 + tid] * lp[192 + tid]);
            if (tid == 0) misc[i] = expf(s1) - expf(s2) + (i == 0 ? LINIT0 : LINIT1); }
    }
    for (int o = bx * NTHR + tid; o < 1024; o += G * NTHR) {
        const int f = o & 255, lb = o >> 8;
        const float* pos = p.in[13] + (size_t)lb * 2048; const float* w1 = p.in[14] + (size_t)lb * 2048 * 256 + f;
        float s = p.in[15][lb * 256 + f];
        for (int i = 0; i < 2048; ++i) s += pos[i] * w1[(size_t)i * 256];
        fold[o] = s;
    }
}
struct CmpOrder {
    int G, c;
    __device__ bool next(int i, pg8::Unit& u) const { const int L = i * G + c; if (L >= 32) return false; u.pm = L; u.pn = L >> 4; return true; }
    __device__ size_t aoff(const pg8::Unit& u, size_t tstepA) const { const int br = u.pm >> 4, g = (u.pm >> 2) & 3, rt = u.pm & 3; return (size_t)rt * tstepA + (size_t)(((br ? 1792 : 1024) + g * 64) * 2); }
};
__device__ __forceinline__ float gelu_tanh_fast(float x) {
    const float y = 0.7978845608028654f * (x + 0.044715f * x * x * x);
    const float t = 1.f - 2.f * __builtin_amdgcn_rcpf(1.f + __expf(2.f * y));
    return 0.5f * x * (1.f + t);
}
struct EpiCmp1 {
    bf16_t* CH; const float* fold;
    __device__ __forceinline__ void operator()(const AccT& acc, const pg8::Unit& u, int wr, int wc, int fr, int fq) const {
        const int br = u.pm >> 4, g = (u.pm >> 2) & 3, rt = u.pm & 3;
        const int row0 = rt * 256 + wr * 64 + fr, col0 = wc * 32 + 8 * fq;
        bf16_t* base = CH + (size_t)(br * 4 + g) * 1024 * 256;
#pragma unroll
        for (int bj = 0; bj < 2; ++bj) {
            const f32x4 b0 = *(const f32x4*)(fold + br * 256 + col0 + bj * 128), b1 = *(const f32x4*)(fold + br * 256 + col0 + bj * 128 + 4);
#pragma unroll
            for (int ai = 0; ai < 2; ++ai)
#pragma unroll
                for (int m = 0; m < 4; ++m) {
                    const f32x4 v0 = acc[ai][bj][m][0] + b0, v1 = acc[ai][bj][m][1] + b1;
                    u32x4 w; w.x = cvt_pk_bf16(gelu_tanh_fast(v0[0]), gelu_tanh_fast(v0[1])); w.y = cvt_pk_bf16(gelu_tanh_fast(v0[2]), gelu_tanh_fast(v0[3]));
                    w.z = cvt_pk_bf16(gelu_tanh_fast(v1[0]), gelu_tanh_fast(v1[1])); w.w = cvt_pk_bf16(gelu_tanh_fast(v1[2]), gelu_tanh_fast(v1[3]));
                    *(u32x4*)(base + (size_t)(row0 + ai * 128 + m * 16) * 256 + col0 + bj * 128) = w;
                }
        }
    }
};
__device__ __forceinline__ void ph_compress1(const Params& p, LAS unsigned char* lds, int l, int bx, int G) {
    const int li = l >> 1;
    pg8::Gemm g{(const bf16_t*)(p.ws + WS_P), (const bf16_t*)(p.ws + WS_W1T) + (size_t)li * 2 * 256 * 2048, 2048, 16u * PW * 2u, PW * 2u};
    CmpOrder S{G, bx};
    EpiCmp1 E{(bf16_t*)(p.ws + WS_CH), (const float*)(p.ws + WS_FOLD) + li * 512};
    pg8::gemm_phase<EpiCmp1, CmpOrder>(lds, g, S, E);
}
__device__ __forceinline__ void ph_compress2(const Params& p, int l, int bx, int G) {
    const int tid = threadIdx.x, lane = tid & 63, w = tid >> 6, li = l >> 1;
    const bf16_t* CH = (const bf16_t*)(p.ws + WS_CH); bf16_t* KCMP = (bf16_t*)(p.ws + WS_KCMP); bf16_t* VCX = (bf16_t*)(p.ws + WS_VCX);
    for (int it = bx * NWAVES + w; it < 8192; it += G * NWAVES) {
        const int r = it & 1023, g = (it >> 10) & 3, br = it >> 12, b = r >> 8, n = r & 255;
        const bf16_t* hp = CH + (size_t)it * 256;
        const float* w2 = p.in[16] + (size_t)(li * 2 + br) * 256 * 64 + lane;
        float s = p.in[17][(li * 2 + br) * 64 + lane];
        for (int f = 0; f < 256; f += 8) {
            const u32x4 hv = *(const u32x4*)(hp + f);
            s += bf2f((bf16_t)(hv.x & 0xffff)) * w2[(f + 0) * 64] + bf2f((bf16_t)(hv.x >> 16)) * w2[(f + 1) * 64] + bf2f((bf16_t)(hv.y & 0xffff)) * w2[(f + 2) * 64] + bf2f((bf16_t)(hv.y >> 16)) * w2[(f + 3) * 64]
               + bf2f((bf16_t)(hv.z & 0xffff)) * w2[(f + 4) * 64] + bf2f((bf16_t)(hv.z >> 16)) * w2[(f + 5) * 64] + bf2f((bf16_t)(hv.w & 0xffff)) * w2[(f + 6) * 64] + bf2f((bf16_t)(hv.w >> 16)) * w2[(f + 7) * 64];
        }
        if (n == 255) s = 0.f;
        if (br == 0) KCMP[((size_t)(b * 4 + g) * 256 + n) * 64 + lane] = f2bf(s);
        else VCX[((size_t)(b * 4 + g) * 128 + lane) * 256 + n] = f2bf(s);
    }
    for (int i = bx * NTHR + tid; i < 16 * 64 * 256; i += G * NTHR) {
        const int n = i & 255, j = (i >> 8) & 63, bg = i >> 14;
        const bool ov = (n < 255) && (n >= 4 * j - 1) && (n <= 4 * j + 3);
        VCX[((size_t)bg * 128 + 64 + j) * 256 + n] = ov ? (bf16_t)0x3F80 : (bf16_t)0;
    }
}
__device__ __forceinline__ void ph_attn_odd(const Params& p, LAS unsigned char* lds, int bx, int G) {
    const int tid = threadIdx.x, lane = tid & 63, w = tid >> 6, r = lane & 31, hi = lane >> 5;
    const bf16_t* P = (const bf16_t*)(p.ws + WS_P); const bf16_t* VT = (const bf16_t*)(p.ws + WS_VT);
    const bf16_t* KCMP = (const bf16_t*)(p.ws + WS_KCMP); const bf16_t* VCX = (const bf16_t*)(p.ws + WS_VCX);
    bf16_t* O = (bf16_t*)(p.ws + WS_O);
    LAS float* imp = (LAS float*)(lds + AT_IMP);
    LAS u64* mks = (LAS u64*)(lds + AT_MASK);
    LAS u64* red = (LAS u64*)(lds + AT_RED);
    for (int c = bx; c < 256; c += G) {
        const int bg = c & 15, qp = c >> 4, b = bg >> 2, g = bg & 3;
#pragma unroll 1
        for (int uu = 0; uu < 4; ++uu) {
            const int qt = uu == 0 ? qp : (uu == 1 ? 31 - qp : (uu == 2 ? 32 + qp : 63 - qp));
            const int head = 4 * g + (w >> 1), qloc = (w & 1) * 32 + r, qpos = qt * 64 + qloc;
            const size_t tok = (size_t)b * SEQ + qpos;
            const bf16_t* qptr = P + tok * PW + head * 64 + hi * 8;
            bf16x8 qf[4];
#pragma unroll
            for (int ks = 0; ks < 4; ++ks) qf[ks] = *(const bf16x8*)(qptr + ks * 16);
            float gt[3];
#pragma unroll
            for (int j = 0; j < 3; ++j) { const float gl = bf2f(VT[(size_t)(512 + head * 3 + j) * NT + tok]); gt[j] = 1.f / (1.f + __expf(-gl)); }
            f32x16 acc[2];
            {
                f32x16 o4[4];
#pragma unroll
                for (int d = 0; d < 4; ++d)
#pragma unroll
                    for (int i = 0; i < 16; ++i) o4[d][i] = 0.f;
                float m = NEGBIG, l = 0.f;
                const int klim = qpos >= 31 ? ((qpos - 31) >> 4) : -1;
                attn_run<4>(lds, KCMP + (size_t)bg * 256 * 64, 64, VCX + (size_t)bg * 128 * 256, 256, tile_range_mask(0, (4 * qt + 2) >> 6), ~0ull, klim, 0, qf, o4, m, l);
                l += __shfl_xor(l, 32);
                const float il = l > 0.f ? 1.f / l : 0.f;
#pragma unroll
                for (int d = 0; d < 2; ++d) acc[d] = o4[d] * (gt[0] * il);
                LAS float* ip = imp + ((w >> 1) * 64 + qloc) * 65 + 4 * hi;
#pragma unroll
                for (int d = 0; d < 2; ++d)
#pragma unroll
                    for (int i = 0; i < 16; ++i) ip[32 * d + (i & 3) + 8 * (i >> 2)] = o4[2 + d][i] * il;
            }
            __syncthreads();
            if (w == 0) {
                LAS float* iq = imp + lane * 65;
                const int own = qt;
                for (int j = 0; j < 64; ++j) {
                    float v = iq[j] + iq[64 * 65 + j] + iq[2 * 64 * 65 + j] + iq[3 * 64 * 65 + j];
                    if (j > own) v = NEGBIG; else if (j == 0 || j == own || j == own - 1) v = 1e6f;
                    iq[j] = v;
                }
                u64 sel = 0ull;
#pragma unroll 1
                for (int k = 0; k < 16; ++k) {
                    int bi = 0; float bv = iq[0];
                    for (int j = 1; j < 64; ++j) { const float v = iq[j]; if (v > bv) { bv = v; bi = j; } }
                    sel |= 1ull << bi; iq[bi] = -3.4e38f;
                }
                mks[lane] = sel;
                unsigned lo = (unsigned)sel, hh = (unsigned)(sel >> 32);
#pragma unroll
                for (int off = 32; off >= 1; off >>= 1) { lo |= __shfl_xor(lo, off); hh |= __shfl_xor(hh, off); }
                if (lane == 0) red[0] = ((u64)hh << 32) | lo;
            }
            __syncthreads();
            const u64 mymask = mks[qloc];
            const u64 tm_sel = red[0] & tile_range_mask(0, qt);
#pragma unroll 1
            for (int br = 0; br < 2; ++br) {
                f32x16 o2[2];
#pragma unroll
                for (int d = 0; d < 2; ++d)
#pragma unroll
                    for (int i = 0; i < 16; ++i) o2[d][i] = 0.f;
                float m = NEGBIG, l = 0.f;
                const bf16_t* Kg = P + (size_t)b * SEQ * PW + (br == 0 ? 1280 : 1536) + g * 64;
                const bf16_t* Vg = VT + (size_t)((br == 0 ? 0 : 256) + g * 64) * NT + (size_t)b * SEQ;
                const u64 tm = br == 0 ? tm_sel : tile_range_mask(qt >= 8 ? qt - 8 : 0, qt);
                attn_run<2>(lds, Kg, PW, Vg, NT, tm, br == 0 ? mymask : ~0ull, qpos, br == 0 ? 0 : qpos - 511, qf, o2, m, l);
                l += __shfl_xor(l, 32);
                const float sc = (l > 0.f ? 1.f / l : 0.f) * (br == 0 ? gt[1] : gt[2]);
#pragma unroll
                for (int d = 0; d < 2; ++d) acc[d] = acc[d] + o2[d] * sc;
            }
            bf16_t* op = O + tok * 1024 + head * 64 + 4 * hi;
#pragma unroll
            for (int d = 0; d < 2; ++d)
#pragma unroll
                for (int cc = 0; cc < 4; ++cc) {
                    u32x2 wv; wv.x = cvtpk_s(acc[d][4 * cc], acc[d][4 * cc + 1]); wv.y = cvtpk_s(acc[d][4 * cc + 2], acc[d][4 * cc + 3]);
                    *(u32x2*)(op + 32 * d + 8 * cc) = wv;
                }
        }
    }
}


template <int MODE>
__device__ __forceinline__ void ph_norm(const Params& p, int l, int bx, int G) {
    const int tid = threadIdx.x, lane = tid & 63, w = tid >> 6;
    float* X = (float*)(p.ws + WS_X); bf16_t* H = (bf16_t*)(p.ws + WS_H);
    const float* mod = (const float*)(p.ws + WS_MOD);
    const bf16_t* Y = (const bf16_t*)(p.ws + WS_Y); const int* POS = (const int*)(p.ws + WS_POS);
    int* tok_e = (int*)(p.ws + WS_ROUTE); float* tok_w = (float*)(p.ws + WS_ROUTE + 131072); int* tok_rank = (int*)(p.ws + WS_ROUTE + 262144);
    unsigned* cnt = (unsigned*)(p.ws + WS_CTL) + CW_CNT + l * 16;
    const bool comb = (MODE == 2) || (MODE == 0 && l > 0);
    const int lc = (MODE == 2) ? DEPTH - 1 : l - 1;
    const float* xin = (MODE == 0 && l == 0) ? p.in[0] : X;
    const float* gsrc = (MODE == 0) ? p.in[2] + l * DM : (MODE == 1 ? p.in[3] + l * DM : p.in[4]);
    const int scc = (MODE == 0) ? 1 : 4, shc = (MODE == 0) ? 0 : 3;
    for (int t = bx * NWAVES + w; t < NT; t += G * NWAVES) {
        const int b = t / SEQ;
        const float* xr = xin + (size_t)t * DM;
        f32x4 xv[4]; float ss = 0.f;
        int p0 = 0, p1 = 0;
        if (comb) { p0 = POS[t * 2]; p1 = POS[t * 2 + 1]; }
#pragma unroll
        for (int i = 0; i < 4; ++i) {
            const int idx = i * 256 + lane * 4;
            xv[i] = *(const f32x4*)(xr + idx);
            if (comb) {
                const u32x2 ya = *(const u32x2*)(Y + (size_t)p0 * DM + idx), yb = *(const u32x2*)(Y + (size_t)p1 * DM + idx);
                const f32x4 g2 = *(const f32x4*)(mod + (size_t)(lc * 4 + b) * 6144 + 5 * 1024 + idx);
                f32x4 ys; ys[0] = bf2f((bf16_t)(ya.x & 0xffff)) + bf2f((bf16_t)(yb.x & 0xffff)); ys[1] = bf2f((bf16_t)(ya.x >> 16)) + bf2f((bf16_t)(yb.x >> 16));
                ys[2] = bf2f((bf16_t)(ya.y & 0xffff)) + bf2f((bf16_t)(yb.y & 0xffff)); ys[3] = bf2f((bf16_t)(ya.y >> 16)) + bf2f((bf16_t)(yb.y >> 16));
                xv[i] = xv[i] + g2 * ys;
                if (MODE == 0) *(f32x4*)(X + (size_t)t * DM + idx) = xv[i];
            }
            ss += xv[i][0] * xv[i][0] + xv[i][1] * xv[i][1] + xv[i][2] * xv[i][2] + xv[i][3] * xv[i][3];
        }
        ss = wave_sum(ss);
        const float rs = rsqrtf(ss * (1.f / DM) + 1e-6f);
        float hv[4][4];
#pragma unroll
        for (int i = 0; i < 4; ++i) {
            const int idx = i * 256 + lane * 4;
            const f32x4 gv = *(const f32x4*)(gsrc + idx);
            f32x4 y = xv[i] * rs * gv;
            if (MODE == 2) { *(f32x4*)(p.out + (size_t)t * DM + idx) = y; }
            else {
                const f32x4 sc = *(const f32x4*)(mod + (size_t)(l * 4 + b) * 6144 + scc * 1024 + idx), sh = *(const f32x4*)(mod + (size_t)(l * 4 + b) * 6144 + shc * 1024 + idx);
                y = y * (sc + 1.f) + sh;
                hv[i][0] = y[0]; hv[i][1] = y[1]; hv[i][2] = y[2]; hv[i][3] = y[3];
                u32x2 o; o.x = pk2(y[0], y[1]); o.y = pk2(y[2], y[3]);
                *(u32x2*)(H + (size_t)t * DM + idx) = o;
            }
        }
        if (MODE == 1) {
            const float* wg = p.in[18] + (size_t)l * 1024 * 4; const float* bg = p.in[19] + l * 4;
            const float* we = p.in[20] + (size_t)l * 1024 * 16; const float* be = p.in[21] + l * 16;
            float acc[20];
#pragma unroll
            for (int q = 0; q < 20; ++q) acc[q] = 0.f;
#pragma unroll
            for (int i = 0; i < 4; ++i)
#pragma unroll
                for (int e = 0; e < 4; ++e) {
                    const int idx = i * 256 + lane * 4 + e; const float h = hv[i][e];
                    const f32x4 a = *(const f32x4*)(wg + idx * 4);
                    acc[0] += h * a[0]; acc[1] += h * a[1]; acc[2] += h * a[2]; acc[3] += h * a[3];
#pragma unroll
                    for (int q = 0; q < 4; ++q) { const f32x4 w4 = *(const f32x4*)(we + idx * 16 + q * 4); acc[4 + q * 4] += h * w4[0]; acc[5 + q * 4] += h * w4[1]; acc[6 + q * 4] += h * w4[2]; acc[7 + q * 4] += h * w4[3]; }
                }
#pragma unroll
            for (int q = 0; q < 20; ++q) acc[q] = wave_sum(acc[q]);
            if (lane == 0) {
                float gl[4];
#pragma unroll
                for (int j = 0; j < 4; ++j) gl[j] = acc[j] + bg[j];
                int gs = 0; float gm = gl[0];
#pragma unroll
                for (int j = 1; j < 4; ++j) if (gl[j] > gm) { gm = gl[j]; gs = j; }
                float den = 0.f;
#pragma unroll
                for (int j = 0; j < 4; ++j) den += expf(gl[j] - gm);
                const float gw = 1.f / den;
                float el[4] = {0.f, 0.f, 0.f, 0.f};
#pragma unroll
                for (int gg = 0; gg < 4; ++gg)
#pragma unroll
                    for (int j = 0; j < 4; ++j) if (gs == gg) el[j] = acc[4 + gg * 4 + j] + be[gg * 4 + j];
                int i1 = 0; float v1 = el[0];
#pragma unroll
                for (int j = 1; j < 4; ++j) if (el[j] > v1) { v1 = el[j]; i1 = j; }
                int i2 = -1; float v2 = -3.0e38f;
#pragma unroll
                for (int j = 0; j < 4; ++j) if (j != i1 && el[j] > v2) { v2 = el[j]; i2 = j; }
                const float t1 = 1.f / (1.f + expf(v2 - v1)), t2 = 1.f - t1;
                const int e1 = gs * 4 + i1, e2 = gs * 4 + i2;
                tok_e[t * 2] = e1; tok_e[t * 2 + 1] = e2; tok_w[t * 2] = gw * t1; tok_w[t * 2 + 1] = gw * t2;
                tok_rank[t * 2] = (int)atomicAdd(cnt + e1, 1u); tok_rank[t * 2 + 1] = (int)atomicAdd(cnt + e2, 1u);
            }
        }
    }
}
__device__ __forceinline__ void ph_moe_permute(const Params& p, int l, int bx, int G) {
    const int tid = threadIdx.x, lane = tid & 63, w = tid >> 6;
    const unsigned* cnt = (const unsigned*)(p.ws + WS_CTL) + CW_CNT + l * 16;
    const int* tok_e = (const int*)(p.ws + WS_ROUTE); const float* tok_w = (const float*)(p.ws + WS_ROUTE + 131072); const int* tok_rank = (const int*)(p.ws + WS_ROUTE + 262144);
    int* POS = (int*)(p.ws + WS_POS); float* wperm = (float*)(p.ws + WS_WPERM); int* tilex = (int*)(p.ws + WS_TILEX);
    const bf16_t* H = (const bf16_t*)(p.ws + WS_H); bf16_t* AP = (bf16_t*)(p.ws + WS_APERM);
    int offs[17]; offs[0] = 0;
#pragma unroll
    for (int e = 0; e < 16; ++e) offs[e + 1] = offs[e] + (int)((cnt[e] + 255u) & ~255u);
    if (bx == 0 && tid == 0) {
        tilex[0] = offs[16] >> 8;
#pragma unroll
        for (int e = 0; e < 16; ++e) for (int rt = offs[e] >> 8; rt < (offs[e + 1] >> 8); ++rt) tilex[1 + rt] = e;
    }
    for (int it = bx * NWAVES + w; it < NT * 2; it += G * NWAVES) {
        const int e = tok_e[it], rank = tok_rank[it];
        int off = 0;
#pragma unroll
        for (int q = 0; q < 16; ++q) off = (e == q) ? offs[q] : off;
        const int pos = off + rank;
        const bf16_t* src = H + (size_t)(it >> 1) * DM + lane * 8; bf16_t* dst = AP + (size_t)pos * DM + lane * 8;
        const u32x4 a = *(const u32x4*)src, bq = *(const u32x4*)(src + 512);
        *(u32x4*)dst = a; *(u32x4*)(dst + 512) = bq;
        if (lane == 0) { POS[it] = pos; wperm[pos] = tok_w[it]; }
    }
}
struct MoeOrder {
    int G, c, nct; const int* tilex;
    __device__ bool next(int i, pg8::Unit& u) const {
        const int L = i * G + c, nt = tilex[0]; if (L >= nt * nct) return false;
        const int rt = L / nct, ct = L - rt * nct; u.pm = rt; u.pn = tilex[1 + rt] * nct + ct; return true;
    }
    __device__ size_t aoff(const pg8::Unit& u, size_t tstepA) const { return (size_t)u.pm * tstepA; }
};
struct EpiMoeH {
    bf16_t* HID; const float* wperm;
    __device__ __forceinline__ void operator()(const AccT& acc, const pg8::Unit& u, int wr, int wc, int fr, int fq) const {
        const int row0 = u.pm * 256 + wr * 64 + fr, f0 = (u.pn & 1) * 128 + wc * 16 + 4 * fq;
#pragma unroll
        for (int ai = 0; ai < 2; ++ai)
#pragma unroll
            for (int m = 0; m < 4; ++m) {
                const int row = row0 + ai * 128 + m * 16; const float wt = wperm[row];
#pragma unroll
                for (int bj = 0; bj < 2; ++bj) {
                    const f32x4 v0 = acc[ai][bj][m][0], v1 = acc[ai][bj][m][1];
                    const float h0 = v0[0] * __builtin_amdgcn_rcpf(1.f + __expf(-v0[0])) * v0[1] * wt, h1 = v0[2] * __builtin_amdgcn_rcpf(1.f + __expf(-v0[2])) * v0[3] * wt;
                    const float h2 = v1[0] * __builtin_amdgcn_rcpf(1.f + __expf(-v1[0])) * v1[1] * wt, h3 = v1[2] * __builtin_amdgcn_rcpf(1.f + __expf(-v1[2])) * v1[3] * wt;
                    u32x2 o; o.x = cvt_pk_bf16(h0, h1); o.y = cvt_pk_bf16(h2, h3);
                    *(u32x2*)(HID + (size_t)row * 256 + f0 + bj * 64) = o;
                }
            }
    }
};
__device__ __forceinline__ void ph_moe_gemm1(const Params& p, LAS unsigned char* lds, int bx, int G) {
    pg8::Gemm g{(const bf16_t*)(p.ws + WS_APERM), (const bf16_t*)(p.ws + WS_WGU), 1024, 2048u, 128u};
    MoeOrder S{G, bx, 2, (const int*)(p.ws + WS_TILEX)};
    EpiMoeH E{(bf16_t*)(p.ws + WS_HIDP), (const float*)(p.ws + WS_WPERM)};
    pg8::gemm_phase<EpiMoeH, MoeOrder>(lds, g, S, E);
}
__device__ __forceinline__ void ph_moe_gemm2(const Params& p, LAS unsigned char* lds, int bx, int G) {
    pg8::Gemm g{(const bf16_t*)(p.ws + WS_HIDP), (const bf16_t*)(p.ws + WS_WD), 256, 512u, 128u};
    MoeOrder S{G, bx, 4, (const int*)(p.ws + WS_TILEX)};
    EpiBf16 E{(bf16_t*)(p.ws + WS_Y), 1024, 3};
    pg8::gemm_phase<EpiBf16, MoeOrder>(lds, g, S, E);
}

__global__ void __launch_bounds__(NTHR, 2) kw_conv_static(Params p) { extern __shared__ __attribute__((aligned(16))) unsigned char lds[]; ph_conv_static(p, (LAS unsigned char*)lds, blockIdx.x, gridDim.x); }
__global__ void __launch_bounds__(NTHR, 2) kw_conv_moe(Params p, int l) { extern __shared__ __attribute__((aligned(16))) unsigned char lds[]; ph_conv_moe(p, (LAS unsigned char*)lds, l, blockIdx.x, gridDim.x); }
__global__ void __launch_bounds__(NTHR, 2) kw_inproj(Params p, int l) { extern __shared__ __attribute__((aligned(16))) unsigned char lds[]; ph_inproj(p, (LAS unsigned char*)lds, l, blockIdx.x, gridDim.x); }
__global__ void __launch_bounds__(NTHR, 2) kw_kmean(Params p) { extern __shared__ __attribute__((aligned(16))) unsigned char lds[]; ph_moba_kmean(p, (LAS unsigned char*)lds, blockIdx.x, gridDim.x); }
__global__ void __launch_bounds__(NTHR, 2) kw_attn_even(Params p) { extern __shared__ __attribute__((aligned(16))) unsigned char lds[]; ph_attn_even(p, (LAS unsigned char*)lds, blockIdx.x, gridDim.x); }
__global__ void __launch_bounds__(NTHR, 2) kw_diff_combine(Params p, int l) { ph_diff_combine(p, l, blockIdx.x, gridDim.x); }
__global__ void __launch_bounds__(NTHR, 2) kw_misc(Params p) { ph_misc(p, blockIdx.x, gridDim.x); }
__global__ void __launch_bounds__(NTHR, 2) kw_compress1(Params p, int l) { extern __shared__ __attribute__((aligned(16))) unsigned char lds[]; ph_compress1(p, (LAS unsigned char*)lds, l, blockIdx.x, gridDim.x); }
__global__ void __launch_bounds__(NTHR, 2) kw_compress2(Params p, int l) { ph_compress2(p, l, blockIdx.x, gridDim.x); }
__global__ void __launch_bounds__(NTHR, 2) kw_attn_odd(Params p) { extern __shared__ __attribute__((aligned(16))) unsigned char lds[]; ph_attn_odd(p, (LAS unsigned char*)lds, blockIdx.x, gridDim.x); }
__global__ void __launch_bounds__(NTHR, 2) kw_norm0(Params p, int l) { ph_norm<0>(p, l, blockIdx.x, gridDim.x); }
__global__ void __launch_bounds__(NTHR, 2) kw_norm1(Params p, int l) { ph_norm<1>(p, l, blockIdx.x, gridDim.x); }
__global__ void __launch_bounds__(NTHR, 2) kw_norm2(Params p) { ph_norm<2>(p, 0, blockIdx.x, gridDim.x); }
__global__ void __launch_bounds__(NTHR, 2) kw_permute(Params p, int l) { ph_moe_permute(p, l, blockIdx.x, gridDim.x); }
__global__ void __launch_bounds__(NTHR, 2) kw_moe1(Params p) { extern __shared__ __attribute__((aligned(16))) unsigned char lds[]; ph_moe_gemm1(p, (LAS unsigned char*)lds, blockIdx.x, gridDim.x); }
__global__ void __launch_bounds__(NTHR, 2) kw_moe2(Params p) { extern __shared__ __attribute__((aligned(16))) unsigned char lds[]; ph_moe_gemm2(p, (LAS unsigned char*)lds, blockIdx.x, gridDim.x); }
__global__ void __launch_bounds__(NTHR, 2) kw_outproj(Params p, int l) { extern __shared__ __attribute__((aligned(16))) unsigned char lds[]; ph_outproj(p, (LAS unsigned char*)lds, l, blockIdx.x, gridDim.x); }

static ColMap mk_map(int nsec, const int (*s)[3]) { ColMap c; memset(&c, 0, sizeof(c)); c.nsec = nsec; for (int i = 0; i < 8; ++i) { c.out0[i] = c.src0[i] = c.len[i] = 0; } for (int i = 0; i < nsec; ++i) { c.out0[i] = s[i][0]; c.src0[i] = s[i][1]; c.len[i] = s[i][2]; } return c; }

extern "C" void kernel_launch(void* const* d_in, const int* in_sizes, int n_in, void* d_out, int out_size, void* d_ws, size_t ws_size, hipStream_t stream) {
    if (ws_size < WS_END2) { fprintf(stderr, "workspace too small: %zu < %zu\n", ws_size, (size_t)WS_END2); return; }
    const float* x = (const float*)d_in[0]; const float* c = (const float*)d_in[1];
    const float* norm1_g = (const float*)d_in[2]; const float* norm2_g = (const float*)d_in[3]; const float* final_g = (const float*)d_in[4];
    const float* ada_w = (const float*)d_in[5]; const float* ada_b = (const float*)d_in[6];
    const float* ev_w_in = (const float*)d_in[7]; const float* ev_w_out = (const float*)d_in[8]; const float* ev_lambda = (const float*)d_in[9]; const float* ev_subln = (const float*)d_in[10];
    const float* od_w_in = (const float*)d_in[11]; const float* od_w_out = (const float*)d_in[12]; const float* od_pos = (const float*)d_in[13];
    const float* od_w1 = (const float*)d_in[14]; const float* od_b1 = (const float*)d_in[15]; const float* od_w2 = (const float*)d_in[16]; const float* od_b2 = (const float*)d_in[17];
    const float* moe_wg = (const float*)d_in[18]; const float* moe_bg = (const float*)d_in[19]; const float* moe_we = (const float*)d_in[20]; const float* moe_be = (const float*)d_in[21];
    const float* moe_wgate = (const float*)d_in[22]; const float* moe_wup = (const float*)d_in[23]; const float* moe_wdown = (const float*)d_in[24];
    unsigned char* ws = (unsigned char*)d_ws;
    unsigned* ctl = (unsigned*)(ws + WS_CTL); float* mod = (float*)(ws + WS_MOD); float* rope = (float*)(ws + WS_ROPE); float* misc = (float*)(ws + WS_MISC);
    float* kmean = (float*)(ws + WS_KMEAN); u64* mmask = (u64*)(ws + WS_MMASK); u64* smask = (u64*)(ws + WS_SMASK);
    bf16_t* KCMP = (bf16_t*)(ws + WS_KCMP); bf16_t* VCMPT = (bf16_t*)(ws + WS_VCMPT); bf16_t* CH = (bf16_t*)(ws + WS_CH);
    int* tok_e = (int*)(ws + WS_ROUTE); float* tok_w = (float*)(ws + WS_ROUTE + 131072); int* tok_rank = (int*)(ws + WS_ROUTE + 262144);
    float* X = (float*)(ws + WS_X); bf16_t* H = (bf16_t*)(ws + WS_H); bf16_t* P = (bf16_t*)(ws + WS_P); bf16_t* VT = (bf16_t*)(ws + WS_VT);
    bf16_t* O = (bf16_t*)(ws + WS_O); float* DT = (float*)(ws + WS_DT); float* PF = (float*)(ws + WS_PF);
    float* HID = (float*)(ws + WS_P);

    Params prm; memset(&prm, 0, sizeof(prm)); for (int i = 0; i < 25; ++i) prm.in[i] = (const float*)d_in[i]; prm.out = (float*)d_out; prm.ws = ws;
    static int attr_done = 0;
    if (!attr_done) { attr_done = 1;
        (void)hipFuncSetAttribute((const void*)kw_conv_static, hipFuncAttributeMaxDynamicSharedMemorySize, LDS_BYTES);
        (void)hipFuncSetAttribute((const void*)kw_conv_moe, hipFuncAttributeMaxDynamicSharedMemorySize, LDS_BYTES);
        (void)hipFuncSetAttribute((const void*)kw_inproj, hipFuncAttributeMaxDynamicSharedMemorySize, LDS_BYTES);
        (void)hipFuncSetAttribute((const void*)kw_outproj, hipFuncAttributeMaxDynamicSharedMemorySize, LDS_BYTES);
        (void)hipFuncSetAttribute((const void*)kw_kmean, hipFuncAttributeMaxDynamicSharedMemorySize, LDS_BYTES);
        (void)hipFuncSetAttribute((const void*)kw_moe1, hipFuncAttributeMaxDynamicSharedMemorySize, LDS_BYTES);
        (void)hipFuncSetAttribute((const void*)kw_moe2, hipFuncAttributeMaxDynamicSharedMemorySize, LDS_BYTES);
        (void)hipFuncSetAttribute((const void*)kw_compress1, hipFuncAttributeMaxDynamicSharedMemorySize, LDS_BYTES);
        (void)hipFuncSetAttribute((const void*)kw_attn_odd, hipFuncAttributeMaxDynamicSharedMemorySize, LDS_BYTES);
        (void)hipFuncSetAttribute((const void*)kw_attn_even, hipFuncAttributeMaxDynamicSharedMemorySize, LDS_BYTES);
    }
    const int GRID = 256;
    (void)hipMemsetAsync(ctl, 0, 1 * MiB, stream);
    kw_conv_static<<<GRID, NTHR, LDS_BYTES, stream>>>(prm);
    k_mod<<<dim3(24, 4), 256, 0, stream>>>(c, ada_w, ada_b, mod);
    k_rope<<<128, 256, 0, stream>>>(rope);
    kw_misc<<<GRID, NTHR, 0, stream>>>(prm);

    for (int l = 0; l < DEPTH; ++l) {
        const float* modl = mod + (size_t)l * 4 * 6144;
        const float* xin = (l == 0) ? x : X;
        const int li = l >> 1;
        kw_norm0<<<GRID, NTHR, 0, stream>>>(prm, l);
        kw_conv_moe<<<GRID, NTHR, LDS_BYTES, stream>>>(prm, l);
        if ((l & 1) == 0) {
            const float* w_in = ev_w_in + (size_t)li * 1024 * 3072;
            kw_inproj<<<GRID, NTHR, LDS_BYTES, stream>>>(prm, l);
            kw_kmean<<<GRID, NTHR, LDS_BYTES, stream>>>(prm);
            kw_attn_even<<<GRID, NTHR, LDS_BYTES, stream>>>(prm);
            kw_diff_combine<<<GRID, NTHR, 0, stream>>>(prm, l);
            kw_outproj<<<GRID, NTHR, LDS_BYTES, stream>>>(prm, l);
        } else {
            const float* w_in = od_w_in + (size_t)li * 1024 * 2608;
            kw_inproj<<<GRID, NTHR, LDS_BYTES, stream>>>(prm, l);
            kw_compress1<<<GRID, NTHR, LDS_BYTES, stream>>>(prm, l);
            kw_compress2<<<GRID, NTHR, 0, stream>>>(prm, l);
            kw_attn_odd<<<GRID, NTHR, LDS_BYTES, stream>>>(prm);
            kw_outproj<<<GRID, NTHR, LDS_BYTES, stream>>>(prm, l);
        }
        kw_norm1<<<GRID, NTHR, 0, stream>>>(prm, l);
        kw_permute<<<GRID, NTHR, 0, stream>>>(prm, l);
        kw_moe1<<<GRID, NTHR, LDS_BYTES, stream>>>(prm);
        kw_moe2<<<GRID, NTHR, LDS_BYTES, stream>>>(prm);
    }
    kw_norm2<<<GRID, NTHR, 0, stream>>>(prm);
}
```

```cpp
#include <hip/hip_runtime.h>
#include <stdint.h>
#include <stdio.h>
#include <string.h>

typedef unsigned short bf16_t;
typedef unsigned long long u64;

constexpr int NB = 4, SEQ = 4096, DM = 1024, NT = NB * SEQ, DEPTH = 4;
constexpr int PW = 2048;
constexpr float C2 = 0.125f * 1.4426950408889634f;
constexpr float NEGBIG = -1e30f;
constexpr float LINIT0 = 0.2f, LINIT1 = 0.47071301834358416f;

constexpr size_t MiB = 1u << 20;
constexpr size_t WS_CTL = 0;
constexpr size_t WS_MOD = 1 * MiB;
constexpr size_t WS_ROPE = 2 * MiB;
constexpr size_t WS_MISC = 3 * MiB;
constexpr size_t WS_KMEAN = 3 * MiB + 65536;
constexpr size_t WS_MMASK = 4 * MiB;
constexpr size_t WS_SMASK = 5 * MiB;
constexpr size_t WS_KCMP = 6 * MiB;
constexpr size_t WS_VCMPT = 6 * MiB + 524288;
constexpr size_t WS_CH = 7 * MiB;
constexpr size_t WS_ROUTE = 11 * MiB;
constexpr size_t WS_X = 16 * MiB;
constexpr size_t WS_H = 80 * MiB;
constexpr size_t WS_R = 112 * MiB;
constexpr size_t WS_P = WS_R;
constexpr size_t WS_VT = WS_R + 64 * MiB;
constexpr size_t WS_O = WS_R + 96 * MiB;
constexpr size_t WS_DT = WS_R + 128 * MiB;
constexpr size_t WS_PF = WS_R + 64 * MiB;
constexpr size_t WS_END = 304 * MiB;

constexpr int CW_CNT = 64;

__device__ __forceinline__ bf16_t f2bf(float f) { unsigned u = __float_as_uint(f); u = (u + 0x7fffu + ((u >> 16) & 1u)) >> 16; return (bf16_t)u; }
__device__ __forceinline__ float bf2f(bf16_t h) { return __uint_as_float(((unsigned)h) << 16); }
__device__ __forceinline__ float wave_sum(float v) {
#pragma unroll
    for (int o = 32; o >= 1; o >>= 1) v += __shfl_xor(v, o);
    return v;
}

__global__ void k_mod(const float* __restrict__ c, const float* __restrict__ ada_w, const float* __restrict__ ada_b, float* __restrict__ mod) {
    __shared__ float cs[4][1024];
    for (int i = threadIdx.x; i < 4096; i += 256) { float v = c[i]; cs[i >> 10][i & 1023] = v / (1.f + expf(-v)); }
    __syncthreads();
    const int j = blockIdx.x * 256 + threadIdx.x, l = blockIdx.y;
    const float* w = ada_w + (size_t)l * 1024 * 6144 + j;
    float a0 = 0.f, a1 = 0.f, a2 = 0.f, a3 = 0.f;
#pragma unroll 8
    for (int i = 0; i < 1024; ++i) { const float wv = w[(size_t)i * 6144]; a0 += cs[0][i] * wv; a1 += cs[1][i] * wv; a2 += cs[2][i] * wv; a3 += cs[3][i] * wv; }
    const float bb = ada_b[l * 6144 + j];
    mod[(l * 4 + 0) * 6144 + j] = a0 + bb; mod[(l * 4 + 1) * 6144 + j] = a1 + bb; mod[(l * 4 + 2) * 6144 + j] = a2 + bb; mod[(l * 4 + 3) * 6144 + j] = a3 + bb;
}

__global__ void k_rope(float* __restrict__ tab) {
    const int i = blockIdx.x * 256 + threadIdx.x;
    if (i < SEQ * 8) {
        const int pos = i >> 3, j = i & 7;
        const float inv = (float)pow(500000.0, -(double)j / 8.0);
        const float ang = (float)pos * inv;
        tab[i] = (float)cos((double)ang); tab[SEQ * 8 + i] = (float)sin((double)ang);
    }
}

__global__ void k_misc(const float* __restrict__ ev_lambda, float* __restrict__ misc) {
    const int lane = threadIdx.x;
    for (int i = 0; i < 2; ++i) {
        const float* lp = ev_lambda + i * 256;
        const float s1 = wave_sum(lp[lane] * lp[64 + lane]), s2 = wave_sum(lp[128 + lane] * lp[192 + lane]);
        if (lane == 0) misc[i] = expf(s1) - expf(s2) + (i == 0 ? LINIT0 : LINIT1);
    }
}

template <int MODE>
__global__ void __launch_bounds__(256) k_norm(const float* __restrict__ xin, const float* __restrict__ g, const float* __restrict__ modl, int sc_chunk, int sh_chunk,
                                              bf16_t* __restrict__ H, float* __restrict__ outf,
                                              const float* __restrict__ wg, const float* __restrict__ bg, const float* __restrict__ we, const float* __restrict__ be,
                                              int* __restrict__ tok_e, float* __restrict__ tok_w, int* __restrict__ tok_rank, unsigned* __restrict__ cnt) {
    const int lane = threadIdx.x & 63, t = blockIdx.x * 4 + (threadIdx.x >> 6), b = t / SEQ;
    const float* xr = xin + (size_t)t * DM;
    float4 xv[4]; float ss = 0.f;
#pragma unroll
    for (int i = 0; i < 4; ++i) { xv[i] = *(const float4*)(xr + i * 256 + lane * 4); ss += xv[i].x * xv[i].x + xv[i].y * xv[i].y + xv[i].z * xv[i].z + xv[i].w * xv[i].w; }
    ss = wave_sum(ss);
    const float rs = rsqrtf(ss * (1.f / DM) + 1e-6f);
    float hv[4][4];
#pragma unroll
    for (int i = 0; i < 4; ++i) {
        const int idx = i * 256 + lane * 4;
        const float4 gv = *(const float4*)(g + idx);
        float y0 = xv[i].x * rs * gv.x, y1 = xv[i].y * rs * gv.y, y2 = xv[i].z * rs * gv.z, y3 = xv[i].w * rs * gv.w;
        if (MODE == 2) { *(float4*)(outf + (size_t)t * DM + idx) = make_float4(y0, y1, y2, y3); }
        else {
            const float4 sc = *(const float4*)(modl + b * 6144 + sc_chunk * 1024 + idx), sh = *(const float4*)(modl + b * 6144 + sh_chunk * 1024 + idx);
            y0 = y0 * (1.f + sc.x) + sh.x; y1 = y1 * (1.f + sc.y) + sh.y; y2 = y2 * (1.f + sc.z) + sh.z; y3 = y3 * (1.f + sc.w) + sh.w;
            hv[i][0] = y0; hv[i][1] = y1; hv[i][2] = y2; hv[i][3] = y3;
            ushort4 o; o.x = f2bf(y0); o.y = f2bf(y1); o.z = f2bf(y2); o.w = f2bf(y3);
            *(ushort4*)(H + (size_t)t * DM + idx) = o;
        }
    }
    if (MODE == 1) {
        float acc[20];
#pragma unroll
        for (int q = 0; q < 20; ++q) acc[q] = 0.f;
#pragma unroll
        for (int i = 0; i < 4; ++i)
#pragma unroll
            for (int e = 0; e < 4; ++e) {
                const int idx = i * 256 + lane * 4 + e; const float h = hv[i][e];
                const float4 a = *(const float4*)(wg + idx * 4);
                acc[0] += h * a.x; acc[1] += h * a.y; acc[2] += h * a.z; acc[3] += h * a.w;
#pragma unroll
                for (int q = 0; q < 4; ++q) { const float4 w4 = *(const float4*)(we + idx * 16 + q * 4); acc[4 + q * 4] += h * w4.x; acc[5 + q * 4] += h * w4.y; acc[6 + q * 4] += h * w4.z; acc[7 + q * 4] += h * w4.w; }
            }
#pragma unroll
        for (int q = 0; q < 20; ++q) acc[q] = wave_sum(acc[q]);
        if (lane == 0) {
            float gl[4];
#pragma unroll
            for (int j = 0; j < 4; ++j) gl[j] = acc[j] + bg[j];
            int gs = 0; float gm = gl[0];
#pragma unroll
            for (int j = 1; j < 4; ++j) if (gl[j] > gm) { gm = gl[j]; gs = j; }
            float den = 0.f;
#pragma unroll
            for (int j = 0; j < 4; ++j) den += expf(gl[j] - gm);
            const float gw = 1.f / den;
            float el[4] = {0.f, 0.f, 0.f, 0.f};
#pragma unroll
            for (int gg = 0; gg < 4; ++gg)
#pragma unroll
                for (int j = 0; j < 4; ++j) if (gs == gg) el[j] = acc[4 + gg * 4 + j] + be[gg * 4 + j];
            int i1 = 0; float v1 = el[0];
#pragma unroll
            for (int j = 1; j < 4; ++j) if (el[j] > v1) { v1 = el[j]; i1 = j; }
            int i2 = -1; float v2 = -3.0e38f;
#pragma unroll
            for (int j = 0; j < 4; ++j) if (j != i1 && el[j] > v2) { v2 = el[j]; i2 = j; }
            const float t1 = 1.f / (1.f + expf(v2 - v1)), t2 = 1.f - t1;
            const int e1 = gs * 4 + i1, e2 = gs * 4 + i2;
            tok_e[t * 2] = e1; tok_e[t * 2 + 1] = e2; tok_w[t * 2] = gw * t1; tok_w[t * 2 + 1] = gw * t2;
            tok_rank[t * 2] = (int)atomicAdd(cnt + e1, 1u); tok_rank[t * 2 + 1] = (int)atomicAdd(cnt + e2, 1u);
        }
    }
}

struct ColMap { int nsec; int out0[8]; int src0[8]; int len[8]; };
__device__ __forceinline__ int cm_src(const ColMap& cm, int n) {
    int r = -1;
#pragma unroll
    for (int s = 0; s < 8; ++s) if (s < cm.nsec && n >= cm.out0[s] && n < cm.out0[s] + cm.len[s]) r = cm.src0[s] + (n - cm.out0[s]);
    return r;
}
template <int EPI>
__global__ void __launch_bounds__(256) k_gemm_naive(const bf16_t* __restrict__ A, int lda, const float* __restrict__ W, int ldw, ColMap cm, int K,
                                                    float* __restrict__ C, int ldc, const float* __restrict__ xin, const float* __restrict__ modg) {
    __shared__ float As[16][68], Bs[16][68];
    const int tid = threadIdx.x, tx = tid & 15, ty = tid >> 4;
    const int m0 = blockIdx.y * 64, n0 = blockIdx.x * 64;
    const int ar = tid >> 2, ak = (tid & 3) * 4;
    const int bk = tid >> 4, bn = (tid & 15) * 4;
    int sc[4];
#pragma unroll
    for (int j = 0; j < 4; ++j) sc[j] = cm_src(cm, n0 + bn + j);
    float acc[4][4];
#pragma unroll
    for (int i = 0; i < 4; ++i)
#pragma unroll
        for (int j = 0; j < 4; ++j) acc[i][j] = 0.f;
    for (int k0 = 0; k0 < K; k0 += 16) {
        const ushort4 av = *(const ushort4*)(A + (size_t)(m0 + ar) * lda + k0 + ak);
        As[ak + 0][ar] = bf2f(av.x); As[ak + 1][ar] = bf2f(av.y); As[ak + 2][ar] = bf2f(av.z); As[ak + 3][ar] = bf2f(av.w);
#pragma unroll
        for (int j = 0; j < 4; ++j) Bs[bk][bn + j] = sc[j] >= 0 ? W[(size_t)(k0 + bk) * ldw + sc[j]] : 0.f;
        __syncthreads();
#pragma unroll
        for (int k = 0; k < 16; ++k) {
            float a[4], bb[4];
#pragma unroll
            for (int i = 0; i < 4; ++i) a[i] = As[k][ty * 4 + i];
#pragma unroll
            for (int j = 0; j < 4; ++j) bb[j] = Bs[k][tx * 4 + j];
#pragma unroll
            for (int i = 0; i < 4; ++i)
#pragma unroll
                for (int j = 0; j < 4; ++j) acc[i][j] += a[i] * bb[j];
        }
        __syncthreads();
    }
#pragma unroll
    for (int i = 0; i < 4; ++i) {
        const int m = m0 + ty * 4 + i;
#pragma unroll
        for (int j = 0; j < 4; ++j) {
            const int n = n0 + tx * 4 + j;
            if (EPI == 0) C[(size_t)m * ldc + n] = acc[i][j];
            else C[(size_t)m * ldc + n] = xin[(size_t)m * ldc + n] + modg[(m / SEQ) * 6144 + n] * acc[i][j];
        }
    }
}

__global__ void k_ropeconv(const float* __restrict__ PF, bf16_t* __restrict__ P, const float* __restrict__ rope, int rope_cols, int qa0, int qa1, int qb0, int qb1) {
    const size_t i = (size_t)blockIdx.x * 256 + threadIdx.x;
    const int t = (int)(i / PW), n = (int)(i % PW), d = n & 63, pos = t % SEQ;
    float v = PF[i];
    if (n < rope_cols && d < 16) {
        const int j = d & 7; const float c = rope[pos * 8 + j], s = rope[SEQ * 8 + pos * 8 + j];
        const float p = PF[d < 8 ? i + 8 : i - 8];
        v = d < 8 ? v * c - p * s : v * c + p * s;
    }
    if ((n >= qa0 && n < qa1) || (n >= qb0 && n < qb1)) v *= C2;
    P[i] = f2bf(v);
}
__global__ void k_vtconv(const float* __restrict__ PF, int ld, int nf, bf16_t* __restrict__ VT) {
    const size_t i = (size_t)blockIdx.x * 256 + threadIdx.x;
    const int f = (int)(i / NT), t = (int)(i % NT);
    if (f < nf) VT[i] = f2bf(PF[(size_t)t * ld + f]);
}

__global__ void k_moba_kmean(const bf16_t* __restrict__ P, float* __restrict__ kmean) {
    const int d = threadIdx.x, blk = blockIdx.x & 15, h = (blockIdx.x >> 4) & 7, b = blockIdx.x >> 7;
    const bf16_t* kp = P + (size_t)(b * SEQ + blk * 256) * PW + 512 + h * 64 + d;
    float s = 0.f;
    for (int i = 0; i < 256; ++i) s += bf2f(kp[(size_t)i * PW]);
    kmean[((b * 8 + h) * 16 + blk) * 64 + d] = s * (1.f / 256.f);
}
__global__ void k_moba_gate(const bf16_t* __restrict__ P, const float* __restrict__ kmean, u64* __restrict__ mmask) {
    const int i = blockIdx.x * 256 + threadIdx.x;
    const int t = i % SEQ, h = (i / SEQ) & 7, b = i / (SEQ * 8);
    const int own = t >> 8;
    const bf16_t* qp = P + (size_t)(b * SEQ + t) * PW + h * 64;
    float q[64];
#pragma unroll
    for (int d = 0; d < 64; ++d) q[d] = bf2f(qp[d]);
    const float* km = kmean + (size_t)(b * 8 + h) * 16 * 64;
    float g0 = NEGBIG, g1 = NEGBIG, g2 = NEGBIG; int i0 = -1, i1 = -1, i2 = -1;
    for (int blk = 0; blk < own; ++blk) {
        float s = 0.f;
#pragma unroll
        for (int d = 0; d < 64; ++d) s += q[d] * km[blk * 64 + d];
        if (s > g0) { g2 = g1; i2 = i1; g1 = g0; i1 = i0; g0 = s; i0 = blk; }
        else if (s > g1) { g2 = g1; i2 = i1; g1 = s; i1 = blk; }
        else if (s > g2) { g2 = s; i2 = blk; }
    }
    u64 m = 0xFull << (4 * own);
    if (i0 >= 0) m |= 0xFull << (4 * i0);
    if (i1 >= 0) m |= 0xFull << (4 * i1);
    if (i2 >= 0) m |= 0xFull << (4 * i2);
    mmask[i] = m;
}

struct AttnN {
    const bf16_t* Kb; int kpitch; int kcol0; int kdiv; size_t kbatch; size_t khead;
    const bf16_t* Vb; int vpitch; int vrow0; int vdiv; size_t vbatch; int dv; size_t vhead;
    const bf16_t* Q; int qcol0;
    const u64* mask; int mdiv; int nmh;
    int window; int cmp;
    int nheads; int nchunk;
    int outmode; bf16_t* Ob; float* Of; int opitch; int ocol0;
    const bf16_t* gate; int grow0; int gidx;
};
__global__ void __launch_bounds__(256) k_attn_naive(AttnN a) {
    const int i = blockIdx.x * 256 + threadIdx.x;
    const int t = i % SEQ; int r = i / SEQ; const int ch = r % a.nchunk; r /= a.nchunk; const int h = r % a.nheads, b = r / a.nheads;
    const bf16_t* qp = a.Q + (size_t)(b * SEQ + t) * PW + a.qcol0 + h * 64;
    float q[64];
#pragma unroll
    for (int d = 0; d < 64; ++d) q[d] = bf2f(qp[d]);
    const bf16_t* kb = a.Kb + (size_t)b * a.kbatch + (size_t)(h / a.kdiv) * a.khead + a.kcol0;
    const bf16_t* vb = a.Vb + (size_t)b * a.vbatch + (size_t)(h / a.vdiv) * a.vhead + (size_t)(a.vrow0 + ch * 32) * a.vpitch;
    const u64 mk = a.mask ? a.mask[(size_t)(b * a.nmh + h / a.mdiv) * SEQ + t] : ~0ull;
    int lo, hi;
    if (a.cmp) { lo = 0; hi = t >= 31 ? (t - 31) / 16 : -1; }
    else { lo = t - a.window + 1; if (lo < 0) lo = 0; hi = t; }
    float m = NEGBIG, l = 0.f, o[32];
#pragma unroll
    for (int e = 0; e < 32; ++e) o[e] = 0.f;
    for (int key = lo; key <= hi; ++key) {
        if (!a.cmp && !((mk >> (key >> 6)) & 1ull)) { key |= 63; continue; }
        const bf16_t* kp = kb + (size_t)key * a.kpitch;
        float s = 0.f;
#pragma unroll
        for (int d = 0; d < 64; ++d) s += q[d] * bf2f(kp[d]);
        if (s > m) { const float c = exp2f(m - s); l *= c;
#pragma unroll
            for (int e = 0; e < 32; ++e) o[e] *= c;
            m = s; }
        const float p = exp2f(s - m);
        l += p;
#pragma unroll
        for (int e = 0; e < 32; ++e) o[e] += p * bf2f(vb[(size_t)e * a.vpitch + key]);
    }
    const float il = l > 0.f ? 1.f / l : 0.f;
    float gt = 1.f;
    if (a.outmode >= 2) { const float gl = bf2f(a.gate[(size_t)(a.grow0 + h * 3 + a.gidx) * NT + b * SEQ + t]); gt = 1.f / (1.f + expf(-gl)); }
    const size_t ob = (size_t)(b * SEQ + t) * a.opitch + a.ocol0 + h * a.dv + ch * 32;
#pragma unroll
    for (int e = 0; e < 32; ++e) {
        const float v = o[e] * il;
        if (a.outmode == 0) a.Ob[ob + e] = f2bf(v);
        else if (a.outmode == 1) a.Of[ob + e] = v;
        else if (a.outmode == 2) a.Of[ob + e] += gt * v;
        else a.Of[ob + e] = gt * v;
    }
}

__global__ void __launch_bounds__(256) k_diff_combine(const float* __restrict__ DT, const float* __restrict__ misc, int li, const float* __restrict__ subg, bf16_t* __restrict__ O) {
    const int lane = threadIdx.x & 63, w = blockIdx.x * 4 + (threadIdx.x >> 6), t = w >> 2, hd = w & 3;
    const float lam = misc[li], linit = li == 0 ? LINIT0 : LINIT1;
    const float* p0 = DT + (size_t)t * 1024 + (hd * 2) * 128, * p1 = p0 + 128;
    const float v0 = p0[lane] - lam * p1[lane], v1 = p0[64 + lane] - lam * p1[64 + lane];
    const float ss = wave_sum(v0 * v0 + v1 * v1);
    const float rs = rsqrtf(ss * (1.f / 128.f) + 1e-6f) * (1.f - linit);
    O[(size_t)t * 1024 + 512 + hd * 128 + lane] = f2bf(v0 * rs * subg[lane]);
    O[(size_t)t * 1024 + 512 + hd * 128 + 64 + lane] = f2bf(v1 * rs * subg[64 + lane]);
}
__global__ void k_f32_to_bf16(const float* __restrict__ src, bf16_t* __restrict__ dst) {
    const size_t i = (size_t)blockIdx.x * 256 + threadIdx.x; dst[i] = f2bf(src[i]);
}

__device__ __forceinline__ float gelu_tanh(float x) { return 0.5f * x * (1.f + tanhf(0.7978845608028654f * (x + 0.044715f * x * x * x))); }
__global__ void __launch_bounds__(256) k_cmp1(const bf16_t* __restrict__ P, const float* __restrict__ pos, const float* __restrict__ w1, const float* __restrict__ b1, bf16_t* __restrict__ CH) {
    const int f = threadIdx.x, r = blockIdx.x & 1023, g = (blockIdx.x >> 10) & 3, br = blockIdx.x >> 12;
    const int n = r & 255;
    __shared__ float xs[2048];
    const int col = (br == 0 ? 1024 : 1792) + g * 64;
    const float* pe = pos + br * 2048;
    for (int i = threadIdx.x; i < 2048; i += 256) { const int l = i >> 6, d = i & 63; const int tok = 16 * r + l;
        xs[i] = (n < 255) ? bf2f(P[(size_t)tok * PW + col + d]) + pe[i] : 0.f; }
    __syncthreads();
    const float* w = w1 + (size_t)br * 2048 * 256 + f;
    float s = 0.f;
    for (int i = 0; i < 2048; ++i) s += xs[i] * w[(size_t)i * 256];
    s += b1[br * 256 + f];
    CH[((size_t)(br * 4 + g) * 1024 + r) * 256 + f] = f2bf(n < 255 ? gelu_tanh(s) : 0.f);
}
__global__ void __launch_bounds__(64) k_cmp2(const bf16_t* __restrict__ CH, const float* __restrict__ w2, const float* __restrict__ b2, bf16_t* __restrict__ KCMP, bf16_t* __restrict__ VCMPT) {
    const int e = threadIdx.x, r = blockIdx.x & 1023, g = (blockIdx.x >> 10) & 3, br = blockIdx.x >> 12;
    const int b = r >> 8, n = r & 255;
    const bf16_t* hp = CH + ((size_t)(br * 4 + g) * 1024 + r) * 256;
    const float* w = w2 + (size_t)br * 256 * 64 + e;
    float s = b2[br * 64 + e];
    for (int f = 0; f < 256; ++f) s += bf2f(hp[f]) * w[f * 64];
    if (n == 255) s = 0.f;
    if (br == 0) KCMP[((size_t)(b * 4 + g) * 256 + n) * 64 + e] = f2bf(s);
    else VCMPT[((size_t)(b * 4 + g) * 64 + e) * 256 + n] = f2bf(s);
}
__global__ void __launch_bounds__(64) k_nsa_select(const bf16_t* __restrict__ P, const bf16_t* __restrict__ KCMP, u64* __restrict__ smask) {
    __shared__ float imp[64][65];
    const int lane = threadIdx.x, i = blockIdx.x * 64 + lane;
    const int t = i % SEQ, g = (i / SEQ) & 3, b = i / (SEQ * 4);
    for (int j = 0; j < 64; ++j) imp[j][lane] = 0.f;
    const int nmax = t >= 31 ? (t - 31) / 16 : -1;
    const bf16_t* kb = KCMP + (size_t)(b * 4 + g) * 256 * 64;
    for (int r = 0; r < 4; ++r) {
        const bf16_t* qp = P + (size_t)(b * SEQ + t) * PW + (g * 4 + r) * 64;
        float q[64];
#pragma unroll
        for (int d = 0; d < 64; ++d) q[d] = bf2f(qp[d]);
        float m = NEGBIG, l = 0.f;
        for (int n = 0; n <= nmax; ++n) {
            float s = 0.f;
#pragma unroll
            for (int d = 0; d < 64; ++d) s += q[d] * bf2f(kb[n * 64 + d]);
            if (s > m) { l *= exp2f(m - s); m = s; }
            l += exp2f(s - m);
        }
        const float il = l > 0.f ? 1.f / l : 0.f;
        for (int n = 0; n <= nmax; ++n) {
            float s = 0.f;
#pragma unroll
            for (int d = 0; d < 64; ++d) s += q[d] * bf2f(kb[n * 64 + d]);
            const float p = exp2f(s - m) * il;
            imp[n >> 2][lane] += p;
            if ((n & 3) == 3 && (n >> 2) + 1 < 64) imp[(n >> 2) + 1][lane] += p;
        }
    }
    const int own = t >> 6;
    u64 sel = 0ull;
    for (int j = 0; j < 64; ++j) {
        float v = imp[j][lane];
        if (j > own) v = NEGBIG; else if (j == 0 || j == own || j == own - 1) v = 1e6f;
        imp[j][lane] = v;
    }
    for (int k = 0; k < 16; ++k) {
        int bi = -1; float bv = -3.0e38f;
        for (int j = 0; j < 64; ++j) { const float v = imp[j][lane]; if (v > bv) { bv = v; bi = j; } }
        sel |= 1ull << bi; imp[bi][lane] = -3.4e38f;
    }
    smask[i] = sel;
}

__global__ void __launch_bounds__(256) k_moe_hidden(const bf16_t* __restrict__ H, const int* __restrict__ tok_e, const float* __restrict__ tok_w,
                                                    const float* __restrict__ wgate, const float* __restrict__ wup, float* __restrict__ HID) {
    const int f = threadIdx.x, ts = blockIdx.x, t = ts >> 1;
    __shared__ float hs[1024];
    for (int i = f; i < 1024; i += 256) hs[i] = bf2f(H[(size_t)t * DM + i]);
    __syncthreads();
    const int e = tok_e[ts];
    const float* wg = wgate + (size_t)e * 1024 * 256 + f, * wu = wup + (size_t)e * 1024 * 256 + f;
    float sg = 0.f, su = 0.f;
#pragma unroll 4
    for (int k = 0; k < 1024; ++k) { const float h = hs[k]; sg += h * wg[(size_t)k * 256]; su += h * wu[(size_t)k * 256]; }
    HID[(size_t)ts * 256 + f] = sg / (1.f + expf(-sg)) * su * tok_w[ts];
}
__global__ void __launch_bounds__(256) k_moe_down(const float* __restrict__ HID, const int* __restrict__ tok_e, const float* __restrict__ wdown,
                                                  const float* __restrict__ modg, float* __restrict__ X) {
    const int t = blockIdx.x, b = t / SEQ;
    __shared__ float hs[512];
    for (int i = threadIdx.x; i < 512; i += 256) hs[i] = HID[(size_t)t * 512 + i];
    __syncthreads();
    float y[4] = {0.f, 0.f, 0.f, 0.f};
    for (int sl = 0; sl < 2; ++sl) {
        const int e = tok_e[t * 2 + sl];
        const float* w = wdown + (size_t)e * 256 * 1024 + threadIdx.x;
        for (int f = 0; f < 256; ++f) { const float h = hs[sl * 256 + f];
#pragma unroll
            for (int j = 0; j < 4; ++j) y[j] += h * w[(size_t)f * 1024 + j * 256]; }
    }
#pragma unroll
    for (int j = 0; j < 4; ++j) { const int d = threadIdx.x + j * 256; X[(size_t)t * DM + d] += modg[b * 6144 + d] * y[j]; }
}


#define LAS __attribute__((address_space(3)))
typedef short bf16x8 __attribute__((ext_vector_type(8)));
typedef float f32x4 __attribute__((ext_vector_type(4)));
typedef float f32x16 __attribute__((ext_vector_type(16)));
typedef unsigned u32x4 __attribute__((ext_vector_type(4)));
typedef unsigned u32x2 __attribute__((ext_vector_type(2)));

constexpr int NWAVES = 8, NTHR = 512;
constexpr int LDS_BYTES = 147456;
constexpr size_t WS_WIN = 304 * MiB;
constexpr size_t WS_WOUT = 328 * MiB;
constexpr size_t WS_W1T = 336 * MiB;
constexpr size_t WS_WGU = 340 * MiB;
constexpr size_t WS_WD = 356 * MiB;
constexpr size_t WS_END2 = 364 * MiB;
constexpr size_t WS_VCX = 12 * MiB;
constexpr size_t WS_FOLD = WS_MISC + 1024;
constexpr int MP_ROWS = 36864;
constexpr size_t WS_APERM = WS_R;
constexpr size_t WS_HIDP = WS_R + 72 * MiB;
constexpr size_t WS_Y = WS_R + 96 * MiB;
constexpr size_t WS_POS = WS_ROUTE + 393216;
constexpr size_t WS_WPERM = WS_ROUTE + 524288;
constexpr size_t WS_TILEX = WS_ROUTE + 786432;

struct Params { const float* in[25]; float* out; unsigned char* ws; };
__device__ __forceinline__ int otid() { int t = threadIdx.x; asm volatile("" : "+v"(t)); return t; }

__device__ __forceinline__ unsigned pk2(float lo, float hi) { return (unsigned)f2bf(lo) | ((unsigned)f2bf(hi) << 16); }
__device__ __forceinline__ unsigned cvt_pk_bf16(float lo, float hi) { unsigned r; asm volatile("v_cvt_pk_bf16_f32 %0, %1, %2" : "=v"(r) : "v"(lo), "v"(hi)); return r; }

__device__ __forceinline__ void conv_item(const float* W, int ldw, int col0, int nvalid, int K, bf16_t* WT, int row0, int rmul, LAS float* scr, int item, int nblk, int lane) {
    const int kb = item / nblk, nb = item % nblk, k0 = 64 * kb, n0 = 32 * nb;
    const int nn = n0 + (lane & 31);
#pragma unroll 8
    for (int i = 0; i < 32; ++i) { const int kk = 2 * i + (lane >> 5); scr[kk * 33 + (lane & 31)] = (nn < nvalid) ? W[(size_t)(k0 + kk) * ldw + col0 + nn] : 0.f; }
    asm volatile("s_waitcnt lgkmcnt(0)" ::: "memory");
    const int c = lane & 7;
#pragma unroll
    for (int j = 0; j < 4; ++j) { const int n = (lane >> 3) + 8 * j; const LAS float* s = scr + (8 * c) * 33 + n;
        u32x4 o; o.x = pk2(s[0 * 33], s[1 * 33]); o.y = pk2(s[2 * 33], s[3 * 33]); o.z = pk2(s[4 * 33], s[5 * 33]); o.w = pk2(s[6 * 33], s[7 * 33]);
        *(u32x4*)(WT + (size_t)(row0 + (n0 + n) * rmul) * K + k0 + 8 * c) = o; }
    asm volatile("s_waitcnt lgkmcnt(0)" ::: "memory");
}
struct ConvCtx { LAS float* scr; int gw, NGW, lane, base; };
__device__ __forceinline__ void conv_job(ConvCtx& cx, const float* W, int ldw, int col0, int ncols, int nvalid, int K, bf16_t* WT, int row0, int rmul) {
    const int nblk = ncols / 32, nitems = (K / 64) * nblk;
    int it = cx.gw - (cx.base % cx.NGW); if (it < 0) it += cx.NGW;
    for (; it < nitems; it += cx.NGW) conv_item(W, ldw, col0, nvalid, K, WT, row0, rmul, cx.scr, it, nblk, cx.lane);
    cx.base += nitems;
}
__device__ __forceinline__ void ph_conv_static(const Params& p, LAS unsigned char* lds, int vcu, int G) {
    const int tid = otid(), lane = tid & 63, wave = tid >> 6;
    ConvCtx cx; cx.scr = (LAS float*)(lds + wave * 16384); cx.gw = vcu * NWAVES + wave; cx.NGW = G * NWAVES; cx.lane = lane; cx.base = 0;
    for (int l = 0; l < DEPTH; ++l) {
        const int li = l >> 1;
        bf16_t* win = (bf16_t*)(p.ws + WS_WIN) + (size_t)l * 3072 * 1024;
        bf16_t* wout = (bf16_t*)(p.ws + WS_WOUT) + (size_t)l * 1024 * 1024;
        if ((l & 1) == 0) {
            const float* w = p.in[7] + (size_t)li * 1024 * 3072;
            conv_job(cx, w, 3072, 0, 512, 512, 1024, win, 0, 1);
            conv_job(cx, w, 3072, 512, 512, 512, 1024, win, 512, 1);
            conv_job(cx, w, 3072, 1536, 512, 512, 1024, win, 1024, 1);
            conv_job(cx, w, 3072, 2048, 512, 512, 1024, win, 1536, 1);
            conv_job(cx, w, 3072, 1024, 512, 512, 1024, win, 2048, 1);
            conv_job(cx, w, 3072, 2560, 512, 512, 1024, win, 2560, 1);
            conv_job(cx, p.in[8] + (size_t)li * 1024 * 1024, 1024, 0, 1024, 1024, 1024, wout, 0, 1);
        } else {
            const float* w = p.in[11] + (size_t)li * 1024 * 2608;
            conv_job(cx, w, 2608, 0, 1024, 1024, 1024, win, 0, 1);
            conv_job(cx, w, 2608, 1024, 256, 256, 1024, win, 1024, 1);
            conv_job(cx, w, 2608, 1536, 256, 256, 1024, win, 1280, 1);
            conv_job(cx, w, 2608, 2048, 256, 256, 1024, win, 1536, 1);
            conv_job(cx, w, 2608, 1280, 256, 256, 1024, win, 1792, 1);
            conv_job(cx, w, 2608, 1792, 256, 256, 1024, win, 2048, 1);
            conv_job(cx, w, 2608, 2304, 256, 256, 1024, win, 2304, 1);
            conv_job(cx, w, 2608, 2560, 256, 48, 1024, win, 2560, 1);
            conv_job(cx, p.in[12] + (size_t)li * 1024 * 1024, 1024, 0, 1024, 1024, 1024, wout, 0, 1);
            bf16_t* w1t = (bf16_t*)(p.ws + WS_W1T) + (size_t)li * 2 * 256 * 2048;
            conv_job(cx, p.in[14] + (size_t)(li * 2 + 0) * 2048 * 256, 256, 0, 256, 256, 2048, w1t, 0, 1);
            conv_job(cx, p.in[14] + (size_t)(li * 2 + 1) * 2048 * 256, 256, 0, 256, 256, 2048, w1t + (size_t)256 * 2048, 0, 1);
        }
    }
}
__device__ __forceinline__ void ph_conv_moe(const Params& p, LAS unsigned char* lds, int l, int vcu, int G) {
    const int tid = otid(), lane = tid & 63, wave = tid >> 6;
    ConvCtx cx; cx.scr = (LAS float*)(lds + wave * 16384); cx.gw = vcu * NWAVES + wave; cx.NGW = G * NWAVES; cx.lane = lane; cx.base = 0;
    bf16_t* wgu = (bf16_t*)(p.ws + WS_WGU); bf16_t* wd = (bf16_t*)(p.ws + WS_WD);
    for (int e = 0; e < 16; ++e) {
        conv_job(cx, p.in[22] + (size_t)(l * 16 + e) * 1024 * 256, 256, 0, 256, 256, 1024, wgu + (size_t)e * 512 * 1024, 0, 2);
        conv_job(cx, p.in[23] + (size_t)(l * 16 + e) * 1024 * 256, 256, 0, 256, 256, 1024, wgu + (size_t)e * 512 * 1024, 1, 2);
        conv_job(cx, p.in[24] + (size_t)(l * 16 + e) * 256 * 1024, 1024, 0, 1024, 1024, 256, wd + (size_t)e * 1024 * 256, 0, 1);
    }
}

namespace pg8 {
constexpr int BM = 256, BK = 64, HALF = 128, HTB = HALF * BK * 2, STAGE_BYTES = 8 * HTB, NXCD = 8, WGM = 8;
__host__ __device__ __forceinline__ int lds_byte(int r, int c) { const int st = (r >> 4) * 2 + (c >> 5), rr = r & 15, cc = c & 31, ob = rr * 64 + cc * 2; return st * 1024 + (ob ^ (((ob >> 9) & 1) << 5)); }
__host__ __device__ __forceinline__ void stage_rc(int b, int& R, int& C) { const int st = b / 1024, sb = b % 1024, swz = sb ^ (((sb >> 9) & 1) << 5); R = (st >> 1) * 16 + swz / 64; C = (st & 1) * 32 + (swz % 64) / 2; }
__host__ __device__ __forceinline__ int perm32(int rho) { const int n = rho >> 4, i = rho & 15; return 8 * (i >> 2) + 4 * n + (i & 3); }
struct Unit { int pm, pn; };
struct Gemm { const bf16_t* A; const bf16_t* Bt; int K; unsigned lda_b; unsigned kstepA; };
struct StaticOrder {
    int nM, nN, nwg, G, c;
    __host__ __device__ void init(int M, int N, int G_, int c_) { nM = M / BM; nN = N / BM; nwg = nM * nN; G = G_; c = c_; }
    __host__ __device__ bool next(int i, Unit& u) const {
        const long L = (long)i * G + c; if (L >= nwg) return false;
        int wgid = (int)L; { const int q = nwg / NXCD, r = nwg % NXCD, xcd = wgid % NXCD, off = wgid / NXCD; wgid = (xcd < r ? xcd * (q + 1) : r * (q + 1) + (xcd - r) * q) + off; }
        const int nig = WGM * nN, gid = wgid / nig, fm = gid * WGM, gsz = (nM - fm) < WGM ? (nM - fm) : WGM;
        u.pm = fm + ((wgid % nig) % gsz); u.pn = (wgid % nig) / gsz; return true;
    }
    __host__ __device__ size_t aoff(const Unit& u, size_t tstepA) const { return (size_t)u.pm * tstepA; }
};
template <class Epi, class Sched>
__device__ __forceinline__ void gemm_phase(LAS unsigned char* lds, const Gemm g, const Sched& S, const Epi& E) {
    const int tid = otid(), wid = __builtin_amdgcn_readfirstlane(tid >> 6), lane = tid & 63, wr = wid >> 2, wc = wid & 3, fr = lane & 15, fq = lane >> 4;
    const int K = g.K, nt = K / BK;
    unsigned voffA[2], voffB[2];
#pragma unroll
    for (int i = 0; i < 2; ++i) { int R, C; stage_rc(tid * 16 + i * 8192, R, C); const int Rb = (R & ~31) + perm32(R & 31);
        voffA[i] = (unsigned)R * g.lda_b + (unsigned)C * 2u; voffB[i] = (unsigned)(Rb * K + C) * 2u; }
    const size_t kstepA = g.kstepA, kstepB = (size_t)(BK * 2);
    const size_t hstepA = (size_t)HALF * g.lda_b, hstepB = (size_t)HALF * K * 2;
    const size_t tstepA = 2 * hstepA, tstepB = 2 * hstepB;
    const unsigned ldsw = (unsigned)wid * 1024u;
    const int aoff = lds_byte(wr * 64 + fr, fq * 8), boff = lds_byte(wc * 32 + fr, fq * 8);
#define PG8_SA(b, h) (((b) * 2 + (h)) * HTB)
#define PG8_SB(b, h) ((4 + (b) * 2 + (h)) * HTB)
#define PG8_STAGE(bufoff, gbase, voff) do { _Pragma("unroll") for (int _i = 0; _i < 2; ++_i) \
        __builtin_amdgcn_global_load_lds((const unsigned*)((const char*)(gbase) + (voff)[_i]), (LAS unsigned*)(lds + (bufoff) + ldsw + _i * 8192), 16, 0, 0); } while (0)
#define PG8_LDA(dst, b, h) do { _Pragma("unroll") for (int m = 0; m < 4; ++m) _Pragma("unroll") for (int k = 0; k < 2; ++k) dst[m][k] = *(const LAS bf16x8*)(lds + PG8_SA(b, h) + aoff + m * 2048 + k * 1024); } while (0)
#define PG8_LDB(dst, b, h) do { _Pragma("unroll") for (int n = 0; n < 2; ++n) _Pragma("unroll") for (int k = 0; k < 2; ++k) dst[n][k] = *(const LAS bf16x8*)(lds + PG8_SB(b, h) + boff + n * 2048 + k * 1024); } while (0)
#define PG8_MMA(ai, bj, At, Bt) do { __builtin_amdgcn_s_setprio(1); _Pragma("unroll") for (int m = 0; m < 4; ++m) _Pragma("unroll") for (int n = 0; n < 2; ++n) _Pragma("unroll") for (int k = 0; k < 2; ++k) \
        acc[ai][bj][m][n] = __builtin_amdgcn_mfma_f32_16x16x32_bf16(Bt[n][k], At[m][k], acc[ai][bj][m][n], 0, 0, 0); __builtin_amdgcn_s_setprio(0); } while (0)
#define PG8_WAIT_V(n) asm volatile("s_waitcnt vmcnt(" #n ")" ::: "memory")
#define PG8_WAIT_L(n) asm volatile("s_waitcnt lgkmcnt(" #n ")" ::: "memory")
#define PG8_BAR __builtin_amdgcn_s_barrier()
#define PG8_SCHED __builtin_amdgcn_sched_barrier(0)
    Unit cur, nxt; int ui = 0;
    if (!S.next(0, cur)) return;
    f32x4 acc[2][2][4][2];
#pragma unroll
    for (int a = 0; a < 2; ++a)
#pragma unroll
        for (int b = 0; b < 2; ++b)
#pragma unroll
            for (int m = 0; m < 4; ++m)
#pragma unroll
                for (int n = 0; n < 2; ++n) acc[a][b][m][n] = (f32x4){0.f, 0.f, 0.f, 0.f};
    bf16x8 At[4][2], B0[2][2], B1[2][2];
    const char* cA = (const char*)g.A + S.aoff(cur, tstepA); const char* cB = (const char*)g.Bt + (size_t)cur.pn * tstepB;
    {
        PG8_STAGE(PG8_SB(0, 0), cB, voffB); PG8_STAGE(PG8_SB(0, 1), cB + hstepB, voffB); PG8_STAGE(PG8_SA(0, 0), cA, voffA); PG8_STAGE(PG8_SA(0, 1), cA + hstepA, voffA);
        if (wr == 1) PG8_BAR;
        PG8_WAIT_V(2); PG8_BAR;
        PG8_STAGE(PG8_SB(1, 0), cB + kstepB, voffB); PG8_STAGE(PG8_SA(1, 0), cA + kstepA, voffA); PG8_STAGE(PG8_SB(1, 1), cB + hstepB + kstepB, voffB);
        PG8_WAIT_V(6); PG8_BAR;
    }
    for (;;) {
        const bool has_next = S.next(ui + 1, nxt);
        const char* nA = has_next ? (const char*)g.A + S.aoff(nxt, tstepA) : cA; const char* nB = has_next ? (const char*)g.Bt + (size_t)nxt.pn * tstepB : cB;
#pragma unroll 1
        for (int t = 0; t < nt; t += 2) {
            const bool last = (t == nt - 2);
            const char* a1 = cA + (size_t)(t + 1) * kstepA;
            const char* a2 = last ? nA : cA + (size_t)(t + 2) * kstepA; const char* b2 = last ? nB : cB + (size_t)(t + 2) * kstepB;
            const char* a3 = a2 + kstepA; const char* b3 = b2 + kstepB;
            PG8_LDB(B0, 0, 0); PG8_LDB(B1, 0, 1); PG8_SCHED; PG8_LDA(At, 0, 0); PG8_STAGE(PG8_SA(1, 1), a1 + hstepA, voffA);
            PG8_WAIT_V(8); PG8_WAIT_L(0); PG8_BAR; PG8_MMA(0, 0, At, B0); PG8_MMA(0, 1, At, B1); PG8_BAR; PG8_SCHED;
            PG8_LDA(At, 0, 1); PG8_STAGE(PG8_SB(0, 0), b2, voffB); PG8_STAGE(PG8_SB(0, 1), b2 + hstepB, voffB); PG8_STAGE(PG8_SA(0, 0), a2, voffA);
            PG8_WAIT_V(8); PG8_WAIT_L(0); PG8_BAR; PG8_MMA(1, 0, At, B0); PG8_MMA(1, 1, At, B1); PG8_BAR; PG8_SCHED;
            PG8_LDB(B0, 1, 0); PG8_LDB(B1, 1, 1); PG8_SCHED; PG8_LDA(At, 1, 0); PG8_STAGE(PG8_SA(0, 1), a2 + hstepA, voffA);
            PG8_WAIT_V(8); PG8_WAIT_L(0); PG8_BAR; PG8_MMA(0, 0, At, B0); PG8_MMA(0, 1, At, B1); PG8_BAR; PG8_SCHED;
            PG8_LDA(At, 1, 1); PG8_STAGE(PG8_SB(1, 0), b3, voffB); PG8_STAGE(PG8_SB(1, 1), b3 + hstepB, voffB); PG8_STAGE(PG8_SA(1, 0), a3, voffA);
            PG8_WAIT_V(8); PG8_WAIT_L(0); PG8_BAR; PG8_MMA(1, 0, At, B0); PG8_MMA(1, 1, At, B1); PG8_BAR; PG8_SCHED;
        }
        if (wr == 0) PG8_BAR;
        E(acc, cur, wr, wc, fr, fq);
        if (!has_next) break;
#pragma unroll
        for (int a = 0; a < 2; ++a)
#pragma unroll
            for (int b = 0; b < 2; ++b)
#pragma unroll
                for (int m = 0; m < 4; ++m)
#pragma unroll
                    for (int n = 0; n < 2; ++n) acc[a][b][m][n] = (f32x4){0.f, 0.f, 0.f, 0.f};
        cur = nxt; cA = nA; cB = nB; ++ui;
        if (wr == 1) PG8_BAR;
    }
    PG8_WAIT_V(0);
    PG8_BAR;
#undef PG8_SA
#undef PG8_SB
#undef PG8_STAGE
#undef PG8_LDA
#undef PG8_LDB
#undef PG8_MMA
#undef PG8_WAIT_V
#undef PG8_WAIT_L
#undef PG8_BAR
#undef PG8_SCHED
}
}

typedef f32x4 AccT[2][2][4][2];
struct EpiProj {
    bf16_t* P; const float* rope; int rope_tiles; unsigned qmask;
    __device__ __forceinline__ void operator()(const AccT& acc, const pg8::Unit& u, int wr, int wc, int fr, int fq) const {
        const int row0 = u.pm * 256 + wr * 64 + fr, col0 = u.pn * 256 + wc * 32 + 8 * fq;
        const bool do_rope = (u.pn < rope_tiles) && ((wc & 1) == 0);
        const float sc = ((qmask >> u.pn) & 1u) ? C2 : 1.f;
#pragma unroll
        for (int ai = 0; ai < 2; ++ai)
#pragma unroll
            for (int m = 0; m < 4; ++m) {
                const int row = row0 + ai * 128 + m * 16, pos = row & (SEQ - 1);
                f32x4 c0 = {1.f, 1.f, 1.f, 1.f}, c1 = c0, s0 = {0.f, 0.f, 0.f, 0.f}, s1 = s0;
                if (do_rope) { c0 = *(const f32x4*)(rope + pos * 8); c1 = *(const f32x4*)(rope + pos * 8 + 4); s0 = *(const f32x4*)(rope + SEQ * 8 + pos * 8); s1 = *(const f32x4*)(rope + SEQ * 8 + pos * 8 + 4); }
#pragma unroll
                for (int bj = 0; bj < 2; ++bj) {
                    f32x4 v0 = acc[ai][bj][m][0], v1 = acc[ai][bj][m][1];
                    if (do_rope) {
                        f32x4 p0, p1;
#pragma unroll
                        for (int e = 0; e < 4; ++e) { p0[e] = __shfl_xor(v0[e], 16); p1[e] = __shfl_xor(v1[e], 16); }
                        const f32x4 a0 = v0 * c0 - p0 * s0, a1 = v1 * c1 - p1 * s1, b0 = v0 * c0 + p0 * s0, b1 = v1 * c1 + p1 * s1;
                        v0 = fq == 0 ? a0 : (fq == 1 ? b0 : v0); v1 = fq == 0 ? a1 : (fq == 1 ? b1 : v1);
                    }
                    v0 = v0 * sc; v1 = v1 * sc;
                    u32x4 w; w.x = cvt_pk_bf16(v0[0], v0[1]); w.y = cvt_pk_bf16(v0[2], v0[3]); w.z = cvt_pk_bf16(v1[0], v1[1]); w.w = cvt_pk_bf16(v1[2], v1[3]);
                    *(u32x4*)(P + (size_t)row * PW + col0 + bj * 128) = w;
                }
            }
    }
};
struct EpiBf16 {
    bf16_t* O; int ldc; int pnmask;
    __device__ __forceinline__ void operator()(const AccT& acc, const pg8::Unit& u, int wr, int wc, int fr, int fq) const {
        const int row0 = u.pm * 256 + wr * 64 + fr, col0 = (u.pn & pnmask) * 256 + wc * 32 + 8 * fq;
#pragma unroll
        for (int ai = 0; ai < 2; ++ai)
#pragma unroll
            for (int m = 0; m < 4; ++m) {
                bf16_t* rowp = O + (size_t)(row0 + ai * 128 + m * 16) * ldc + col0;
#pragma unroll
                for (int bj = 0; bj < 2; ++bj) { const f32x4 v0 = acc[ai][bj][m][0], v1 = acc[ai][bj][m][1];
                    u32x4 w; w.x = cvt_pk_bf16(v0[0], v0[1]); w.y = cvt_pk_bf16(v0[2], v0[3]); w.z = cvt_pk_bf16(v1[0], v1[1]); w.w = cvt_pk_bf16(v1[2], v1[3]);
                    *(u32x4*)(rowp + bj * 128) = w; }
            }
    }
};
struct EpiResid {
    const float* xin; float* xout; const float* g;
    __device__ __forceinline__ void operator()(const AccT& acc, const pg8::Unit& u, int wr, int wc, int fr, int fq) const {
        const int row0 = u.pm * 256 + wr * 64 + fr, col0 = u.pn * 256 + wc * 32 + 8 * fq;
        const float* gb = g + (u.pm / 16) * 6144;
#pragma unroll
        for (int bj = 0; bj < 2; ++bj) {
            const f32x4 g0 = *(const f32x4*)(gb + col0 + bj * 128), g1 = *(const f32x4*)(gb + col0 + bj * 128 + 4);
#pragma unroll
            for (int ai = 0; ai < 2; ++ai)
#pragma unroll
                for (int m = 0; m < 4; ++m) {
                    const size_t off = (size_t)(row0 + ai * 128 + m * 16) * DM + col0 + bj * 128;
                    const f32x4 x0 = *(const f32x4*)(xin + off), x1 = *(const f32x4*)(xin + off + 4);
                    *(f32x4*)(xout + off) = x0 + g0 * acc[ai][bj][m][0]; *(f32x4*)(xout + off + 4) = x1 + g1 * acc[ai][bj][m][1];
                }
        }
    }
};

__device__ __forceinline__ void ph_inproj(const Params& p, LAS unsigned char* lds, int l, int bx, int G) {
    const bf16_t* H = (const bf16_t*)(p.ws + WS_H);
    const bf16_t* win = (const bf16_t*)(p.ws + WS_WIN) + (size_t)l * 3072 * 1024;
    const bool even = (l & 1) == 0;
    {
        pg8::Gemm g{H, win, 1024, 2048u, 128u}; pg8::StaticOrder S; S.init(NT, PW, G, bx);
        EpiProj E{(bf16_t*)(p.ws + WS_P), (const float*)(p.ws + WS_ROPE), even ? 8 : 7, even ? 0x33u : 0x0Fu};
        pg8::gemm_phase<EpiProj, pg8::StaticOrder>(lds, g, S, E);
    }
    {
        pg8::Gemm g{win + (size_t)2048 * 1024, H, 1024, 2048u, 128u}; pg8::StaticOrder S; S.init(even ? 1024 : 768, NT, G, bx);
        EpiBf16 E{(bf16_t*)(p.ws + WS_VT), NT, 0x7fffffff};
        pg8::gemm_phase<EpiBf16, pg8::StaticOrder>(lds, g, S, E);
    }
}
__device__ __forceinline__ void ph_outproj(const Params& p, LAS unsigned char* lds, int l, int bx, int G) {
    const bf16_t* O = (const bf16_t*)(p.ws + WS_O);
    const bf16_t* wout = (const bf16_t*)(p.ws + WS_WOUT) + (size_t)l * 1024 * 1024;
    float* X = (float*)(p.ws + WS_X);
    pg8::Gemm g{O, wout, 1024, 2048u, 128u}; pg8::StaticOrder S; S.init(NT, DM, G, bx);
    EpiResid E{l == 0 ? p.in[0] : X, X, (const float*)(p.ws + WS_MOD) + (size_t)l * 4 * 6144 + 2 * 1024};
    pg8::gemm_phase<EpiResid, pg8::StaticOrder>(lds, g, S, E);
}


typedef float f32x2_t __attribute__((ext_vector_type(2))); typedef __bf16 bf16x2_t __attribute__((ext_vector_type(2)));
__device__ __forceinline__ unsigned cvtpk_s(float lo, float hi) { f32x2_t v = {lo, hi}; bf16x2_t b = __builtin_convertvector(v, bf16x2_t); return __builtin_bit_cast(unsigned, b); }
#define MFMA32(a, b, c) __builtin_amdgcn_mfma_f32_32x32x16_bf16((a), (b), (c), 0, 0, 0)
constexpr int AT_KB = 64 * 144, AT_VB = 128 * 136;
constexpr int AT_KOFF = 0, AT_VOFF = 2 * AT_KB;
constexpr int AT_MASK = AT_VOFF + 2 * AT_VB;
constexpr int AT_RED = AT_MASK + 2048;
constexpr int AT_KM = AT_RED + 1024;
constexpr int AT_IMP = 61440;
static_assert(AT_IMP + 4 * 64 * 65 * 4 <= 131072, "attention LDS map");

template <int DVB>
__device__ __forceinline__ void attn_run(LAS unsigned char* lds, const bf16_t* __restrict__ Kg, int kpitch, const bf16_t* __restrict__ Vg, int vpitch,
                                         u64 tmask, u64 mymask, int klim, int kmin, const bf16x8 (&qf)[4], f32x16 (&o)[DVB], float& m, float& l) {
    const int tid = otid(), lane = tid & 63, r = lane & 31, hi = lane >> 5;
    const int lrow = tid >> 3, lch = tid & 7;
    if (tmask == 0ull) return;
    int j = __builtin_ctzll(tmask); tmask &= tmask - 1ull;
    {
        const u32x4 kreg = *(const u32x4*)(Kg + (size_t)(j * 64 + lrow) * kpitch + lch * 8);
        u32x4 vreg[DVB / 2];
#pragma unroll
        for (int i = 0; i < DVB / 2; ++i) vreg[i] = *(const u32x4*)(Vg + (size_t)(lrow + 64 * i) * vpitch + j * 64 + lch * 8);
        *(LAS u32x4*)(lds + AT_KOFF + lrow * 144 + lch * 16) = kreg;
#pragma unroll
        for (int i = 0; i < DVB / 2; ++i) { LAS unsigned char* vp = lds + AT_VOFF + (lrow + 64 * i) * 136 + lch * 16;
            *(LAS u32x2*)vp = (u32x2){vreg[i].x, vreg[i].y}; *(LAS u32x2*)(vp + 8) = (u32x2){vreg[i].z, vreg[i].w}; }
    }
    __syncthreads();
    int cur = 0;
    for (;;) {
        int jn = -1; if (tmask != 0ull) { jn = __builtin_ctzll(tmask); tmask &= tmask - 1ull; }
        u32x4 kreg = {0u, 0u, 0u, 0u}; u32x4 vreg[DVB / 2];
#pragma unroll
        for (int i = 0; i < DVB / 2; ++i) vreg[i] = (u32x4){0u, 0u, 0u, 0u};
        if (jn >= 0) {
            kreg = *(const u32x4*)(Kg + (size_t)(jn * 64 + lrow) * kpitch + lch * 8);
#pragma unroll
            for (int i = 0; i < DVB / 2; ++i) vreg[i] = *(const u32x4*)(Vg + (size_t)(lrow + 64 * i) * vpitch + jn * 64 + lch * 8);
        }
        {
            const int k0 = j * 64;
            const bool bit = ((mymask >> j) & 1ull) != 0ull;
            const bool any = bit && (k0 <= klim) && (k0 + 63 >= kmin);
            if (__ballot(any) != 0ull) {
                const bool full = bit && (k0 + 63 <= klim) && (k0 >= kmin);
                const bool allfull = (__ballot(full) == ~0ull);
                const LAS unsigned char* kb = lds + AT_KOFF + cur * AT_KB + r * 144 + hi * 16;
                f32x16 p0, p1;
#pragma unroll
                for (int i = 0; i < 16; ++i) { p0[i] = 0.f; p1[i] = 0.f; }
#pragma unroll
                for (int ks = 0; ks < 4; ++ks) {
                    const bf16x8 ka = *(const LAS bf16x8*)(kb + ks * 32), kb2 = *(const LAS bf16x8*)(kb + 32 * 144 + ks * 32);
                    p0 = MFMA32(ka, qf[ks], p0); p1 = MFMA32(kb2, qf[ks], p1);
                }
                if (!allfull) {
#pragma unroll
                    for (int i = 0; i < 16; ++i) { const int key = k0 + (i & 3) + 8 * (i >> 2) + 4 * hi;
                        const bool ok0 = bit && (key <= klim) && (key >= kmin), ok1 = bit && (key + 32 <= klim) && (key + 32 >= kmin);
                        p0[i] = ok0 ? p0[i] : NEGBIG; p1[i] = ok1 ? p1[i] : NEGBIG; }
                }
                float mx = fmaxf(p0[0], p1[0]);
#pragma unroll
                for (int i = 1; i < 16; ++i) mx = fmaxf(mx, fmaxf(p0[i], p1[i]));
                mx = fmaxf(mx, __shfl_xor(mx, 32));
                const float mnew = fmaxf(m, mx);
                const float alpha = __builtin_amdgcn_exp2f(m - mnew);
                float ls = 0.f;
#pragma unroll
                for (int i = 0; i < 16; ++i) {
                    float e0 = __builtin_amdgcn_exp2f(p0[i] - mnew), e1 = __builtin_amdgcn_exp2f(p1[i] - mnew);
                    if (!allfull) { e0 = (p0[i] <= -5e29f) ? 0.f : e0; e1 = (p1[i] <= -5e29f) ? 0.f : e1; }
                    p0[i] = e0; p1[i] = e1; ls += e0 + e1;
                }
                l = l * alpha + ls; m = mnew;
#pragma unroll
                for (int d = 0; d < DVB; ++d) o[d] = o[d] * alpha;
                bf16x8 pb[2][2];
#pragma unroll
                for (int s2 = 0; s2 < 2; ++s2) {
                    u32x4 w0, w1;
                    w0.x = cvtpk_s(p0[8 * s2 + 0], p0[8 * s2 + 1]); w0.y = cvtpk_s(p0[8 * s2 + 2], p0[8 * s2 + 3]); w0.z = cvtpk_s(p0[8 * s2 + 4], p0[8 * s2 + 5]); w0.w = cvtpk_s(p0[8 * s2 + 6], p0[8 * s2 + 7]);
                    w1.x = cvtpk_s(p1[8 * s2 + 0], p1[8 * s2 + 1]); w1.y = cvtpk_s(p1[8 * s2 + 2], p1[8 * s2 + 3]); w1.z = cvtpk_s(p1[8 * s2 + 4], p1[8 * s2 + 5]); w1.w = cvtpk_s(p1[8 * s2 + 6], p1[8 * s2 + 7]);
                    pb[0][s2] = __builtin_bit_cast(bf16x8, w0); pb[1][s2] = __builtin_bit_cast(bf16x8, w1);
                }
                const LAS unsigned char* vb = lds + AT_VOFF + cur * AT_VB + r * 136 + hi * 8;
#pragma unroll
                for (int d = 0; d < DVB; ++d)
#pragma unroll
                    for (int kg = 0; kg < 2; ++kg)
#pragma unroll
                        for (int s2 = 0; s2 < 2; ++s2) {
                            const LAS unsigned char* vp = vb + d * 32 * 136 + (kg * 32 + s2 * 16) * 2;
                            const u32x2 lo = *(const LAS u32x2*)vp, h2 = *(const LAS u32x2*)(vp + 16);
                            const bf16x8 va = __builtin_bit_cast(bf16x8, (u32x4){lo.x, lo.y, h2.x, h2.y});
                            o[d] = MFMA32(va, pb[kg][s2], o[d]);
                        }
            }
        }
        if (jn >= 0) {
            const int nb = cur ^ 1;
            *(LAS u32x4*)(lds + AT_KOFF + nb * AT_KB + lrow * 144 + lch * 16) = kreg;
#pragma unroll
            for (int i = 0; i < DVB / 2; ++i) { LAS unsigned char* vp = lds + AT_VOFF + nb * AT_VB + (lrow + 64 * i) * 136 + lch * 16;
                *(LAS u32x2*)vp = (u32x2){vreg[i].x, vreg[i].y}; *(LAS u32x2*)(vp + 8) = (u32x2){vreg[i].z, vreg[i].w}; }
        }
        __syncthreads();
        if (jn < 0) break;
        j = jn; cur ^= 1;
    }
}
__device__ __forceinline__ u64 tile_range_mask(int lo, int hi) {
    const u64 up = (hi >= 63) ? ~0ull : ((1ull << (hi + 1)) - 1ull);
    return up & ~((1ull << lo) - 1ull);
}

__device__ __forceinline__ void ph_moba_kmean(const Params& p, LAS unsigned char* lds, int bx, int G) {
    const int tid = otid(), lane = tid & 63, w = tid >> 6;
    const bf16_t* P = (const bf16_t*)(p.ws + WS_P); float* kmean = (float*)(p.ws + WS_KMEAN);
    LAS float* red = (LAS float*)lds;
    for (int it = bx; it < NB * 8 * 16; it += G) {
        const int blk = it & 15, h = (it >> 4) & 7, b = it >> 7;
        const bf16_t* kp = P + (size_t)(b * SEQ + blk * 256 + w * 32) * PW + 512 + h * 64 + lane;
        float s = 0.f;
#pragma unroll 8
        for (int i = 0; i < 32; ++i) s += bf2f(kp[(size_t)i * PW]);
        red[w * 64 + lane] = s;
        __syncthreads();
        if (w == 0) { float t = 0.f;
#pragma unroll
            for (int i = 0; i < 8; ++i) t += red[i * 64 + lane];
            kmean[((b * 8 + h) * 16 + blk) * 64 + lane] = t * (1.f / 256.f); }
        __syncthreads();
    }
}
__device__ __forceinline__ void ph_attn_even(const Params& p, LAS unsigned char* lds, int bx, int G) {
    const int tid = otid(), lane = tid & 63, w = tid >> 6, r = lane & 31, hi = lane >> 5;
    const bf16_t* P = (const bf16_t*)(p.ws + WS_P); const bf16_t* VT = (const bf16_t*)(p.ws + WS_VT);
    const float* kmean = (const float*)(p.ws + WS_KMEAN);
    bf16_t* O = (bf16_t*)(p.ws + WS_O); float* DT = (float*)(p.ws + WS_DT);
    LAS float* kml = (LAS float*)(lds + AT_KM);
    for (int c = bx; c < 256; c += G) {
        const int bh = c & 31, qtp = c >> 5;
#pragma unroll 1
        for (int uu = 0; uu < 4; ++uu) {
            const int kind = uu >> 1, qt = (uu & 1) ? (15 - qtp) : qtp;
            const int b = bh >> 3, hh = bh & 7;
            const int qpos = qt * 256 + w * 32 + r;
            const size_t tok = (size_t)b * SEQ + qpos;
            if (kind == 0) {
                const bf16_t* qp = P + tok * PW + hh * 64 + hi * 8;
                bf16x8 qf[4];
#pragma unroll
                for (int ks = 0; ks < 4; ++ks) qf[ks] = *(const bf16x8*)(qp + ks * 16);
                __syncthreads();
                for (int i = tid; i < 1024; i += NTHR) kml[i] = kmean[(size_t)(b * 8 + hh) * 1024 + i];
                __syncthreads();
                const int own = qt;
                float g0 = NEGBIG, g1 = NEGBIG, g2 = NEGBIG; int i0 = -1, i1 = -1, i2 = -1;
                for (int blk = 0; blk < own; ++blk) {
                    float s = 0.f;
#pragma unroll
                    for (int ks = 0; ks < 4; ++ks)
#pragma unroll
                        for (int e = 0; e < 8; ++e) s += bf2f((bf16_t)qf[ks][e]) * kml[blk * 64 + ks * 16 + hi * 8 + e];
                    s += __shfl_xor(s, 32);
                    if (s > g0) { g2 = g1; i2 = i1; g1 = g0; i1 = i0; g0 = s; i0 = blk; }
                    else if (s > g1) { g2 = g1; i2 = i1; g1 = s; i1 = blk; }
                    else if (s > g2) { g2 = s; i2 = blk; }
                }
                u64 mk = 0xFull << (4 * own);
                if (i0 >= 0) mk |= 0xFull << (4 * i0);
                if (i1 >= 0) mk |= 0xFull << (4 * i1);
                if (i2 >= 0) mk |= 0xFull << (4 * i2);
                f32x16 o[2];
#pragma unroll
                for (int d = 0; d < 2; ++d)
#pragma unroll
                    for (int i = 0; i < 16; ++i) o[d][i] = 0.f;
                float m = NEGBIG, l = 0.f;
                attn_run<2>(lds, P + (size_t)b * SEQ * PW + 512 + hh * 64, PW, VT + (size_t)(hh * 64) * NT + (size_t)b * SEQ, NT,
                            tile_range_mask(0, 4 * qt + 3), mk, qpos, 0, qf, o, m, l);
                l += __shfl_xor(l, 32);
                const float il = l > 0.f ? 1.f / l : 0.f;
                bf16_t* op = O + tok * 1024 + hh * 64 + 4 * hi;
#pragma unroll
                for (int d = 0; d < 2; ++d)
#pragma unroll
                    for (int cc = 0; cc < 4; ++cc) {
                        u32x2 wv; wv.x = cvtpk_s(o[d][4 * cc] * il, o[d][4 * cc + 1] * il); wv.y = cvtpk_s(o[d][4 * cc + 2] * il, o[d][4 * cc + 3] * il);
                        *(u32x2*)(op + 32 * d + 8 * cc) = wv;
                    }
            } else {
                const bf16_t* qp = P + tok * PW + 1024 + hh * 64 + hi * 8;
                bf16x8 qf[4];
#pragma unroll
                for (int ks = 0; ks < 4; ++ks) qf[ks] = *(const bf16x8*)(qp + ks * 16);
                f32x16 o[4];
#pragma unroll
                for (int d = 0; d < 4; ++d)
#pragma unroll
                    for (int i = 0; i < 16; ++i) o[d][i] = 0.f;
                float m = NEGBIG, l = 0.f;
                attn_run<4>(lds, P + (size_t)b * SEQ * PW + 1536 + hh * 64, PW, VT + (size_t)(512 + (hh >> 1) * 128) * NT + (size_t)b * SEQ, NT,
                            tile_range_mask(0, 4 * qt + 3), ~0ull, qpos, 0, qf, o, m, l);
                l += __shfl_xor(l, 32);
                const float il = l > 0.f ? 1.f / l : 0.f;
                float* op = DT + tok * 1024 + hh * 128 + 4 * hi;
#pragma unroll
                for (int d = 0; d < 4; ++d)
#pragma unroll
                    for (int cc = 0; cc < 4; ++cc)
                        *(f32x4*)(op + 32 * d + 8 * cc) = (f32x4){o[d][4 * cc] * il, o[d][4 * cc + 1] * il, o[d][4 * cc + 2] * il, o[d][4 * cc + 3] * il};
            }
        }
    }
}
__device__ __forceinline__ void ph_diff_combine(const Params& p, int l, int bx, int G) {
    const int tid = otid(), lane = tid & 63, w = tid >> 6;
    const float* DT = (const float*)(p.ws + WS_DT); bf16_t* O = (bf16_t*)(p.ws + WS_O);
    const int li = l >> 1;
    const float lam = ((const float*)(p.ws + WS_MISC))[li], linit = li == 0 ? LINIT0 : LINIT1;
    const float* subg = p.in[10] + li * 128;
    const float sg0 = subg[lane], sg1 = subg[64 + lane];
    for (int it = bx * NWAVES + w; it < NT * 4; it += G * NWAVES) {
        const int t = it >> 2, hd = it & 3;
        const float* p0 = DT + (size_t)t * 1024 + (hd * 2) * 128, * p1 = p0 + 128;
        const float v0 = p0[lane] - lam * p1[lane], v1 = p0[64 + lane] - lam * p1[64 + lane];
        const float ss = wave_sum(v0 * v0 + v1 * v1);
        const float rs = rsqrtf(ss * (1.f / 128.f) + 1e-6f) * (1.f - linit);
        O[(size_t)t * 1024 + 512 + hd * 128 + lane] = f2bf(v0 * rs * sg0);
        O[(size_t)t * 1024 + 512 + hd * 128 + 64 + lane] = f2bf(v1 * rs * sg1);
    }
}


__device__ __forceinline__ void ph_misc(const Params& p, int bx, int G) {
    const int tid = otid();
    float* misc = (float*)(p.ws + WS_MISC); float* fold = (float*)(p.ws + WS_FOLD);
    if (bx == 0 && tid < 64) {
        for (int i = 0; i < 2; ++i) { const float* lp = p.in[9] + i * 256;
            const float s1 = wave_sum(lp[tid] * lp[64 + tid]), s2 = wave_sum(lp[128 + tid] * lp[192 + tid]);
            if (tid == 0) misc[i] = expf(s1) - expf(s2) + (i == 0 ? LINIT0 : LINIT1); }
    }
    for (int o = bx * NTHR + tid; o < 1024; o += G * NTHR) {
        const int f = o & 255, lb = o >> 8;
        const float* pos = p.in[13] + (size_t)lb * 2048; const float* w1 = p.in[14] + (size_t)lb * 2048 * 256 + f;
        float s = p.in[15][lb * 256 + f];
        for (int i = 0; i < 2048; ++i) s += pos[i] * w1[(size_t)i * 256];
        fold[o] = s;
    }
}
struct CmpOrder {
    int G, c;
    __device__ bool next(int i, pg8::Unit& u) const { const int L = i * G + c; if (L >= 32) return false; u.pm = L; u.pn = L >> 4; return true; }
    __device__ size_t aoff(const pg8::Unit& u, size_t tstepA) const { const int br = u.pm >> 4, g = (u.pm >> 2) & 3, rt = u.pm & 3; return (size_t)rt * tstepA + (size_t)(((br ? 1792 : 1024) + g * 64) * 2); }
};
__device__ __forceinline__ float gelu_tanh_fast(float x) {
    const float y = 0.7978845608028654f * (x + 0.044715f * x * x * x);
    const float t = 1.f - 2.f * __builtin_amdgcn_rcpf(1.f + __expf(2.f * y));
    return 0.5f * x * (1.f + t);
}
struct EpiCmp1 {
    bf16_t* CH; const float* fold;
    __device__ __forceinline__ void operator()(const AccT& acc, const pg8::Unit& u, int wr, int wc, int fr, int fq) const {
        const int br = u.pm >> 4, g = (u.pm >> 2) & 3, rt = u.pm & 3;
        const int row0 = rt * 256 + wr * 64 + fr, col0 = wc * 32 + 8 * fq;
        bf16_t* base = CH + (size_t)(br * 4 + g) * 1024 * 256;
#pragma unroll
        for (int bj = 0; bj < 2; ++bj) {
            const f32x4 b0 = *(const f32x4*)(fold + br * 256 + col0 + bj * 128), b1 = *(const f32x4*)(fold + br * 256 + col0 + bj * 128 + 4);
#pragma unroll
            for (int ai = 0; ai < 2; ++ai)
#pragma unroll
                for (int m = 0; m < 4; ++m) {
                    const f32x4 v0 = acc[ai][bj][m][0] + b0, v1 = acc[ai][bj][m][1] + b1;
                    u32x4 w; w.x = cvt_pk_bf16(gelu_tanh_fast(v0[0]), gelu_tanh_fast(v0[1])); w.y = cvt_pk_bf16(gelu_tanh_fast(v0[2]), gelu_tanh_fast(v0[3]));
                    w.z = cvt_pk_bf16(gelu_tanh_fast(v1[0]), gelu_tanh_fast(v1[1])); w.w = cvt_pk_bf16(gelu_tanh_fast(v1[2]), gelu_tanh_fast(v1[3]));
                    *(u32x4*)(base + (size_t)(row0 + ai * 128 + m * 16) * 256 + col0 + bj * 128) = w;
                }
        }
    }
};
__device__ __forceinline__ void ph_compress1(const Params& p, LAS unsigned char* lds, int l, int bx, int G) {
    const int li = l >> 1;
    pg8::Gemm g{(const bf16_t*)(p.ws + WS_P), (const bf16_t*)(p.ws + WS_W1T) + (size_t)li * 2 * 256 * 2048, 2048, 16u * PW * 2u, PW * 2u};
    CmpOrder S{G, bx};
    EpiCmp1 E{(bf16_t*)(p.ws + WS_CH), (const float*)(p.ws + WS_FOLD) + li * 512};
    pg8::gemm_phase<EpiCmp1, CmpOrder>(lds, g, S, E);
}
__device__ __forceinline__ void ph_compress2(const Params& p, int l, int bx, int G) {
    const int tid = otid(), lane = tid & 63, w = tid >> 6, li = l >> 1;
    const bf16_t* CH = (const bf16_t*)(p.ws + WS_CH); bf16_t* KCMP = (bf16_t*)(p.ws + WS_KCMP); bf16_t* VCX = (bf16_t*)(p.ws + WS_VCX);
    for (int it = bx * NWAVES + w; it < 8192; it += G * NWAVES) {
        const int r = it & 1023, g = (it >> 10) & 3, br = it >> 12, b = r >> 8, n = r & 255;
        const bf16_t* hp = CH + (size_t)it * 256;
        const float* w2 = p.in[16] + (size_t)(li * 2 + br) * 256 * 64 + lane;
        float s = p.in[17][(li * 2 + br) * 64 + lane];
        for (int f = 0; f < 256; f += 8) {
            const u32x4 hv = *(const u32x4*)(hp + f);
            s += bf2f((bf16_t)(hv.x & 0xffff)) * w2[(f + 0) * 64] + bf2f((bf16_t)(hv.x >> 16)) * w2[(f + 1) * 64] + bf2f((bf16_t)(hv.y & 0xffff)) * w2[(f + 2) * 64] + bf2f((bf16_t)(hv.y >> 16)) * w2[(f + 3) * 64]
               + bf2f((bf16_t)(hv.z & 0xffff)) * w2[(f + 4) * 64] + bf2f((bf16_t)(hv.z >> 16)) * w2[(f + 5) * 64] + bf2f((bf16_t)(hv.w & 0xffff)) * w2[(f + 6) * 64] + bf2f((bf16_t)(hv.w >> 16)) * w2[(f + 7) * 64];
        }
        if (n == 255) s = 0.f;
        if (br == 0) KCMP[((size_t)(b * 4 + g) * 256 + n) * 64 + lane] = f2bf(s);
        else VCX[((size_t)(b * 4 + g) * 128 + lane) * 256 + n] = f2bf(s);
    }
    for (int i = bx * NTHR + tid; i < 16 * 64 * 256; i += G * NTHR) {
        const int n = i & 255, j = (i >> 8) & 63, bg = i >> 14;
        const bool ov = (n < 255) && (n >= 4 * j - 1) && (n <= 4 * j + 3);
        VCX[((size_t)bg * 128 + 64 + j) * 256 + n] = ov ? (bf16_t)0x3F80 : (bf16_t)0;
    }
}
__device__ __forceinline__ void ph_attn_odd(const Params& p, LAS unsigned char* lds, int bx, int G) {
    const int tid = otid(), lane = tid & 63, w = tid >> 6, r = lane & 31, hi = lane >> 5;
    const bf16_t* P = (const bf16_t*)(p.ws + WS_P); const bf16_t* VT = (const bf16_t*)(p.ws + WS_VT);
    const bf16_t* KCMP = (const bf16_t*)(p.ws + WS_KCMP); const bf16_t* VCX = (const bf16_t*)(p.ws + WS_VCX);
    bf16_t* O = (bf16_t*)(p.ws + WS_O);
    LAS float* imp = (LAS float*)(lds + AT_IMP);
    LAS u64* mks = (LAS u64*)(lds + AT_MASK);
    LAS u64* red = (LAS u64*)(lds + AT_RED);
    for (int c = bx; c < 256; c += G) {
        const int bg = c & 15, qp = c >> 4, b = bg >> 2, g = bg & 3;
#pragma unroll 1
        for (int uu = 0; uu < 4; ++uu) {
            const int qt = uu == 0 ? qp : (uu == 1 ? 31 - qp : (uu == 2 ? 32 + qp : 63 - qp));
            const int head = 4 * g + (w >> 1), qloc = (w & 1) * 32 + r, qpos = qt * 64 + qloc;
            const size_t tok = (size_t)b * SEQ + qpos;
            const bf16_t* qptr = P + tok * PW + head * 64 + hi * 8;
            bf16x8 qf[4];
#pragma unroll
            for (int ks = 0; ks < 4; ++ks) qf[ks] = *(const bf16x8*)(qptr + ks * 16);
            float gt[3];
#pragma unroll
            for (int j = 0; j < 3; ++j) { const float gl = bf2f(VT[(size_t)(512 + head * 3 + j) * NT + tok]); gt[j] = 1.f / (1.f + __expf(-gl)); }
            f32x16 acc[2];
            {
                f32x16 o4[4];
#pragma unroll
                for (int d = 0; d < 4; ++d)
#pragma unroll
                    for (int i = 0; i < 16; ++i) o4[d][i] = 0.f;
                float m = NEGBIG, l = 0.f;
                const int klim = qpos >= 31 ? ((qpos - 31) >> 4) : -1;
                attn_run<4>(lds, KCMP + (size_t)bg * 256 * 64, 64, VCX + (size_t)bg * 128 * 256, 256, tile_range_mask(0, (4 * qt + 2) >> 6), ~0ull, klim, 0, qf, o4, m, l);
                l += __shfl_xor(l, 32);
                const float il = l > 0.f ? 1.f / l : 0.f;
#pragma unroll
                for (int d = 0; d < 2; ++d) acc[d] = o4[d] * (gt[0] * il);
                LAS float* ip = imp + ((w >> 1) * 64 + qloc) * 65 + 4 * hi;
#pragma unroll
                for (int d = 0; d < 2; ++d)
#pragma unroll
                    for (int i = 0; i < 16; ++i) ip[32 * d + (i & 3) + 8 * (i >> 2)] = o4[2 + d][i] * il;
            }
            __syncthreads();
            if (w == 0) {
                LAS float* iq = imp + lane * 65;
                const int own = qt;
                for (int j = 0; j < 64; ++j) {
                    float v = iq[j] + iq[64 * 65 + j] + iq[2 * 64 * 65 + j] + iq[3 * 64 * 65 + j];
                    if (j > own) v = NEGBIG; else if (j == 0 || j == own || j == own - 1) v = 1e6f;
                    iq[j] = v;
                }
                u64 sel = 0ull;
#pragma unroll 1
                for (int k = 0; k < 16; ++k) {
                    int bi = 0; float bv = iq[0];
                    for (int j = 1; j < 64; ++j) { const float v = iq[j]; if (v > bv) { bv = v; bi = j; } }
                    sel |= 1ull << bi; iq[bi] = -3.4e38f;
                }
                mks[lane] = sel;
                unsigned lo = (unsigned)sel, hh = (unsigned)(sel >> 32);
#pragma unroll
                for (int off = 32; off >= 1; off >>= 1) { lo |= __shfl_xor(lo, off); hh |= __shfl_xor(hh, off); }
                if (lane == 0) red[0] = ((u64)hh << 32) | lo;
            }
            __syncthreads();
            const u64 mymask = mks[qloc];
            const u64 tm_sel = red[0] & tile_range_mask(0, qt);
#pragma unroll 1
            for (int br = 0; br < 2; ++br) {
                f32x16 o2[2];
#pragma unroll
                for (int d = 0; d < 2; ++d)
#pragma unroll
                    for (int i = 0; i < 16; ++i) o2[d][i] = 0.f;
                float m = NEGBIG, l = 0.f;
                const bf16_t* Kg = P + (size_t)b * SEQ * PW + (br == 0 ? 1280 : 1536) + g * 64;
                const bf16_t* Vg = VT + (size_t)((br == 0 ? 0 : 256) + g * 64) * NT + (size_t)b * SEQ;
                const u64 tm = br == 0 ? tm_sel : tile_range_mask(qt >= 8 ? qt - 8 : 0, qt);
                attn_run<2>(lds, Kg, PW, Vg, NT, tm, br == 0 ? mymask : ~0ull, qpos, br == 0 ? 0 : qpos - 511, qf, o2, m, l);
                l += __shfl_xor(l, 32);
                const float sc = (l > 0.f ? 1.f / l : 0.f) * (br == 0 ? gt[1] : gt[2]);
#pragma unroll
                for (int d = 0; d < 2; ++d) acc[d] = acc[d] + o2[d] * sc;
            }
            bf16_t* op = O + tok * 1024 + head * 64 + 4 * hi;
#pragma unroll
            for (int d = 0; d < 2; ++d)
#pragma unroll
                for (int cc = 0; cc < 4; ++cc) {
                    u32x2 wv; wv.x = cvtpk_s(acc[d][4 * cc], acc[d][4 * cc + 1]); wv.y = cvtpk_s(acc[d][4 * cc + 2], acc[d][4 * cc + 3]);
                    *(u32x2*)(op + 32 * d + 8 * cc) = wv;
                }
        }
    }
}


template <int MODE>
__device__ __forceinline__ void ph_norm(const Params& p, int l, int bx, int G) {
    const int tid = otid(), lane = tid & 63, w = tid >> 6;
    float* X = (float*)(p.ws + WS_X); bf16_t* H = (bf16_t*)(p.ws + WS_H);
    const float* mod = (const float*)(p.ws + WS_MOD);
    const bf16_t* Y = (const bf16_t*)(p.ws + WS_Y); const int* POS = (const int*)(p.ws + WS_POS);
    int* tok_e = (int*)(p.ws + WS_ROUTE); float* tok_w = (float*)(p.ws + WS_ROUTE + 131072); int* tok_rank = (int*)(p.ws + WS_ROUTE + 262144);
    unsigned* cnt = (unsigned*)(p.ws + WS_CTL) + CW_CNT + l * 16;
    const bool comb = (MODE == 2) || (MODE == 0 && l > 0);
    const int lc = (MODE == 2) ? DEPTH - 1 : l - 1;
    const float* xin = (MODE == 0 && l == 0) ? p.in[0] : X;
    const float* gsrc = (MODE == 0) ? p.in[2] + l * DM : (MODE == 1 ? p.in[3] + l * DM : p.in[4]);
    const int scc = (MODE == 0) ? 1 : 4, shc = (MODE == 0) ? 0 : 3;
    for (int t = bx * NWAVES + w; t < NT; t += G * NWAVES) {
        const int b = t / SEQ;
        const float* xr = xin + (size_t)t * DM;
        f32x4 xv[4]; float ss = 0.f;
        int p0 = 0, p1 = 0;
        if (comb) { p0 = POS[t * 2]; p1 = POS[t * 2 + 1]; }
#pragma unroll
        for (int i = 0; i < 4; ++i) {
            const int idx = i * 256 + lane * 4;
            xv[i] = *(const f32x4*)(xr + idx);
            if (comb) {
                const u32x2 ya = *(const u32x2*)(Y + (size_t)p0 * DM + idx), yb = *(const u32x2*)(Y + (size_t)p1 * DM + idx);
                const f32x4 g2 = *(const f32x4*)(mod + (size_t)(lc * 4 + b) * 6144 + 5 * 1024 + idx);
                f32x4 ys; ys[0] = bf2f((bf16_t)(ya.x & 0xffff)) + bf2f((bf16_t)(yb.x & 0xffff)); ys[1] = bf2f((bf16_t)(ya.x >> 16)) + bf2f((bf16_t)(yb.x >> 16));
                ys[2] = bf2f((bf16_t)(ya.y & 0xffff)) + bf2f((bf16_t)(yb.y & 0xffff)); ys[3] = bf2f((bf16_t)(ya.y >> 16)) + bf2f((bf16_t)(yb.y >> 16));
                xv[i] = xv[i] + g2 * ys;
                if (MODE == 0) *(f32x4*)(X + (size_t)t * DM + idx) = xv[i];
            }
            ss += xv[i][0] * xv[i][0] + xv[i][1] * xv[i][1] + xv[i][2] * xv[i][2] + xv[i][3] * xv[i][3];
        }
        ss = wave_sum(ss);
        const float rs = rsqrtf(ss * (1.f / DM) + 1e-6f);
        float hv[4][4];
#pragma unroll
        for (int i = 0; i < 4; ++i) {
            const int idx = i * 256 + lane * 4;
            const f32x4 gv = *(const f32x4*)(gsrc + idx);
            f32x4 y = xv[i] * rs * gv;
            if (MODE == 2) { *(f32x4*)(p.out + (size_t)t * DM + idx) = y; }
            else {
                const f32x4 sc = *(const f32x4*)(mod + (size_t)(l * 4 + b) * 6144 + scc * 1024 + idx), sh = *(const f32x4*)(mod + (size_t)(l * 4 + b) * 6144 + shc * 1024 + idx);
                y = y * (sc + 1.f) + sh;
                hv[i][0] = y[0]; hv[i][1] = y[1]; hv[i][2] = y[2]; hv[i][3] = y[3];
                u32x2 o; o.x = pk2(y[0], y[1]); o.y = pk2(y[2], y[3]);
                *(u32x2*)(H + (size_t)t * DM + idx) = o;
            }
        }
        if (MODE == 1) {
            const float* wg = p.in[18] + (size_t)l * 1024 * 4; const float* bg = p.in[19] + l * 4;
            const float* we = p.in[20] + (size_t)l * 1024 * 16; const float* be = p.in[21] + l * 16;
            float acc[20];
#pragma unroll
            for (int q = 0; q < 20; ++q) acc[q] = 0.f;
#pragma unroll
            for (int i = 0; i < 4; ++i)
#pragma unroll
                for (int e = 0; e < 4; ++e) {
                    const int idx = i * 256 + lane * 4 + e; const float h = hv[i][e];
                    const f32x4 a = *(const f32x4*)(wg + idx * 4);
                    acc[0] += h * a[0]; acc[1] += h * a[1]; acc[2] += h * a[2]; acc[3] += h * a[3];
#pragma unroll
                    for (int q = 0; q < 4; ++q) { const f32x4 w4 = *(const f32x4*)(we + idx * 16 + q * 4); acc[4 + q * 4] += h * w4[0]; acc[5 + q * 4] += h * w4[1]; acc[6 + q * 4] += h * w4[2]; acc[7 + q * 4] += h * w4[3]; }
                }
#pragma unroll
            for (int q = 0; q < 20; ++q) acc[q] = wave_sum(acc[q]);
            if (lane == 0) {
                float gl[4];
#pragma unroll
                for (int j = 0; j < 4; ++j) gl[j] = acc[j] + bg[j];
                int gs = 0; float gm = gl[0];
#pragma unroll
                for (int j = 1; j < 4; ++j) if (gl[j] > gm) { gm = gl[j]; gs = j; }
                float den = 0.f;
#pragma unroll
                for (int j = 0; j < 4; ++j) den += expf(gl[j] - gm);
                const float gw = 1.f / den;
                float el[4] = {0.f, 0.f, 0.f, 0.f};
#pragma unroll
                for (int gg = 0; gg < 4; ++gg)
#pragma unroll
                    for (int j = 0; j < 4; ++j) if (gs == gg) el[j] = acc[4 + gg * 4 + j] + be[gg * 4 + j];
                int i1 = 0; float v1 = el[0];
#pragma unroll
                for (int j = 1; j < 4; ++j) if (el[j] > v1) { v1 = el[j]; i1 = j; }
                int i2 = -1; float v2 = -3.0e38f;
#pragma unroll
                for (int j = 0; j < 4; ++j) if (j != i1 && el[j] > v2) { v2 = el[j]; i2 = j; }
                const float t1 = 1.f / (1.f + expf(v2 - v1)), t2 = 1.f - t1;
                const int e1 = gs * 4 + i1, e2 = gs * 4 + i2;
                tok_e[t * 2] = e1; tok_e[t * 2 + 1] = e2; tok_w[t * 2] = gw * t1; tok_w[t * 2 + 1] = gw * t2;
                tok_rank[t * 2] = (int)atomicAdd(cnt + e1, 1u); tok_rank[t * 2 + 1] = (int)atomicAdd(cnt + e2, 1u);
            }
        }
    }
}
__device__ __forceinline__ void ph_moe_permute(const Params& p, int l, int bx, int G) {
    const int tid = otid(), lane = tid & 63, w = tid >> 6;
    const unsigned* cnt = (const unsigned*)(p.ws + WS_CTL) + CW_CNT + l * 16;
    const int* tok_e = (const int*)(p.ws + WS_ROUTE); const float* tok_w = (const float*)(p.ws + WS_ROUTE + 131072); const int* tok_rank = (const int*)(p.ws + WS_ROUTE + 262144);
    int* POS = (int*)(p.ws + WS_POS); float* wperm = (float*)(p.ws + WS_WPERM); int* tilex = (int*)(p.ws + WS_TILEX);
    const bf16_t* H = (const bf16_t*)(p.ws + WS_H); bf16_t* AP = (bf16_t*)(p.ws + WS_APERM);
    int offs[17]; offs[0] = 0;
#pragma unroll
    for (int e = 0; e < 16; ++e) offs[e + 1] = offs[e] + (int)((cnt[e] + 255u) & ~255u);
    if (bx == 0 && tid < 160) {
        if (tid == 0) tilex[0] = offs[16] >> 8;
        int ex = 0;
#pragma unroll
        for (int e = 1; e < 16; ++e) ex = (tid * 256 >= offs[e]) ? e : ex;
        if (tid * 256 < offs[16]) tilex[1 + tid] = ex;
    }
    for (int it = bx * NWAVES + w; it < NT * 2; it += G * NWAVES) {
        const int e = tok_e[it], rank = tok_rank[it];
        int off = 0;
#pragma unroll
        for (int q = 0; q < 16; ++q) off = (e == q) ? offs[q] : off;
        const int pos = off + rank;
        const bf16_t* src = H + (size_t)(it >> 1) * DM + lane * 8; bf16_t* dst = AP + (size_t)pos * DM + lane * 8;
        const u32x4 a = *(const u32x4*)src, bq = *(const u32x4*)(src + 512);
        *(u32x4*)dst = a; *(u32x4*)(dst + 512) = bq;
        if (lane == 0) { POS[it] = pos; wperm[pos] = tok_w[it]; }
    }
}
struct MoeOrder {
    int G, c, nct; const int* tilex;
    __device__ bool next(int i, pg8::Unit& u) const {
        const int L = i * G + c, nt = tilex[0]; if (L >= nt * nct) return false;
        const int rt = L / nct, ct = L - rt * nct; u.pm = rt; u.pn = tilex[1 + rt] * nct + ct; return true;
    }
    __device__ size_t aoff(const pg8::Unit& u, size_t tstepA) const { return (size_t)u.pm * tstepA; }
};
struct EpiMoeH {
    bf16_t* HID; const float* wperm;
    __device__ __forceinline__ void operator()(const AccT& acc, const pg8::Unit& u, int wr, int wc, int fr, int fq) const {
        const int row0 = u.pm * 256 + wr * 64 + fr, f0 = (u.pn & 1) * 128 + wc * 16 + 4 * fq;
#pragma unroll
        for (int ai = 0; ai < 2; ++ai)
#pragma unroll
            for (int m = 0; m < 4; ++m) {
                const int row = row0 + ai * 128 + m * 16; const float wt = wperm[row];
#pragma unroll
                for (int bj = 0; bj < 2; ++bj) {
                    const f32x4 v0 = acc[ai][bj][m][0], v1 = acc[ai][bj][m][1];
                    const float h0 = v0[0] * __builtin_amdgcn_rcpf(1.f + __expf(-v0[0])) * v0[1] * wt, h1 = v0[2] * __builtin_amdgcn_rcpf(1.f + __expf(-v0[2])) * v0[3] * wt;
                    const float h2 = v1[0] * __builtin_amdgcn_rcpf(1.f + __expf(-v1[0])) * v1[1] * wt, h3 = v1[2] * __builtin_amdgcn_rcpf(1.f + __expf(-v1[2])) * v1[3] * wt;
                    u32x2 o; o.x = cvt_pk_bf16(h0, h1); o.y = cvt_pk_bf16(h2, h3);
                    *(u32x2*)(HID + (size_t)row * 256 + f0 + bj * 64) = o;
                }
            }
    }
};
__device__ __forceinline__ void ph_moe_gemm1(const Params& p, LAS unsigned char* lds, int bx, int G) {
    pg8::Gemm g{(const bf16_t*)(p.ws + WS_APERM), (const bf16_t*)(p.ws + WS_WGU), 1024, 2048u, 128u};
    MoeOrder S{G, bx, 2, (const int*)(p.ws + WS_TILEX)};
    EpiMoeH E{(bf16_t*)(p.ws + WS_HIDP), (const float*)(p.ws + WS_WPERM)};
    pg8::gemm_phase<EpiMoeH, MoeOrder>(lds, g, S, E);
}
__device__ __forceinline__ void ph_moe_gemm2(const Params& p, LAS unsigned char* lds, int bx, int G) {
    pg8::Gemm g{(const bf16_t*)(p.ws + WS_HIDP), (const bf16_t*)(p.ws + WS_WD), 256, 512u, 128u};
    MoeOrder S{G, bx, 4, (const int*)(p.ws + WS_TILEX)};
    EpiBf16 E{(bf16_t*)(p.ws + WS_Y), 1024, 3};
    pg8::gemm_phase<EpiBf16, MoeOrder>(lds, g, S, E);
}


__device__ __forceinline__ void ph_mod(const Params& p, LAS unsigned char* lds, int bx, int G) {
    const int tid = otid();
    LAS float* cs = (LAS float*)lds;
    LAS float* red = (LAS float*)(lds + 16384);
    float* mod = (float*)(p.ws + WS_MOD);
    for (int i = tid; i < 4096; i += NTHR) { const float v = p.in[1][i]; cs[i] = v / (1.f + expf(-v)); }
    __syncthreads();
    const int col = tid & 127, ch = tid >> 7;
    for (int it = bx; it < 4 * 48; it += G) {
        const int l = it / 48, j = (it % 48) * 128 + col;
        const float* w = p.in[5] + (size_t)l * 1024 * 6144 + (size_t)(ch * 256) * 6144 + j;
        float a0 = 0.f, a1 = 0.f, a2 = 0.f, a3 = 0.f;
#pragma unroll 8
        for (int i = 0; i < 256; ++i) { const float wv = w[(size_t)i * 6144]; const int ii = ch * 256 + i; a0 += cs[ii] * wv; a1 += cs[1024 + ii] * wv; a2 += cs[2048 + ii] * wv; a3 += cs[3072 + ii] * wv; }
        red[(ch * 4 + 0) * 128 + col] = a0; red[(ch * 4 + 1) * 128 + col] = a1; red[(ch * 4 + 2) * 128 + col] = a2; red[(ch * 4 + 3) * 128 + col] = a3;
        __syncthreads();
        {
            const float sum = red[(0 * 4 + ch) * 128 + col] + red[(1 * 4 + ch) * 128 + col] + red[(2 * 4 + ch) * 128 + col] + red[(3 * 4 + ch) * 128 + col];
            mod[(size_t)(l * 4 + ch) * 6144 + j] = sum + p.in[6][l * 6144 + j];
        }
        __syncthreads();
    }
}
__device__ __forceinline__ void ph_rope(const Params& p, int bx, int G) {
    float* tab = (float*)(p.ws + WS_ROPE);
    for (int i = bx * NTHR + otid(); i < SEQ * 8; i += G * NTHR) {
        const int pos = i >> 3, j = i & 7;
        const float inv = (float)pow(500000.0, -(double)j / 8.0);
        const float ang = (float)pos * inv;
        tab[i] = (float)cos((double)ang); tab[SEQ * 8 + i] = (float)sin((double)ang);
    }
}

#define XB_TMO      128
#define XB_XCNT(j)  (256  + 64 * (j))
#define XB_XSUB(j)  (1280 + 64 * (j))
#define XB_XGEN(j)  (2304 + 64 * (j))
#define XB_TOP      3328
#define XB_TOPGEN   3392
#define XCD_BAR_WORDS 3456
#define XB_SPIN_CAP (1u << 18)
__device__ __forceinline__ unsigned xb_ld(unsigned* p)              { return __hip_atomic_load(p, __ATOMIC_RELAXED, __HIP_MEMORY_SCOPE_AGENT); }
__device__ __forceinline__ unsigned xb_add(unsigned* p, unsigned v) { return __hip_atomic_fetch_add(p, v, __ATOMIC_RELAXED, __HIP_MEMORY_SCOPE_AGENT); }
__device__ __forceinline__ unsigned xb_xcc_id() { return (unsigned)__builtin_amdgcn_s_getreg((3 << 11) | 20) & 0xFu; }
#define XB_SPIN(cond, bar) do { unsigned _sp = 0; while (cond) { __builtin_amdgcn_s_sleep(1); \
    if ((++_sp & 255u) == 0u) { if (xb_ld(&(bar)[XB_TMO])) break; if (_sp > XB_SPIN_CAP) { atomicAdd(&(bar)[XB_TMO], 1u); break; } } } } while (0)
struct XcdBarrier { unsigned* bar; unsigned x; volatile LAS unsigned* st; };
__device__ __forceinline__ XcdBarrier xcd_barrier_post(unsigned* bar, volatile LAS unsigned* st) {
    XcdBarrier b; b.bar = bar; b.x = xb_xcc_id(); b.st = st;
    if (threadIdx.x == 0) (void)xb_add(&bar[XB_XCNT(b.x)], 1u);
    return b;
}
__device__ __forceinline__ void xcd_barrier_complete(unsigned* bar, unsigned x, unsigned& nloc, unsigned& nx) {
    const unsigned G = gridDim.x * gridDim.y * gridDim.z;
    unsigned sum, cnt, mine, sp = 0u;
    for (;;) {
        sum = 0u; cnt = 0u; mine = 0u;
#pragma unroll
        for (unsigned j = 0; j < 16; ++j) { const unsigned c = xb_ld(&bar[XB_XCNT(j)]); sum += c; cnt += (c > 0u) ? 1u : 0u; mine = (j == x) ? c : mine; }
        if (sum == G) break;
        __builtin_amdgcn_s_sleep(1);
        if ((++sp & 255u) == 0u) { if (xb_ld(&bar[XB_TMO])) break; if (sp > XB_SPIN_CAP) { atomicAdd(&bar[XB_TMO], 1u); break; } }
    }
    nloc = mine > 0u ? mine : 1u; nx = cnt > 0u ? cnt : 1u;
}
__device__ __forceinline__ void xcd_barrier(const XcdBarrier& b) {
    asm volatile("s_waitcnt vmcnt(0)" ::: "memory");
    __syncthreads();
    if (threadIdx.x == 0) {
        unsigned* bar = b.bar;
        __builtin_amdgcn_s_waitcnt(0);
        unsigned nloc = b.st[0], nx = b.st[1];
        if (nloc == 0u) { xcd_barrier_complete(bar, b.x, nloc, nx); b.st[0] = nloc; b.st[1] = nx; }
        const unsigned old = xb_add(&bar[XB_XSUB(b.x)], 1u);
        const unsigned gen = old / nloc;
        if (old + 1u == (gen + 1u) * nloc) {
            __builtin_amdgcn_fence(__ATOMIC_RELEASE, "agent");
            asm volatile("s_waitcnt vmcnt(0)" ::: "memory");
            const unsigned og = xb_add(&bar[XB_TOP], 1u);
            const unsigned tg = og / nx;
            if (og + 1u == (tg + 1u) * nx) xb_add(&bar[XB_TOPGEN], 1u);
            else XB_SPIN(xb_ld(&bar[XB_TOPGEN]) == tg, bar);
            __builtin_amdgcn_fence(__ATOMIC_ACQUIRE, "agent");
            xb_add(&bar[XB_XGEN(b.x)], 1u);
            asm volatile("s_waitcnt vmcnt(0)" ::: "memory");
        } else {
            XB_SPIN(xb_ld(&bar[XB_XGEN(b.x)]) == gen, bar);
            __builtin_amdgcn_fence(__ATOMIC_ACQUIRE, "agent");
            asm volatile("s_waitcnt vmcnt(0)" ::: "memory");
        }
    }
    __syncthreads();
}
constexpr int CW_BAR = 4096;
constexpr int LDS_XB = 131072 + 512;

__global__ void __launch_bounds__(NTHR, 2) mega_fwd(Params p) {
    extern __shared__ __attribute__((aligned(16))) unsigned char lds_raw[];
    LAS unsigned char* lds = (LAS unsigned char*)lds_raw;
    const int bx = blockIdx.x, G = gridDim.x;
    typedef const Params __attribute__((address_space(4)))* CP;
    CP kp = (CP)__builtin_amdgcn_kernarg_segment_ptr();
#define LP() ({ CP q_ = kp; asm volatile("" : "+s"(q_)); Params r_; _Pragma("unroll") for (int i_ = 0; i_ < 25; ++i_) r_.in[i_] = q_->in[i_]; r_.out = q_->out; r_.ws = q_->ws; r_; })
    if (threadIdx.x < 4) ((LAS unsigned*)(lds + LDS_XB))[threadIdx.x] = 0u;
    __syncthreads();
    const XcdBarrier bar = xcd_barrier_post((unsigned*)(kp->ws + WS_CTL) + CW_BAR, (volatile LAS unsigned*)(lds + LDS_XB));
#define GRID_BAR() do { XcdBarrier b2_ = bar; asm volatile("" : "+s"(b2_.bar), "+s"(b2_.x)); xcd_barrier(b2_); } while (0)
    { const Params pp = LP(); ph_conv_static(pp, lds, bx, G); }
    __syncthreads();
    { const Params pp = LP(); ph_mod(pp, lds, bx, G); }
    { const Params pp = LP(); ph_rope(pp, bx, G); }
    { const Params pp = LP(); ph_misc(pp, bx, G); }
    GRID_BAR();
#pragma unroll 1
    for (int l = 0; l < DEPTH; ++l) {
        { const Params pp = LP(); ph_norm<0>(pp, l, bx, G); }
        { const Params pp = LP(); ph_conv_moe(pp, lds, l, bx, G); }
        GRID_BAR();
        { const Params pp = LP(); ph_inproj(pp, lds, l, bx, G); }
        GRID_BAR();
        if ((l & 1) == 0) {
            { const Params pp = LP(); ph_moba_kmean(pp, lds, bx, G); }
            GRID_BAR();
            { const Params pp = LP(); ph_attn_even(pp, lds, bx, G); }
            GRID_BAR();
            { const Params pp = LP(); ph_diff_combine(pp, l, bx, G); }
            GRID_BAR();
        } else {
            { const Params pp = LP(); ph_compress1(pp, lds, l, bx, G); }
            GRID_BAR();
            { const Params pp = LP(); ph_compress2(pp, l, bx, G); }
            GRID_BAR();
            { const Params pp = LP(); ph_attn_odd(pp, lds, bx, G); }
            GRID_BAR();
        }
        { const Params pp = LP(); ph_outproj(pp, lds, l, bx, G); }
        GRID_BAR();
        { const Params pp = LP(); ph_norm<1>(pp, l, bx, G); }
        GRID_BAR();
        { const Params pp = LP(); ph_moe_permute(pp, l, bx, G); }
        GRID_BAR();
        { const Params pp = LP(); ph_moe_gemm1(pp, lds, bx, G); }
        GRID_BAR();
        { const Params pp = LP(); ph_moe_gemm2(pp, lds, bx, G); }
        GRID_BAR();
    }
    { const Params pp = LP(); ph_norm<2>(pp, 0, bx, G); }
#undef GRID_BAR
}

__global__ void __launch_bounds__(NTHR, 2) kw_conv_static(Params p) { extern __shared__ __attribute__((aligned(16))) unsigned char lds[]; ph_conv_static(p, (LAS unsigned char*)lds, blockIdx.x, gridDim.x); }
__global__ void __launch_bounds__(NTHR, 2) kw_conv_moe(Params p, int l) { extern __shared__ __attribute__((aligned(16))) unsigned char lds[]; ph_conv_moe(p, (LAS unsigned char*)lds, l, blockIdx.x, gridDim.x); }
__global__ void __launch_bounds__(NTHR, 2) kw_inproj(Params p, int l) { extern __shared__ __attribute__((aligned(16))) unsigned char lds[]; ph_inproj(p, (LAS unsigned char*)lds, l, blockIdx.x, gridDim.x); }
__global__ void __launch_bounds__(NTHR, 2) kw_kmean(Params p) { extern __shared__ __attribute__((aligned(16))) unsigned char lds[]; ph_moba_kmean(p, (LAS unsigned char*)lds, blockIdx.x, gridDim.x); }
__global__ void __launch_bounds__(NTHR, 2) kw_attn_even(Params p) { extern __shared__ __attribute__((aligned(16))) unsigned char lds[]; ph_attn_even(p, (LAS unsigned char*)lds, blockIdx.x, gridDim.x); }
__global__ void __launch_bounds__(NTHR, 2) kw_diff_combine(Params p, int l) { ph_diff_combine(p, l, blockIdx.x, gridDim.x); }
__global__ void __launch_bounds__(NTHR, 2) kw_misc(Params p) { ph_misc(p, blockIdx.x, gridDim.x); }
__global__ void __launch_bounds__(NTHR, 2) kw_compress1(Params p, int l) { extern __shared__ __attribute__((aligned(16))) unsigned char lds[]; ph_compress1(p, (LAS unsigned char*)lds, l, blockIdx.x, gridDim.x); }
__global__ void __launch_bounds__(NTHR, 2) kw_compress2(Params p, int l) { ph_compress2(p, l, blockIdx.x, gridDim.x); }
__global__ void __launch_bounds__(NTHR, 2) kw_attn_odd(Params p) { extern __shared__ __attribute__((aligned(16))) unsigned char lds[]; ph_attn_odd(p, (LAS unsigned char*)lds, blockIdx.x, gridDim.x); }
__global__ void __launch_bounds__(NTHR, 2) kw_norm0(Params p, int l) { ph_norm<0>(p, l, blockIdx.x, gridDim.x); }
__global__ void __launch_bounds__(NTHR, 2) kw_norm1(Params p, int l) { ph_norm<1>(p, l, blockIdx.x, gridDim.x); }
__global__ void __launch_bounds__(NTHR, 2) kw_norm2(Params p) { ph_norm<2>(p, 0, blockIdx.x, gridDim.x); }
__global__ void __launch_bounds__(NTHR, 2) kw_permute(Params p, int l) { ph_moe_permute(p, l, blockIdx.x, gridDim.x); }
__global__ void __launch_bounds__(NTHR, 2) kw_moe1(Params p) { extern __shared__ __attribute__((aligned(16))) unsigned char lds[]; ph_moe_gemm1(p, (LAS unsigned char*)lds, blockIdx.x, gridDim.x); }
__global__ void __launch_bounds__(NTHR, 2) kw_moe2(Params p) { extern __shared__ __attribute__((aligned(16))) unsigned char lds[]; ph_moe_gemm2(p, (LAS unsigned char*)lds, blockIdx.x, gridDim.x); }
__global__ void __launch_bounds__(NTHR, 2) kw_outproj(Params p, int l) { extern __shared__ __attribute__((aligned(16))) unsigned char lds[]; ph_outproj(p, (LAS unsigned char*)lds, l, blockIdx.x, gridDim.x); }

static ColMap mk_map(int nsec, const int (*s)[3]) { ColMap c; memset(&c, 0, sizeof(c)); c.nsec = nsec; for (int i = 0; i < 8; ++i) { c.out0[i] = c.src0[i] = c.len[i] = 0; } for (int i = 0; i < nsec; ++i) { c.out0[i] = s[i][0]; c.src0[i] = s[i][1]; c.len[i] = s[i][2]; } return c; }

static void kernel_launch_multi(void* const* d_in, const int* in_sizes, int n_in, void* d_out, int out_size, void* d_ws, size_t ws_size, hipStream_t stream) {
    if (ws_size < WS_END2) { fprintf(stderr, "workspace too small: %zu < %zu\n", ws_size, (size_t)WS_END2); return; }
    const float* x = (const float*)d_in[0]; const float* c = (const float*)d_in[1];
    const float* norm1_g = (const float*)d_in[2]; const float* norm2_g = (const float*)d_in[3]; const float* final_g = (const float*)d_in[4];
    const float* ada_w = (const float*)d_in[5]; const float* ada_b = (const float*)d_in[6];
    const float* ev_w_in = (const float*)d_in[7]; const float* ev_w_out = (const float*)d_in[8]; const float* ev_lambda = (const float*)d_in[9]; const float* ev_subln = (const float*)d_in[10];
    const float* od_w_in = (const float*)d_in[11]; const float* od_w_out = (const float*)d_in[12]; const float* od_pos = (const float*)d_in[13];
    const float* od_w1 = (const float*)d_in[14]; const float* od_b1 = (const float*)d_in[15]; const float* od_w2 = (const float*)d_in[16]; const float* od_b2 = (const float*)d_in[17];
    const float* moe_wg = (const float*)d_in[18]; const float* moe_bg = (const float*)d_in[19]; const float* moe_we = (const float*)d_in[20]; const float* moe_be = (const float*)d_in[21];
    const float* moe_wgate = (const float*)d_in[22]; const float* moe_wup = (const float*)d_in[23]; const float* moe_wdown = (const float*)d_in[24];
    unsigned char* ws = (unsigned char*)d_ws;
    unsigned* ctl = (unsigned*)(ws + WS_CTL); float* mod = (float*)(ws + WS_MOD); float* rope = (float*)(ws + WS_ROPE); float* misc = (float*)(ws + WS_MISC);
    float* kmean = (float*)(ws + WS_KMEAN); u64* mmask = (u64*)(ws + WS_MMASK); u64* smask = (u64*)(ws + WS_SMASK);
    bf16_t* KCMP = (bf16_t*)(ws + WS_KCMP); bf16_t* VCMPT = (bf16_t*)(ws + WS_VCMPT); bf16_t* CH = (bf16_t*)(ws + WS_CH);
    int* tok_e = (int*)(ws + WS_ROUTE); float* tok_w = (float*)(ws + WS_ROUTE + 131072); int* tok_rank = (int*)(ws + WS_ROUTE + 262144);
    float* X = (float*)(ws + WS_X); bf16_t* H = (bf16_t*)(ws + WS_H); bf16_t* P = (bf16_t*)(ws + WS_P); bf16_t* VT = (bf16_t*)(ws + WS_VT);
    bf16_t* O = (bf16_t*)(ws + WS_O); float* DT = (float*)(ws + WS_DT); float* PF = (float*)(ws + WS_PF);
    float* HID = (float*)(ws + WS_P);

    Params prm; memset(&prm, 0, sizeof(prm)); for (int i = 0; i < 25; ++i) prm.in[i] = (const float*)d_in[i]; prm.out = (float*)d_out; prm.ws = ws;
    static int attr_done = 0;
    if (!attr_done) { attr_done = 1;
        (void)hipFuncSetAttribute((const void*)kw_conv_static, hipFuncAttributeMaxDynamicSharedMemorySize, LDS_BYTES);
        (void)hipFuncSetAttribute((const void*)kw_conv_moe, hipFuncAttributeMaxDynamicSharedMemorySize, LDS_BYTES);
        (void)hipFuncSetAttribute((const void*)kw_inproj, hipFuncAttributeMaxDynamicSharedMemorySize, LDS_BYTES);
        (void)hipFuncSetAttribute((const void*)kw_outproj, hipFuncAttributeMaxDynamicSharedMemorySize, LDS_BYTES);
        (void)hipFuncSetAttribute((const void*)kw_kmean, hipFuncAttributeMaxDynamicSharedMemorySize, LDS_BYTES);
        (void)hipFuncSetAttribute((const void*)kw_moe1, hipFuncAttributeMaxDynamicSharedMemorySize, LDS_BYTES);
        (void)hipFuncSetAttribute((const void*)kw_moe2, hipFuncAttributeMaxDynamicSharedMemorySize, LDS_BYTES);
        (void)hipFuncSetAttribute((const void*)kw_compress1, hipFuncAttributeMaxDynamicSharedMemorySize, LDS_BYTES);
        (void)hipFuncSetAttribute((const void*)kw_attn_odd, hipFuncAttributeMaxDynamicSharedMemorySize, LDS_BYTES);
        (void)hipFuncSetAttribute((const void*)kw_attn_even, hipFuncAttributeMaxDynamicSharedMemorySize, LDS_BYTES);
    }
    const int GRID = 256;
    (void)hipMemsetAsync(ctl, 0, 1 * MiB, stream);
    kw_conv_static<<<GRID, NTHR, LDS_BYTES, stream>>>(prm);
    k_mod<<<dim3(24, 4), 256, 0, stream>>>(c, ada_w, ada_b, mod);
    k_rope<<<128, 256, 0, stream>>>(rope);
    kw_misc<<<GRID, NTHR, 0, stream>>>(prm);

    for (int l = 0; l < DEPTH; ++l) {
        const float* modl = mod + (size_t)l * 4 * 6144;
        const float* xin = (l == 0) ? x : X;
        const int li = l >> 1;
        kw_norm0<<<GRID, NTHR, 0, stream>>>(prm, l);
        kw_conv_moe<<<GRID, NTHR, LDS_BYTES, stream>>>(prm, l);
        if ((l & 1) == 0) {
            const float* w_in = ev_w_in + (size_t)li * 1024 * 3072;
            kw_inproj<<<GRID, NTHR, LDS_BYTES, stream>>>(prm, l);
            kw_kmean<<<GRID, NTHR, LDS_BYTES, stream>>>(prm);
            kw_attn_even<<<GRID, NTHR, LDS_BYTES, stream>>>(prm);
            kw_diff_combine<<<GRID, NTHR, 0, stream>>>(prm, l);
            kw_outproj<<<GRID, NTHR, LDS_BYTES, stream>>>(prm, l);
        } else {
            const float* w_in = od_w_in + (size_t)li * 1024 * 2608;
            kw_inproj<<<GRID, NTHR, LDS_BYTES, stream>>>(prm, l);
            kw_compress1<<<GRID, NTHR, LDS_BYTES, stream>>>(prm, l);
            kw_compress2<<<GRID, NTHR, 0, stream>>>(prm, l);
            kw_attn_odd<<<GRID, NTHR, LDS_BYTES, stream>>>(prm);
            kw_outproj<<<GRID, NTHR, LDS_BYTES, stream>>>(prm, l);
        }
        kw_norm1<<<GRID, NTHR, 0, stream>>>(prm, l);
        kw_permute<<<GRID, NTHR, 0, stream>>>(prm, l);
        kw_moe1<<<GRID, NTHR, LDS_BYTES, stream>>>(prm);
        kw_moe2<<<GRID, NTHR, LDS_BYTES, stream>>>(prm);
    }
    kw_norm2<<<GRID, NTHR, 0, stream>>>(prm);
}

extern "C" void kernel_launch(void* const* d_in, const int* in_sizes, int n_in, void* d_out, int out_size, void* d_ws, size_t ws_size, hipStream_t stream) {
    static int grid = 0;
    if (grid == 0) {
        if (n_in != 25 || out_size != NT * DM || ws_size < WS_END2) { fprintf(stderr, "kernel_launch: unexpected shapes / workspace (n_in %d out %d ws %zu, need %zu)\n", n_in, out_size, ws_size, (size_t)WS_END2); grid = -1; return; }
        int dev = 0, cus = 0;
        if (hipGetDevice(&dev) != hipSuccess || hipDeviceGetAttribute(&cus, hipDeviceAttributeMultiprocessorCount, dev) != hipSuccess) { grid = -1; return; }
        if (hipFuncSetAttribute((const void*)mega_fwd, hipFuncAttributeMaxDynamicSharedMemorySize, LDS_BYTES) != hipSuccess) { fprintf(stderr, "kernel_launch: hipFuncSetAttribute failed\n"); grid = -1; return; }
        int per_cu = 0;
        if (hipOccupancyMaxActiveBlocksPerMultiprocessor(&per_cu, (const void*)mega_fwd, NTHR, LDS_BYTES) != hipSuccess || per_cu < 1) { fprintf(stderr, "kernel_launch: occupancy query says %d\n", per_cu); }
        (void)hipGetLastError();
        grid = cus < 256 ? cus : 256;
    }
    if (grid < 0) return;
    Params prm; memset(&prm, 0, sizeof(prm)); for (int i = 0; i < 25; ++i) prm.in[i] = (const float*)d_in[i]; prm.out = (float*)d_out; prm.ws = (unsigned char*)d_ws;
    (void)hipMemsetAsync(d_ws, 0, 1 * MiB, stream);
    mega_fwd<<<grid, NTHR, LDS_BYTES, stream>>>(prm);
}
```

```cpp
#include <hip/hip_runtime.h>
#include <stdint.h>
#include <stdio.h>
#include <string.h>

typedef unsigned short bf16_t;
typedef unsigned long long u64;

constexpr int NB = 4, SEQ = 4096, DM = 1024, NT = NB * SEQ, DEPTH = 4;
constexpr int PW = 2048;
constexpr float C2 = 0.125f * 1.4426950408889634f;
constexpr float NEGBIG = -1e30f;
constexpr float LINIT0 = 0.2f, LINIT1 = 0.47071301834358416f;

constexpr size_t MiB = 1u << 20;
constexpr size_t WS_CTL = 0;
constexpr size_t WS_MOD = 1 * MiB;
constexpr size_t WS_ROPE = 2 * MiB;
constexpr size_t WS_MISC = 3 * MiB;
constexpr size_t WS_KMEAN = 3 * MiB + 65536;
constexpr size_t WS_MMASK = 4 * MiB;
constexpr size_t WS_SMASK = 5 * MiB;
constexpr size_t WS_KCMP = 6 * MiB;
constexpr size_t WS_VCMPT = 6 * MiB + 524288;
constexpr size_t WS_CH = 7 * MiB;
constexpr size_t WS_ROUTE = 11 * MiB;
constexpr size_t WS_X = 16 * MiB;
constexpr size_t WS_H = 80 * MiB;
constexpr size_t WS_R = 112 * MiB;
constexpr size_t WS_P = WS_R;
constexpr size_t WS_VT = WS_R + 64 * MiB;
constexpr size_t WS_O = WS_R + 96 * MiB;
constexpr size_t WS_DT = WS_R + 128 * MiB;
constexpr size_t WS_PF = WS_R + 64 * MiB;
constexpr size_t WS_END = 304 * MiB;

constexpr int CW_CNT = 64;

__device__ __forceinline__ bf16_t f2bf(float f) { unsigned u = __float_as_uint(f); u = (u + 0x7fffu + ((u >> 16) & 1u)) >> 16; return (bf16_t)u; }
__device__ __forceinline__ float bf2f(bf16_t h) { return __uint_as_float(((unsigned)h) << 16); }
__device__ __forceinline__ float wave_sum(float v) {
#pragma unroll
    for (int o = 32; o >= 1; o >>= 1) v += __shfl_xor(v, o);
    return v;
}

#define LAS __attribute__((address_space(3)))
#define ST16_WT(ptr, val) asm volatile("global_store_dwordx4 %0, %1, off sc0 sc1\n\ts_nop 1" :: "v"(ptr), "v"(val) : "memory")
typedef short bf16x8 __attribute__((ext_vector_type(8)));
typedef float f32x4 __attribute__((ext_vector_type(4)));
typedef float f32x16 __attribute__((ext_vector_type(16)));
typedef unsigned u32x4 __attribute__((ext_vector_type(4)));
typedef unsigned u32x2 __attribute__((ext_vector_type(2)));

constexpr int NWAVES = 8, NTHR = 512;
constexpr int LDS_BYTES = 147456;
constexpr size_t WS_WIN = 304 * MiB;
constexpr size_t WS_WOUT = 328 * MiB;
constexpr size_t WS_W1T = 336 * MiB;
constexpr size_t WS_WGU = 340 * MiB;
constexpr size_t WS_WD = 356 * MiB;
constexpr size_t WS_END2 = 364 * MiB;
constexpr size_t WS_VCX = 12 * MiB;
constexpr size_t WS_FOLD = WS_MISC + 1024;
constexpr int MP_ROWS = 36864;
constexpr size_t WS_APERM = WS_R;
constexpr size_t WS_HIDP = WS_R + 72 * MiB;
constexpr size_t WS_Y = WS_R + 96 * MiB;
constexpr size_t WS_POS = WS_ROUTE + 393216;
constexpr size_t WS_WPERM = WS_ROUTE + 524288;
constexpr size_t WS_TILEX = WS_ROUTE + 786432;
constexpr size_t WS_ROWTOK = WS_ROUTE + 868352;
constexpr size_t WS_BCNT = WS_ROUTE + 851968;

struct Params { const float* in[25]; float* out; unsigned char* ws; };
__device__ __forceinline__ int otid() { int t = threadIdx.x; asm volatile("" : "+v"(t)); return t; }

__device__ __forceinline__ unsigned pk2(float lo, float hi) { return (unsigned)f2bf(lo) | ((unsigned)f2bf(hi) << 16); }
__device__ __forceinline__ unsigned cvt_pk_bf16(float lo, float hi) { unsigned r; asm volatile("v_cvt_pk_bf16_f32 %0, %1, %2" : "=v"(r) : "v"(lo), "v"(hi)); return r; }

__device__ __forceinline__ void conv_item(const float* W, int ldw, int col0, int nvalid, int K, bf16_t* WT, int row0, int rmul, LAS float* scr, int item, int nblk, int lane) {
    const int kb = item / nblk, nb = item % nblk, k0 = 64 * kb, n0 = 64 * nb;
    const int c4 = lane & 15, rr = lane >> 4;
    const bool okc = (n0 + 4 * c4) < nvalid;
    f32x4 v[16];
#pragma unroll
    for (int i = 0; i < 16; ++i) v[i] = okc ? *(const f32x4*)(W + (size_t)(k0 + rr + 4 * i) * ldw + col0 + n0 + 4 * c4) : (f32x4){0.f, 0.f, 0.f, 0.f};
#pragma unroll
    for (int i = 0; i < 16; ++i) { const int kk = rr + 4 * i;
        scr[(4 * c4 + 0) * 65 + kk] = v[i][0]; scr[(4 * c4 + 1) * 65 + kk] = v[i][1]; scr[(4 * c4 + 2) * 65 + kk] = v[i][2]; scr[(4 * c4 + 3) * 65 + kk] = v[i][3]; }
    asm volatile("s_waitcnt lgkmcnt(0)" ::: "memory");
    const int c = lane & 7;
#pragma unroll
    for (int j = 0; j < 8; ++j) { const int n = (lane >> 3) + 8 * j; const LAS float* sp = scr + n * 65 + 8 * c;
        u32x4 o; o.x = pk2(sp[0], sp[1]); o.y = pk2(sp[2], sp[3]); o.z = pk2(sp[4], sp[5]); o.w = pk2(sp[6], sp[7]);
        *(u32x4*)(WT + (size_t)(row0 + (n0 + n) * rmul) * K + k0 + 8 * c) = o; }
    asm volatile("s_waitcnt lgkmcnt(0)" ::: "memory");
}
struct ConvCtx { LAS float* scr; int gw, NGW, lane, base; };
__device__ __forceinline__ void conv_job(ConvCtx& cx, const float* W, int ldw, int col0, int ncols, int nvalid, int K, bf16_t* WT, int row0, int rmul) {
    const int nblk = ncols / 64, nitems = (K / 64) * nblk;
    int it = cx.gw - (cx.base % cx.NGW); if (it < 0) it += cx.NGW;
    for (; it < nitems; it += cx.NGW) conv_item(W, ldw, col0, nvalid, K, WT, row0, rmul, cx.scr, it, nblk, cx.lane);
    cx.base += nitems;
}
__device__ __forceinline__ void ph_conv_static(const Params& p, LAS unsigned char* lds, int vcu, int G) {
    const int tid = otid(), lane = tid & 63, wave = tid >> 6;
    ConvCtx cx; cx.scr = (LAS float*)(lds + wave * 16640); cx.gw = vcu * NWAVES + wave; cx.NGW = G * NWAVES; cx.lane = lane; cx.base = 0;
    for (int l = 0; l < DEPTH; ++l) {
        const int li = l >> 1;
        bf16_t* win = (bf16_t*)(p.ws + WS_WIN) + (size_t)l * 3072 * 1024;
        bf16_t* wout = (bf16_t*)(p.ws + WS_WOUT) + (size_t)l * 1024 * 1024;
        if ((l & 1) == 0) {
            const float* w = p.in[7] + (size_t)li * 1024 * 3072;
            conv_job(cx, w, 3072, 0, 512, 512, 1024, win, 0, 1);
            conv_job(cx, w, 3072, 512, 512, 512, 1024, win, 512, 1);
            conv_job(cx, w, 3072, 1536, 512, 512, 1024, win, 1024, 1);
            conv_job(cx, w, 3072, 2048, 512, 512, 1024, win, 1536, 1);
            conv_job(cx, w, 3072, 1024, 512, 512, 1024, win, 2048, 1);
            conv_job(cx, w, 3072, 2560, 512, 512, 1024, win, 2560, 1);
            conv_job(cx, p.in[8] + (size_t)li * 1024 * 1024, 1024, 0, 1024, 1024, 1024, wout, 0, 1);
        } else {
            const float* w = p.in[11] + (size_t)li * 1024 * 2608;
            conv_job(cx, w, 2608, 0, 1024, 1024, 1024, win, 0, 1);
            conv_job(cx, w, 2608, 1024, 256, 256, 1024, win, 1024, 1);
            conv_job(cx, w, 2608, 1536, 256, 256, 1024, win, 1280, 1);
            conv_job(cx, w, 2608, 2048, 256, 256, 1024, win, 1536, 1);
            conv_job(cx, w, 2608, 1280, 256, 256, 1024, win, 1792, 1);
            conv_job(cx, w, 2608, 1792, 256, 256, 1024, win, 2048, 1);
            conv_job(cx, w, 2608, 2304, 256, 256, 1024, win, 2304, 1);
            conv_job(cx, w, 2608, 2560, 256, 48, 1024, win, 2560, 1);
            conv_job(cx, p.in[12] + (size_t)li * 1024 * 1024, 1024, 0, 1024, 1024, 1024, wout, 0, 1);
            bf16_t* w1t = (bf16_t*)(p.ws + WS_W1T) + (size_t)li * 2 * 256 * 2048;
            conv_job(cx, p.in[14] + (size_t)(li * 2 + 0) * 2048 * 256, 256, 0, 256, 256, 2048, w1t, 0, 1);
            conv_job(cx, p.in[14] + (size_t)(li * 2 + 1) * 2048 * 256, 256, 0, 256, 256, 2048, w1t + (size_t)256 * 2048, 0, 1);
        }
    }
}
__device__ __forceinline__ void ph_zero_kmsum(const Params& p, int bx, int G) {
    float* km = (float*)(p.ws + WS_KMEAN);
    int gstride = G * NTHR; asm volatile("" : "+s"(gstride));
    float z = 0.f; asm volatile("" : "+v"(z));
    for (int i = bx * NTHR + otid(); i < NB * 8 * 16 * 64; i += gstride) km[i] = z;
}
__device__ __forceinline__ void ph_conv_moe(const Params& p, LAS unsigned char* lds, int l, int vcu, int G) {
    const int tid = otid(), lane = tid & 63, wave = tid >> 6;
    ConvCtx cx; cx.scr = (LAS float*)(lds + wave * 16640); cx.gw = vcu * NWAVES + wave; cx.NGW = G * NWAVES; cx.lane = lane; cx.base = 0;
    bf16_t* wgu = (bf16_t*)(p.ws + WS_WGU); bf16_t* wd = (bf16_t*)(p.ws + WS_WD);
    for (int e = 0; e < 16; ++e) {
        conv_job(cx, p.in[22] + (size_t)(l * 16 + e) * 1024 * 256, 256, 0, 256, 256, 1024, wgu + (size_t)e * 512 * 1024, 0, 2);
        conv_job(cx, p.in[23] + (size_t)(l * 16 + e) * 1024 * 256, 256, 0, 256, 256, 1024, wgu + (size_t)e * 512 * 1024, 1, 2);
        conv_job(cx, p.in[24] + (size_t)(l * 16 + e) * 256 * 1024, 1024, 0, 1024, 1024, 256, wd + (size_t)e * 1024 * 256, 0, 1);
    }
}

namespace pg8 {
constexpr int BM = 256, BK = 64, HALF = 128, HTB = HALF * BK * 2, STAGE_BYTES = 8 * HTB, NXCD = 8, WGM = 8;
__host__ __device__ __forceinline__ int lds_byte(int r, int c) { const int st = (r >> 4) * 2 + (c >> 5), rr = r & 15, cc = c & 31, ob = rr * 64 + cc * 2; return st * 1024 + (ob ^ (((ob >> 9) & 1) << 5)); }
__host__ __device__ __forceinline__ void stage_rc(int b, int& R, int& C) { const int st = b / 1024, sb = b % 1024, swz = sb ^ (((sb >> 9) & 1) << 5); R = (st >> 1) * 16 + swz / 64; C = (st & 1) * 32 + (swz % 64) / 2; }
__host__ __device__ __forceinline__ int perm32(int rho) { const int n = rho >> 4, i = rho & 15; return 8 * (i >> 2) + 4 * n + (i & 3); }
struct Unit { int pm, pn; };
struct Gemm { const bf16_t* A; const bf16_t* Bt; int K; unsigned lda_b; unsigned kstepA; int ldb; };
struct StaticOrder {
    static constexpr bool GATHER = false, SIGNAL = false;
    int nM, nN, nwg, G, c;
    __host__ __device__ void init(int M, int N, int G_, int c_) { nM = M / BM; nN = N / BM; nwg = nM * nN; G = G_; c = c_; }
    __host__ __device__ bool next(int i, Unit& u) const {
        const long L = (long)i * G + c; if (L >= nwg) return false;
        int wgid = (int)L; { const int q = nwg / NXCD, r = nwg % NXCD, xcd = wgid % NXCD, off = wgid / NXCD; wgid = (xcd < r ? xcd * (q + 1) : r * (q + 1) + (xcd - r) * q) + off; }
        const int nig = WGM * nN, gid = wgid / nig, fm = gid * WGM, gsz = (nM - fm) < WGM ? (nM - fm) : WGM;
        u.pm = fm + ((wgid % nig) % gsz); u.pn = (wgid % nig) / gsz; return true;
    }
    __host__ __device__ size_t aoff(const Unit& u, size_t tstepA) const { return (size_t)u.pm * tstepA; }
    __host__ __device__ size_t boff(const Unit&) const { return 0; }
};
template <class Epi, class Sched>
__device__ __forceinline__ void gemm_phase(LAS unsigned char* lds, const Gemm g, const Sched& S, const Epi& E) {
    const int tid = otid(), wid = __builtin_amdgcn_readfirstlane(tid >> 6), lane = tid & 63, wr = wid >> 2, wc = wid & 3, fr = lane & 15, fq = lane >> 4;
    const int K = g.K, nt = K / BK;
    unsigned voffA[2], voffB[2];
#pragma unroll
    for (int i = 0; i < 2; ++i) { int R, C; stage_rc(tid * 16 + i * 8192, R, C); const int Rb = (R & ~31) + perm32(R & 31);
        voffA[i] = (unsigned)R * g.lda_b + (unsigned)C * 2u; voffB[i] = (unsigned)(Rb * g.ldb + C) * 2u; }
    const size_t kstepA = g.kstepA, kstepB = (size_t)(BK * 2);
    const size_t hstepA = (size_t)HALF * g.lda_b, hstepB = (size_t)HALF * g.ldb * 2;
    const size_t tstepA = 2 * hstepA, tstepB = 2 * hstepB;
    const unsigned ldsw = (unsigned)wid * 1024u;
    const int aoff = lds_byte(wr * 64 + fr, fq * 8), boff = lds_byte(wc * 32 + fr, fq * 8);
#define PG8_SA(b, h) (((b) * 2 + (h)) * HTB)
#define PG8_SB(b, h) ((4 + (b) * 2 + (h)) * HTB)
#define PG8_STAGE(bufoff, gbase, voff) do { _Pragma("unroll") for (int _i = 0; _i < 2; ++_i) \
        __builtin_amdgcn_global_load_lds((const unsigned*)((const char*)(gbase) + (voff)[_i]), (LAS unsigned*)(lds + (bufoff) + ldsw + _i * 8192), 16, 0, 0); } while (0)
#define PG8_LDA(dst, b, h) do { _Pragma("unroll") for (int m = 0; m < 4; ++m) _Pragma("unroll") for (int k = 0; k < 2; ++k) dst[m][k] = *(const LAS bf16x8*)(lds + PG8_SA(b, h) + aoff + m * 2048 + k * 1024); } while (0)
#define PG8_LDB(dst, b, h) do { _Pragma("unroll") for (int n = 0; n < 2; ++n) _Pragma("unroll") for (int k = 0; k < 2; ++k) dst[n][k] = *(const LAS bf16x8*)(lds + PG8_SB(b, h) + boff + n * 2048 + k * 1024); } while (0)
#define PG8_MMA(ai, bj, At, Bt) do { __builtin_amdgcn_s_setprio(1); _Pragma("unroll") for (int m = 0; m < 4; ++m) _Pragma("unroll") for (int n = 0; n < 2; ++n) _Pragma("unroll") for (int k = 0; k < 2; ++k) \
        acc[ai][bj][m][n] = __builtin_amdgcn_mfma_f32_16x16x32_bf16(Bt[n][k], At[m][k], acc[ai][bj][m][n], 0, 0, 0); __builtin_amdgcn_s_setprio(0); } while (0)
#define PG8_WAIT_V(n) asm volatile("s_waitcnt vmcnt(" #n ")" ::: "memory")
#define PG8_WAIT_L(n) asm volatile("s_waitcnt lgkmcnt(" #n ")" ::: "memory")
#define PG8_BAR __builtin_amdgcn_s_barrier()
#define PG8_SCHED __builtin_amdgcn_sched_barrier(0)
    Unit cur, nxt; int ui = 0;
    if (!S.next(0, cur)) return;
    unsigned vC[2][2], vN[2][2];
    LAS int* rtl = (LAS int*)(lds + STAGE_BYTES);
    int Rg[2], Cg[2];
    if constexpr (Sched::GATHER) {
        { Unit uu; for (int i = 0; i < 15 && S.next(i, uu); ++i) if (tid < 256) rtl[i * 256 + tid] = S.rowtok[uu.pm * 256 + tid]; }
        __syncthreads();
#pragma unroll
        for (int i = 0; i < 2; ++i) stage_rc(tid * 16 + i * 8192, Rg[i], Cg[i]);
#pragma unroll
        for (int h = 0; h < 2; ++h)
#pragma unroll
            for (int i = 0; i < 2; ++i) { vC[h][i] = (unsigned)rtl[Rg[i] + 128 * h] * g.lda_b + (unsigned)Cg[i] * 2u; vN[h][i] = vC[h][i]; }
    }
#define PG8_STAGE_A(bufoff, kb, h, nx) do { if constexpr (Sched::GATHER) { unsigned vv_[2]; vv_[0] = (nx) ? vN[h][0] : vC[h][0]; vv_[1] = (nx) ? vN[h][1] : vC[h][1]; PG8_STAGE(bufoff, (const char*)g.A + (kb), vv_); } \
        else PG8_STAGE(bufoff, ((nx) ? nA : cA) + (kb) + (h) * hstepA, voffA); } while (0)
    f32x4 acc[2][2][4][2];
#pragma unroll
    for (int a = 0; a < 2; ++a)
#pragma unroll
        for (int b = 0; b < 2; ++b)
#pragma unroll
            for (int m = 0; m < 4; ++m)
#pragma unroll
                for (int n = 0; n < 2; ++n) acc[a][b][m][n] = (f32x4){0.f, 0.f, 0.f, 0.f};
    bf16x8 At[4][2], B0[2][2], B1[2][2];
    const char* cA = (const char*)g.A + S.aoff(cur, tstepA); const char* cB = (const char*)g.Bt + (size_t)cur.pn * tstepB + S.boff(cur);
    {
        const char* nA = cA;
        PG8_STAGE(PG8_SB(0, 0), cB, voffB); PG8_STAGE(PG8_SB(0, 1), cB + hstepB, voffB); PG8_STAGE_A(PG8_SA(0, 0), (size_t)0, 0, false); PG8_STAGE_A(PG8_SA(0, 1), (size_t)0, 1, false);
        if (wr == 1) PG8_BAR;
        PG8_WAIT_V(2); PG8_BAR;
        PG8_STAGE(PG8_SB(1, 0), cB + kstepB, voffB); PG8_STAGE_A(PG8_SA(1, 0), kstepA, 0, false); PG8_STAGE(PG8_SB(1, 1), cB + hstepB + kstepB, voffB);
        PG8_WAIT_V(6); PG8_BAR;
    }
    for (;;) {
        const bool has_next = S.next(ui + 1, nxt);
        const char* nA = has_next ? (const char*)g.A + S.aoff(nxt, tstepA) : cA; const char* nB = has_next ? (const char*)g.Bt + (size_t)nxt.pn * tstepB + S.boff(nxt) : cB;
        if constexpr (Sched::GATHER) {
            if (has_next) {
#pragma unroll
                for (int h = 0; h < 2; ++h)
#pragma unroll
                    for (int i = 0; i < 2; ++i) vN[h][i] = (unsigned)rtl[(ui + 1) * 256 + Rg[i] + 128 * h] * g.lda_b + (unsigned)Cg[i] * 2u;
            }
        }
#pragma unroll 1
        for (int t = 0; t < nt; t += 2) {
            const bool last = (t == nt - 2);
            const size_t k1 = (size_t)(t + 1) * kstepA, k2 = last ? (size_t)0 : (size_t)(t + 2) * kstepA, k3 = k2 + kstepA;
            const char* b2 = last ? nB : cB + (size_t)(t + 2) * kstepB; const char* b3 = b2 + kstepB;
            PG8_LDB(B0, 0, 0); PG8_LDB(B1, 0, 1); PG8_SCHED; PG8_LDA(At, 0, 0); PG8_STAGE_A(PG8_SA(1, 1), k1, 1, false);
            PG8_WAIT_V(8); PG8_WAIT_L(0); PG8_BAR; PG8_MMA(0, 0, At, B0); PG8_MMA(0, 1, At, B1); PG8_BAR; PG8_SCHED;
            PG8_LDA(At, 0, 1); PG8_STAGE(PG8_SB(0, 0), b2, voffB); PG8_STAGE(PG8_SB(0, 1), b2 + hstepB, voffB); PG8_STAGE_A(PG8_SA(0, 0), k2, 0, last);
            PG8_WAIT_V(8); PG8_WAIT_L(0); PG8_BAR; PG8_MMA(1, 0, At, B0); PG8_MMA(1, 1, At, B1); PG8_BAR; PG8_SCHED;
            PG8_LDB(B0, 1, 0); PG8_LDB(B1, 1, 1); PG8_SCHED; PG8_LDA(At, 1, 0); PG8_STAGE_A(PG8_SA(0, 1), k2, 1, last);
            PG8_WAIT_V(8); PG8_WAIT_L(0); PG8_BAR; PG8_MMA(0, 0, At, B0); PG8_MMA(0, 1, At, B1); PG8_BAR; PG8_SCHED;
            PG8_LDA(At, 1, 1); PG8_STAGE(PG8_SB(1, 0), b3, voffB); PG8_STAGE(PG8_SB(1, 1), b3 + hstepB, voffB); PG8_STAGE_A(PG8_SA(1, 0), k3, 0, last);
            PG8_WAIT_V(8); PG8_WAIT_L(0); PG8_BAR; PG8_MMA(1, 0, At, B0); PG8_MMA(1, 1, At, B1); PG8_BAR; PG8_SCHED;
        }
        if (wr == 0) PG8_BAR;
        E(acc, cur, wr, wc, fr, fq);
        if constexpr (Sched::SIGNAL) {
            asm volatile("s_waitcnt vmcnt(0)" ::: "memory"); PG8_BAR;
            if (tid == 0) (void)__hip_atomic_fetch_add(S.ready + cur.pm, 1u, __ATOMIC_RELAXED, __HIP_MEMORY_SCOPE_AGENT);
        }
        if (!has_next) break;
#pragma unroll
        for (int a = 0; a < 2; ++a)
#pragma unroll
            for (int b = 0; b < 2; ++b)
#pragma unroll
                for (int m = 0; m < 4; ++m)
#pragma unroll
                    for (int n = 0; n < 2; ++n) acc[a][b][m][n] = (f32x4){0.f, 0.f, 0.f, 0.f};
        cur = nxt; cA = nA; cB = nB; ++ui;
        if constexpr (Sched::GATHER) {
#pragma unroll
            for (int h = 0; h < 2; ++h)
#pragma unroll
                for (int i = 0; i < 2; ++i) vC[h][i] = vN[h][i];
        }
        if (wr == 1) PG8_BAR;
    }
    PG8_WAIT_V(0);
    PG8_BAR;
#undef PG8_SA
#undef PG8_SB
#undef PG8_STAGE
#undef PG8_STAGE_A
#undef PG8_LDA
#undef PG8_LDB
#undef PG8_MMA
#undef PG8_WAIT_V
#undef PG8_WAIT_L
#undef PG8_BAR
#undef PG8_SCHED
}
}

typedef f32x4 AccT[2][2][4][2];
struct EpiProj {
    bf16_t* P; const float* rope; int rope_tiles; unsigned qmask; float* kmsum; int km_tile0;
    __device__ __forceinline__ void operator()(const AccT& acc, const pg8::Unit& u, int wr, int wc, int fr, int fq) const {
        const int row0 = u.pm * 256 + wr * 64 + fr, col0 = u.pn * 256 + wc * 32 + 8 * fq;
        const bool do_rope = (u.pn < rope_tiles) && ((wc & 1) == 0);
        const float sc = ((qmask >> u.pn) & 1u) ? C2 : 1.f;
        const bool do_km = (kmsum != nullptr) && ((u.pn == km_tile0) || (u.pn == km_tile0 + 1));
#pragma unroll
        for (int bj = 0; bj < 2; ++bj) {
            f32x4 ks0 = {0.f, 0.f, 0.f, 0.f}, ks1 = ks0;
#pragma unroll
            for (int ai = 0; ai < 2; ++ai)
#pragma unroll
                for (int m = 0; m < 4; ++m) {
                    const int row = row0 + ai * 128 + m * 16, pos = row & (SEQ - 1);
                    f32x4 v0 = acc[ai][bj][m][0], v1 = acc[ai][bj][m][1];
                    if (do_rope) {
                        const f32x4 c0 = *(const f32x4*)(rope + pos * 8), c1 = *(const f32x4*)(rope + pos * 8 + 4), s0 = *(const f32x4*)(rope + SEQ * 8 + pos * 8), s1 = *(const f32x4*)(rope + SEQ * 8 + pos * 8 + 4);
                        f32x4 p0, p1;
#pragma unroll
                        for (int e = 0; e < 4; ++e) { p0[e] = __shfl_xor(v0[e], 16); p1[e] = __shfl_xor(v1[e], 16); }
                        const f32x4 a0 = v0 * c0 - p0 * s0, a1 = v1 * c1 - p1 * s1, b0 = v0 * c0 + p0 * s0, b1 = v1 * c1 + p1 * s1;
                        v0 = fq == 0 ? a0 : (fq == 1 ? b0 : v0); v1 = fq == 0 ? a1 : (fq == 1 ? b1 : v1);
                    }
                    ks0 = ks0 + v0; ks1 = ks1 + v1;
                    v0 = v0 * sc; v1 = v1 * sc;
                    u32x4 w; w.x = cvt_pk_bf16(v0[0], v0[1]); w.y = cvt_pk_bf16(v0[2], v0[3]); w.z = cvt_pk_bf16(v1[0], v1[1]); w.w = cvt_pk_bf16(v1[2], v1[3]);
                    ST16_WT(P + (size_t)row * PW + col0 + bj * 128, w);
                }
            if (do_km) {
                const int b = u.pm >> 4, blk = u.pm & 15;
#pragma unroll
                for (int n = 0; n < 2; ++n)
#pragma unroll
                    for (int e = 0; e < 4; ++e) {
                        float t = n == 0 ? ks0[e] : ks1[e];
                        t += __shfl_xor(t, 1); t += __shfl_xor(t, 2); t += __shfl_xor(t, 4); t += __shfl_xor(t, 8);
                        if (fr == 0) { const int c = (u.pn - km_tile0) * 256 + bj * 128 + wc * 32 + 8 * fq + 4 * n + e;
                            atomicAdd(kmsum + ((size_t)(b * 8 + (c >> 6)) * 16 + blk) * 64 + (c & 63), t); }
                    }
            }
        }
    }
};
struct EpiBf16 {
    bf16_t* O; int ldc; int pnmask;
    __device__ __forceinline__ void operator()(const AccT& acc, const pg8::Unit& u, int wr, int wc, int fr, int fq) const {
        const int row0 = u.pm * 256 + wr * 64 + fr, col0 = (u.pn & pnmask) * 256 + wc * 32 + 8 * fq;
#pragma unroll
        for (int ai = 0; ai < 2; ++ai)
#pragma unroll
            for (int m = 0; m < 4; ++m) {
                bf16_t* rowp = O + (size_t)(row0 + ai * 128 + m * 16) * ldc + col0;
#pragma unroll
                for (int bj = 0; bj < 2; ++bj) { const f32x4 v0 = acc[ai][bj][m][0], v1 = acc[ai][bj][m][1];
                    u32x4 w; w.x = cvt_pk_bf16(v0[0], v0[1]); w.y = cvt_pk_bf16(v0[2], v0[3]); w.z = cvt_pk_bf16(v1[0], v1[1]); w.w = cvt_pk_bf16(v1[2], v1[3]);
                    ST16_WT(rowp + bj * 128, w); }
            }
    }
};
struct EpiResid {
    const float* x0; bf16_t* X; const float* g;
    __device__ __forceinline__ void operator()(const AccT& acc, const pg8::Unit& u, int wr, int wc, int fr, int fq) const {
        const int row0 = u.pm * 256 + wr * 64 + fr, col0 = u.pn * 256 + wc * 32 + 8 * fq;
        const float* gb = g + (u.pm / 16) * 6144;
#pragma unroll
        for (int bj = 0; bj < 2; ++bj) {
            const f32x4 g0 = *(const f32x4*)(gb + col0 + bj * 128), g1 = *(const f32x4*)(gb + col0 + bj * 128 + 4);
#pragma unroll
            for (int ai = 0; ai < 2; ++ai)
#pragma unroll
                for (int m = 0; m < 4; ++m) {
                    const size_t off = (size_t)(row0 + ai * 128 + m * 16) * DM + col0 + bj * 128;
                    f32x4 x0v, x1v;
                    if (x0 != nullptr) { x0v = *(const f32x4*)(x0 + off); x1v = *(const f32x4*)(x0 + off + 4); }
                    else { const u32x4 xr = *(const u32x4*)(X + off);
                        x0v[0] = __uint_as_float(xr.x << 16); x0v[1] = __uint_as_float(xr.x & 0xffff0000u); x0v[2] = __uint_as_float(xr.y << 16); x0v[3] = __uint_as_float(xr.y & 0xffff0000u);
                        x1v[0] = __uint_as_float(xr.z << 16); x1v[1] = __uint_as_float(xr.z & 0xffff0000u); x1v[2] = __uint_as_float(xr.w << 16); x1v[3] = __uint_as_float(xr.w & 0xffff0000u); }
                    const f32x4 y0 = x0v + g0 * acc[ai][bj][m][0], y1 = x1v + g1 * acc[ai][bj][m][1];
                    u32x4 w; w.x = cvt_pk_bf16(y0[0], y0[1]); w.y = cvt_pk_bf16(y0[2], y0[3]); w.z = cvt_pk_bf16(y1[0], y1[1]); w.w = cvt_pk_bf16(y1[2], y1[3]);
                    ST16_WT(X + off, w);
                }
        }
    }
};

struct CmpOrder {
    static constexpr bool GATHER = false, SIGNAL = false;
    int G, c;
    __device__ bool next(int i, pg8::Unit& u) const { const int L = i * G + c; if (c < 0 || L >= 64) return false; u.pm = L; u.pn = (L & 31) >> 4; return true; }
    __device__ size_t aoff(const pg8::Unit& u, size_t tstepA) const { const int ks = u.pm >> 5, br = (u.pm >> 4) & 1, g = (u.pm >> 2) & 3, rt = u.pm & 3; return (size_t)rt * tstepA + (size_t)(((br ? 1792 : 1024) + g * 64) * 2) + (size_t)ks * 16 * PW * 2; }
    __device__ size_t boff(const pg8::Unit& u) const { return (size_t)(u.pm >> 5) * 1024 * 2; }
};
__device__ __forceinline__ float gelu_tanh_fast(float x) {
    const float y = 0.7978845608028654f * (x + 0.044715f * x * x * x);
    const float t = 1.f - 2.f * __builtin_amdgcn_rcpf(1.f + __expf(2.f * y));
    return 0.5f * x * (1.f + t);
}
struct EpiCmp1 {
    float* CHP;
    __device__ __forceinline__ void operator()(const AccT& acc, const pg8::Unit& u, int wr, int wc, int fr, int fq) const {
        const int ks = u.pm >> 5, br = (u.pm >> 4) & 1, g = (u.pm >> 2) & 3, rt = u.pm & 3;
        const int row0 = rt * 256 + wr * 64 + fr, col0 = wc * 32 + 8 * fq;
        float* base = CHP + ((size_t)ks * 8192 + (size_t)(br * 4 + g) * 1024) * 256;
#pragma unroll
        for (int bj = 0; bj < 2; ++bj)
#pragma unroll
            for (int ai = 0; ai < 2; ++ai)
#pragma unroll
                for (int m = 0; m < 4; ++m) {
                    float* dst = base + (size_t)(row0 + ai * 128 + m * 16) * 256 + col0 + bj * 128;
                    *(f32x4*)dst = acc[ai][bj][m][0]; *(f32x4*)(dst + 4) = acc[ai][bj][m][1];
                }
    }
};
__device__ __forceinline__ void ph_inproj(const Params& p, LAS unsigned char* lds, int l, int bx, int G, int stage) {
    const bf16_t* H = (const bf16_t*)(p.ws + WS_H);
    const bf16_t* win = (const bf16_t*)(p.ws + WS_WIN) + (size_t)l * 3072 * 1024;
    const bool even = (l & 1) == 0;
    const bool split = (G >= 224);
    if (stage != 2) {
        pg8::Gemm g{H, win, 1024, 2048u, 128u, 1024}; pg8::StaticOrder S; S.init(NT, PW, G, bx);
        EpiProj E{(bf16_t*)(p.ws + WS_P), (const float*)(p.ws + WS_ROPE), even ? 8 : 7, even ? 0x33u : 0x0Fu, even ? (float*)(p.ws + WS_KMEAN) : nullptr, 2};
        pg8::gemm_phase<EpiProj, pg8::StaticOrder>(lds, g, S, E);
    }
    const bool doV = (stage == 0) || (stage == 2 && (!split || bx < 192));
    if (doV) {
        pg8::Gemm g{win + (size_t)2048 * 1024, H, 1024, 2048u, 128u, 1024}; pg8::StaticOrder S; S.init(even ? 1024 : 768, NT, (stage == 2 && split) ? 192 : G, bx);
        EpiBf16 E{(bf16_t*)(p.ws + WS_VT), NT, 0x7fffffff};
        pg8::gemm_phase<EpiBf16, pg8::StaticOrder>(lds, g, S, E);
    }
    if (stage == 2 && (!split || bx >= 192)) {
        const int li = l >> 1;
        pg8::Gemm g{(const bf16_t*)(p.ws + WS_P), (const bf16_t*)(p.ws + WS_W1T) + (size_t)li * 2 * 256 * 2048, 1024, 16u * PW * 2u, PW * 2u, 2048};
        CmpOrder S{split ? 64 : G, split ? bx - 192 : bx};
        EpiCmp1 E{(float*)(p.ws + WS_DT)};
        pg8::gemm_phase<EpiCmp1, CmpOrder>(lds, g, S, E);
    }
}
__device__ __forceinline__ void ph_outproj(const Params& p, LAS unsigned char* lds, int l, int bx, int G) {
    const bf16_t* O = (const bf16_t*)(p.ws + WS_O);
    const bf16_t* wout = (const bf16_t*)(p.ws + WS_WOUT) + (size_t)l * 1024 * 1024;
    bf16_t* X = (bf16_t*)(p.ws + WS_X);
    pg8::Gemm g{O, wout, 1024, 2048u, 128u, 1024}; pg8::StaticOrder S; S.init(NT, DM, G, bx);
    EpiResid E{l == 0 ? p.in[0] : (const float*)nullptr, X, (const float*)(p.ws + WS_MOD) + (size_t)l * 4 * 6144 + 2 * 1024};
    pg8::gemm_phase<EpiResid, pg8::StaticOrder>(lds, g, S, E);
}


typedef float f32x2_t __attribute__((ext_vector_type(2))); typedef __bf16 bf16x2_t __attribute__((ext_vector_type(2)));
__device__ __forceinline__ unsigned cvtpk_s(float lo, float hi) { f32x2_t v = {lo, hi}; bf16x2_t b = __builtin_convertvector(v, bf16x2_t); return __builtin_bit_cast(unsigned, b); }
#define MFMA32(a, b, c) __builtin_amdgcn_mfma_f32_32x32x16_bf16((a), (b), (c), 0, 0, 0)
constexpr int AT_KB = 64 * 144, AT_VB = 128 * 144;
constexpr int AT_KOFF = 0, AT_VOFF = 2 * AT_KB;
constexpr int AT_MASK = AT_VOFF + 3 * AT_VB;
constexpr int AT_RED = AT_MASK + 2048;
constexpr int AT_KM = AT_RED + 1024;
constexpr int AT_K2OFF = 81920;
constexpr int AT_IMP = 0;
static_assert(AT_IMP + 4 * 64 * 65 * 4 <= AT_MASK && AT_KM + 4096 <= 131072, "attention LDS map");

template <int DVB>
__device__ __forceinline__ bool attn_part1(LAS unsigned char* lds, int j, int kbuf, u64 mymask, int klim, int kmin, int r, int hi,
                                           const bf16x8 (&qf)[4], f32x16 (&o)[DVB], float& l, float& m_run, bool& fresh, f32x16& negm, bf16x8 (&pbo)[2][2], int kring = AT_KOFF) {
    bool done = false;
        {
            const int k0 = j * 64;
            const bool bit = ((mymask >> j) & 1ull) != 0ull;
            const bool any = bit && (k0 <= klim) && (k0 + 63 >= kmin);
            if (__ballot(any) != 0ull) {
                const bool rfull = (k0 + 63 <= klim) && (k0 >= kmin);
                const bool range_full = (__ballot(rfull) == ~0ull);
                const LAS unsigned char* kb = lds + kring + kbuf * AT_KB + r * 144 + hi * 16;
                f32x16 p0, p1;
                {
                    const bf16x8 ka = *(const LAS bf16x8*)(kb), kb2 = *(const LAS bf16x8*)(kb + 32 * 144);
                    p0 = MFMA32(ka, qf[0], negm); p1 = MFMA32(kb2, qf[0], negm);
                }
#pragma unroll
                for (int ks = 1; ks < 4; ++ks) {
                    const bf16x8 ka = *(const LAS bf16x8*)(kb + ks * 32), kb2 = *(const LAS bf16x8*)(kb + 32 * 144 + ks * 32);
                    p0 = MFMA32(ka, qf[ks], p0); p1 = MFMA32(kb2, qf[ks], p1);
                }
                if (!range_full) {
#pragma unroll
                    for (int i = 0; i < 16; ++i) { const int key = k0 + (i & 3) + 8 * (i >> 2) + 4 * hi;
                        const bool ok0 = (key <= klim) && (key >= kmin), ok1 = (key + 32 <= klim) && (key + 32 >= kmin);
                        p0[i] = ok0 ? p0[i] : NEGBIG; p1[i] = ok1 ? p1[i] : NEGBIG; }
                }
                float mx;
                {
                    float t[11];
#pragma unroll
                    for (int i = 0; i < 5; ++i) { t[2 * i] = fmaxf(fmaxf(p0[3 * i], p0[3 * i + 1]), p0[3 * i + 2]); t[2 * i + 1] = fmaxf(fmaxf(p1[3 * i], p1[3 * i + 1]), p1[3 * i + 2]); }
                    t[10] = fmaxf(fmaxf(p0[15], p1[15]), t[0]);
                    const float u0 = fmaxf(fmaxf(t[1], t[2]), t[3]), u1 = fmaxf(fmaxf(t[4], t[5]), t[6]), u2 = fmaxf(fmaxf(t[7], t[8]), t[9]);
                    mx = fmaxf(fmaxf(u0, u1), fmaxf(u2, t[10]));
                }
                { const auto sw = __builtin_amdgcn_permlane32_swap(__float_as_uint(mx), __float_as_uint(mx), false, false); mx = fmaxf(__uint_as_float(sw[0]), __uint_as_float(sw[1])); }
                const bool valid = bit && (mx > -1e29f);
                float d = 0.f;
                if (valid && (fresh || mx > 8.f)) d = mx;
                if (__ballot(d != 0.f) != 0ull) {
                    const float alpha = fresh ? 1.f : __builtin_amdgcn_exp2f(-d);
                    l *= alpha; m_run += d;
#pragma unroll
                    for (int dd = 0; dd < DVB; ++dd) o[dd] = o[dd] * alpha;
#pragma unroll
                    for (int i = 0; i < 16; ++i) { negm[i] = -m_run; p0[i] -= d; p1[i] -= d; }
                }
                fresh = fresh && !valid;
                float ls;
                {
#pragma unroll
                    for (int i = 0; i < 16; ++i) { p0[i] = __builtin_amdgcn_exp2f(p0[i]); p1[i] = __builtin_amdgcn_exp2f(p1[i]); }
                    float s8[8];
#pragma unroll
                    for (int i = 0; i < 8; ++i) s8[i] = (p0[i] + p0[i + 8]) + (p1[i] + p1[i + 8]);
                    ls = ((s8[0] + s8[1]) + (s8[2] + s8[3])) + ((s8[4] + s8[5]) + (s8[6] + s8[7]));
                }
                l += valid ? ls : 0.f;
                                u32x4 wq[2][2];
#pragma unroll
                for (int s2 = 0; s2 < 2; ++s2) {
                    wq[0][s2].x = cvtpk_s(p0[8 * s2 + 0], p0[8 * s2 + 1]); wq[0][s2].y = cvtpk_s(p0[8 * s2 + 2], p0[8 * s2 + 3]); wq[0][s2].z = cvtpk_s(p0[8 * s2 + 4], p0[8 * s2 + 5]); wq[0][s2].w = cvtpk_s(p0[8 * s2 + 6], p0[8 * s2 + 7]);
                    wq[1][s2].x = cvtpk_s(p1[8 * s2 + 0], p1[8 * s2 + 1]); wq[1][s2].y = cvtpk_s(p1[8 * s2 + 2], p1[8 * s2 + 3]); wq[1][s2].z = cvtpk_s(p1[8 * s2 + 4], p1[8 * s2 + 5]); wq[1][s2].w = cvtpk_s(p1[8 * s2 + 6], p1[8 * s2 + 7]);
                }
                if (__ballot(!valid) != 0ull) {
                    const unsigned vm = valid ? 0xffffffffu : 0u;
#pragma unroll
                    for (int a2 = 0; a2 < 2; ++a2)
#pragma unroll
                        for (int s2 = 0; s2 < 2; ++s2) { wq[a2][s2].x &= vm; wq[a2][s2].y &= vm; wq[a2][s2].z &= vm; wq[a2][s2].w &= vm; }
                }
#pragma unroll
                for (int s2 = 0; s2 < 2; ++s2) { pbo[0][s2] = __builtin_bit_cast(bf16x8, wq[0][s2]); pbo[1][s2] = __builtin_bit_cast(bf16x8, wq[1][s2]); }
                done = true;
            }
        }
    return done;
}
template <int DVB>
__device__ __forceinline__ void attn_part2(LAS unsigned char* lds, int vbuf, int r, int hi, const bf16x8 (&pb)[2][2], f32x16 (&o)[DVB]) {
    const LAS unsigned char* vb = lds + AT_VOFF + vbuf * AT_VB + r * 144 + hi * 16;
#pragma unroll
    for (int dd = 0; dd < DVB; ++dd)
#pragma unroll
        for (int kg = 0; kg < 2; ++kg)
#pragma unroll
            for (int s2 = 0; s2 < 2; ++s2) {
                const bf16x8 va = *(const LAS bf16x8*)(vb + dd * 32 * 144 + (kg * 32 + s2 * 16) * 2);
                o[dd] = MFMA32(va, pb[kg][s2], o[dd]);
            }
}
#ifndef TSEL
#define TSEL 0
#endif
constexpr int LDS_TACC = 147264;
#define TSTART(k) unsigned long long t_s_ = 0; if (TSEL == (k)) t_s_ = __builtin_amdgcn_s_memrealtime();
#define TSTOP(k) if (TSEL == (k)) { const unsigned long long t_e_ = __builtin_amdgcn_s_memrealtime(); if (otid() == 0) *(LAS unsigned*)(lds + LDS_TACC) += (unsigned)(t_e_ - t_s_); }
template <int DVB>
__device__ __forceinline__ void attn_stage_load(const bf16_t* __restrict__ Kg, int kpitch, const bf16_t* __restrict__ Vg, int vpitch, int jl, int lrow, int lch, u32x4& kreg, u32x4 (&vreg)[DVB / 2]) {
    kreg = *(const u32x4*)(Kg + (size_t)(jl * 64 + lrow) * kpitch + lch * 8);
#pragma unroll
    for (int i = 0; i < DVB / 2; ++i) vreg[i] = *(const u32x4*)(Vg + (size_t)(lrow + 64 * i) * vpitch + jl * 64 + lch * 8);
}
template <int DVB>
__device__ __forceinline__ void attn_stage_write(LAS unsigned char* lds, int nkb, int nvb, int lrow, int lch, const u32x4& kreg, const u32x4 (&vreg)[DVB / 2]) {
    *(LAS u32x4*)(lds + AT_KOFF + nkb * AT_KB + lrow * 144 + lch * 16) = kreg;
#pragma unroll
    for (int i = 0; i < DVB / 2; ++i) { LAS unsigned char* vp = lds + AT_VOFF + nvb * AT_VB + (lrow + 64 * i) * 144 + (lch >> 1) * 32 + (lch & 1) * 8;
        *(LAS u32x2*)vp = (u32x2){vreg[i].x, vreg[i].y}; *(LAS u32x2*)(vp + 16) = (u32x2){vreg[i].z, vreg[i].w}; }
}
template <int DVB, bool DUAL = false>
__device__ __forceinline__ void attn_run(LAS unsigned char* lds, const bf16_t* __restrict__ Kg, int kpitch, const bf16_t* __restrict__ Vg, int vpitch,
                                         u64 tmask, u64 mymask, int klim, int kmin, const bf16x8 (&qf)[4], f32x16 (&o)[DVB], float& m, float& l) {
    const int tid = otid(), lane = tid & 63, r = lane & 31, hi = lane >> 5;
    const int lrow = tid >> 3, lch = tid & 7;
    const bool grpB = __builtin_amdgcn_readfirstlane(tid >> 8) != 0;
    if (tmask == 0ull) return;
    float m_run = 0.f; bool fresh = true; f32x16 negm;
#pragma unroll
    for (int i = 0; i < 16; ++i) negm[i] = 0.f;
    (void)m;
    int j = __builtin_ctzll(tmask); tmask &= tmask - 1ull;
    int jn = -1; if (tmask != 0ull) { jn = __builtin_ctzll(tmask); tmask &= tmask - 1ull; }
    u32x4 kA, vA[DVB / 2], kA2;
    const int kring = (DUAL && grpB) ? AT_K2OFF : AT_KOFF;
    attn_stage_load<DVB>(Kg, kpitch, Vg, vpitch, j, lrow, lch, kA, vA);
    if (DUAL) kA2 = *(const u32x4*)(Kg + (size_t)(j * 64 + lrow) * kpitch + 64 + lch * 8);
    attn_stage_write<DVB>(lds, 0, 0, lrow, lch, kA, vA);
    if (DUAL) *(LAS u32x4*)(lds + AT_K2OFF + lrow * 144 + lch * 16) = kA2;
    __syncthreads();
    int kb = 0, vbc = 0, vbp = 0;
    bool havep = false; bf16x8 pbp[2][2];
#pragma unroll
    for (int a2 = 0; a2 < 2; ++a2)
#pragma unroll
        for (int b2 = 0; b2 < 2; ++b2) pbp[a2][b2] = (bf16x8){0, 0, 0, 0, 0, 0, 0, 0};
    for (;;) {
        { TSTART(1) attn_stage_load<DVB>(Kg, kpitch, Vg, vpitch, jn >= 0 ? jn : j, lrow, lch, kA, vA);
          if (DUAL) kA2 = *(const u32x4*)(Kg + (size_t)((jn >= 0 ? jn : j) * 64 + lrow) * kpitch + 64 + lch * 8); TSTOP(1) }
        { TSTART(2)
        if (grpB && havep) attn_part2<DVB>(lds, vbp, r, hi, pbp, o);
        havep = attn_part1<DVB>(lds, j, kb, mymask, klim, kmin, r, hi, qf, o, l, m_run, fresh, negm, pbp, kring);
        vbp = vbc;
        if (!grpB && havep) attn_part2<DVB>(lds, vbc, r, hi, pbp, o);
        TSTOP(2) }
        const int vbn = (vbc == 2) ? 0 : vbc + 1;
        { TSTART(3) if (jn >= 0) { attn_stage_write<DVB>(lds, kb ^ 1, vbn, lrow, lch, kA, vA); if (DUAL) *(LAS u32x4*)(lds + AT_K2OFF + (kb ^ 1) * AT_KB + lrow * 144 + lch * 16) = kA2; } TSTOP(3) }
        { TSTART(4) __syncthreads(); TSTOP(4) }
        if (jn < 0) break;
        j = jn; kb ^= 1; vbc = vbn;
        jn = -1; if (tmask != 0ull) { jn = __builtin_ctzll(tmask); tmask &= tmask - 1ull; }
    }
    if (grpB && havep) attn_part2<DVB>(lds, vbp, r, hi, pbp, o);
    __syncthreads();
}
__device__ __forceinline__ u64 tile_range_mask(int lo, int hi) {
    const u64 up = (hi >= 63) ? ~0ull : ((1ull << (hi + 1)) - 1ull);
    return up & ~((1ull << lo) - 1ull);
}

__device__ __forceinline__ void ph_moba_kmean(const Params& p, LAS unsigned char* lds, int bx, int G) {
    const int tid = otid(), lane = tid & 63, w = tid >> 6;
    const bf16_t* P = (const bf16_t*)(p.ws + WS_P); float* kmean = (float*)(p.ws + WS_KMEAN);
    LAS float* red = (LAS float*)lds;
    for (int it = bx; it < NB * 8 * 16; it += G) {
        const int blk = it & 15, h = (it >> 4) & 7, b = it >> 7;
        const bf16_t* kp = P + (size_t)(b * SEQ + blk * 256 + w * 32) * PW + 512 + h * 64 + lane;
        float s = 0.f;
#pragma unroll 32
        for (int i = 0; i < 32; ++i) s += bf2f(kp[(size_t)i * PW]);
        red[w * 64 + lane] = s;
        __syncthreads();
        if (w == 0) { float t = 0.f;
#pragma unroll
            for (int i = 0; i < 8; ++i) t += red[i * 64 + lane];
            kmean[((b * 8 + h) * 16 + blk) * 64 + lane] = t * (1.f / 256.f); }
        __syncthreads();
    }
}
__device__ __forceinline__ void ph_attn_even(const Params& p, LAS unsigned char* lds, int lyr, int bx, int G) {
    const int tid = otid(), lane = tid & 63, w = tid >> 6, r = lane & 31, hi = lane >> 5;
    const bf16_t* P = (const bf16_t*)(p.ws + WS_P); const bf16_t* VT = (const bf16_t*)(p.ws + WS_VT);
    const float* kmean = (const float*)(p.ws + WS_KMEAN);
    bf16_t* O = (bf16_t*)(p.ws + WS_O);
    LAS float* kml = (LAS float*)(lds + AT_KM);
    for (int c = bx; c < 256; c += G) {
        const int bh = c & 31, qtp = c >> 5;
#pragma unroll 1
        for (int uu = 0; uu < 4; ++uu) {
            const int kind = uu >> 1, qt = (uu & 1) ? (15 - qtp) : qtp;
            const int b = bh >> 3, hh = bh & 7;
            const int qpos = qt * 256 + w * 32 + r;
            const size_t tok = (size_t)b * SEQ + qpos;
            if (kind == 0) {
                const bf16_t* qp = P + tok * PW + hh * 64 + hi * 8;
                bf16x8 qf[4];
#pragma unroll
                for (int ks = 0; ks < 4; ++ks) qf[ks] = *(const bf16x8*)(qp + ks * 16);
                __syncthreads();
                for (int i = tid; i < 1024; i += NTHR) kml[i] = kmean[(size_t)(b * 8 + hh) * 1024 + i] * (1.f / 256.f);
                __syncthreads();
                const int own = qt;
                float g0 = NEGBIG, g1 = NEGBIG, g2 = NEGBIG; int i0 = -1, i1 = -1, i2 = -1;
                for (int blk = 0; blk < own; ++blk) {
                    float s = 0.f;
#pragma unroll
                    for (int ks = 0; ks < 4; ++ks)
#pragma unroll
                        for (int e = 0; e < 8; ++e) s += bf2f((bf16_t)qf[ks][e]) * kml[blk * 64 + ks * 16 + hi * 8 + e];
                    s += __shfl_xor(s, 32);
                    if (s > g0) { g2 = g1; i2 = i1; g1 = g0; i1 = i0; g0 = s; i0 = blk; }
                    else if (s > g1) { g2 = g1; i2 = i1; g1 = s; i1 = blk; }
                    else if (s > g2) { g2 = s; i2 = blk; }
                }
                u64 mk = 0xFull << (4 * own);
                if (i0 >= 0) mk |= 0xFull << (4 * i0);
                if (i1 >= 0) mk |= 0xFull << (4 * i1);
                if (i2 >= 0) mk |= 0xFull << (4 * i2);
                f32x16 o[2];
#pragma unroll
                for (int d = 0; d < 2; ++d)
#pragma unroll
                    for (int i = 0; i < 16; ++i) o[d][i] = 0.f;
                float m = NEGBIG, l = 0.f;
                attn_run<2>(lds, P + (size_t)b * SEQ * PW + 512 + hh * 64, PW, VT + (size_t)(hh * 64) * NT + (size_t)b * SEQ, NT,
                            tile_range_mask(0, 4 * qt + 3), mk, qpos, 0, qf, o, m, l);
                l += __shfl_xor(l, 32);
                const float il = l > 0.f ? 1.f / l : 0.f;
                bf16_t* op = O + tok * 1024 + hh * 64 + 4 * hi;
#pragma unroll
                for (int d = 0; d < 2; ++d)
#pragma unroll
                    for (int cc = 0; cc < 4; ++cc) {
                        u32x2 wv; wv.x = cvtpk_s(o[d][4 * cc] * il, o[d][4 * cc + 1] * il); wv.y = cvtpk_s(o[d][4 * cc + 2] * il, o[d][4 * cc + 3] * il);
                        *(u32x2*)(op + 32 * d + 8 * cc) = wv;
                    }
            } else {
                const int bh16 = c & 15, jq = c >> 4, qt2 = (uu & 1) ? (31 - jq) : jq;
                const int b2 = bh16 >> 2, head = bh16 & 3, map = w >> 2;
                const int qpos2 = qt2 * 128 + (w & 3) * 32 + r;
                const size_t tok2 = (size_t)b2 * SEQ + qpos2;
                const bf16_t* qp = P + tok2 * PW + 1024 + (head * 2 + map) * 64 + hi * 8;
                bf16x8 qf[4];
#pragma unroll
                for (int ks = 0; ks < 4; ++ks) qf[ks] = *(const bf16x8*)(qp + ks * 16);
                f32x16 o[4];
#pragma unroll
                for (int d = 0; d < 4; ++d)
#pragma unroll
                    for (int i = 0; i < 16; ++i) o[d][i] = 0.f;
                float m = NEGBIG, l = 0.f;
                attn_run<4, true>(lds, P + (size_t)b2 * SEQ * PW + 1536 + head * 128, PW, VT + (size_t)(512 + head * 128) * NT + (size_t)b2 * SEQ, NT,
                                  tile_range_mask(0, 2 * qt2 + 1), ~0ull, qpos2, 0, qf, o, m, l);
                l += __shfl_xor(l, 32);
                const float il = l > 0.f ? 1.f / l : 0.f;
                LAS float* xb = (LAS float*)lds + (w & 3) * 4096 + r;
                if (map == 1) {
#pragma unroll
                    for (int d = 0; d < 4; ++d)
#pragma unroll
                        for (int i = 0; i < 16; ++i) xb[(32 * d + (i & 3) + 8 * (i >> 2) + 4 * hi) * 32] = o[d][i] * il;
                }
                __syncthreads();
                if (map == 0) {
                    const int li = lyr >> 1;
                    const float lam = ((const float*)(p.ws + WS_MISC))[li], linit = li == 0 ? LINIT0 : LINIT1;
                    float ss = 0.f;
#pragma unroll
                    for (int d = 0; d < 4; ++d)
#pragma unroll
                        for (int i = 0; i < 16; ++i) { const float v = o[d][i] * il - lam * xb[(32 * d + (i & 3) + 8 * (i >> 2) + 4 * hi) * 32]; o[d][i] = v; ss += v * v; }
                    ss += __shfl_xor(ss, 32);
                    const float rs = rsqrtf(ss * (1.f / 128.f) + 1e-6f) * (1.f - linit);
                    const float* subg = p.in[10] + li * 128 + 4 * hi;
                    bf16_t* op = O + tok2 * 1024 + 512 + head * 128 + 4 * hi;
#pragma unroll
                    for (int d = 0; d < 4; ++d)
#pragma unroll
                        for (int cc = 0; cc < 4; ++cc) {
                            const f32x4 sg = *(const f32x4*)(subg + 32 * d + 8 * cc);
                            u32x2 wv; wv.x = cvtpk_s(o[d][4 * cc] * rs * sg[0], o[d][4 * cc + 1] * rs * sg[1]); wv.y = cvtpk_s(o[d][4 * cc + 2] * rs * sg[2], o[d][4 * cc + 3] * rs * sg[3]);
                            *(u32x2*)(op + 32 * d + 8 * cc) = wv;
                        }
                }
                __syncthreads();
            }
        }
    }
}

__device__ __forceinline__ void ph_misc(const Params& p, LAS unsigned char* lds, int bx, int G) {
    const int tid = otid();
    float* misc = (float*)(p.ws + WS_MISC); float* fold = (float*)(p.ws + WS_FOLD);
    if (bx == 0 && tid < 64) {
        for (int i = 0; i < 2; ++i) { const float* lp = p.in[9] + i * 256;
            const float s1 = wave_sum(lp[tid] * lp[64 + tid]), s2 = wave_sum(lp[128 + tid] * lp[192 + tid]);
            if (tid == 0) misc[i] = expf(s1) - expf(s2) + (i == 0 ? LINIT0 : LINIT1); }
    }
    {
        LAS float* red = (LAS float*)lds;
        for (int it = bx; it < 64; it += G) {
            const int lb = it >> 4, f = (it & 15) * 16 + (tid & 15), ch = tid >> 4;
            const float* pos = p.in[13] + (size_t)lb * 2048 + ch * 64; const float* w1 = p.in[14] + (size_t)lb * 2048 * 256 + (size_t)(ch * 64) * 256 + f;
            float s0 = 0.f;
#pragma unroll 16
            for (int i = 0; i < 64; ++i) s0 += pos[i] * w1[(size_t)i * 256];
            red[tid] = s0;
            __syncthreads();
            if (tid < 16) { float t = p.in[15][lb * 256 + f]; for (int k = 0; k < 32; ++k) t += red[k * 16 + tid]; fold[lb * 256 + f] = t; }
            __syncthreads();
        }
    }
}
__device__ __forceinline__ void ph_compress2(const Params& p, LAS unsigned char* lds, int l, int bx, int G) {
    const int tid = otid(), lane = tid & 63, w = tid >> 6, li = l >> 1;
    const float* CHP = (const float*)(p.ws + WS_DT); bf16_t* KCMP = (bf16_t*)(p.ws + WS_KCMP); bf16_t* VCX = (bf16_t*)(p.ws + WS_VCX);
    LAS float* w2s = (LAS float*)lds;
    LAS float* hrow = (LAS float*)(lds + 65536) + w * 256;
    const int ipb = 8192 / G, it0 = bx * ipb, br = it0 >> 12;
    {
        const float* w2 = p.in[16] + (size_t)(li * 2 + br) * 256 * 64;
        for (int i = tid; i < 4096; i += NTHR) ((LAS f32x4*)w2s)[i] = *(const f32x4*)(w2 + i * 4);
    }
    __syncthreads();
    const float bias = p.in[17][(li * 2 + br) * 64 + lane];
    const f32x4 foldv = *(const f32x4*)((const float*)(p.ws + WS_FOLD) + li * 512 + br * 256 + lane * 4);
    for (int k = w; k < ipb; k += NWAVES) {
        const int it = it0 + k, r = it & 1023, g = (it >> 10) & 3, b = r >> 8, n = r & 255;
        const f32x4 pa = *(const f32x4*)(CHP + (size_t)it * 256 + lane * 4), pb = *(const f32x4*)(CHP + ((size_t)8192 + it) * 256 + lane * 4);
        const f32x4 hs = pa + pb + foldv;
        *(LAS f32x4*)(hrow + lane * 4) = (f32x4){gelu_tanh_fast(hs[0]), gelu_tanh_fast(hs[1]), gelu_tanh_fast(hs[2]), gelu_tanh_fast(hs[3])};
        asm volatile("s_waitcnt lgkmcnt(0)" ::: "memory");
        float s0 = 0.f, s1 = 0.f, s2 = 0.f, s3 = 0.f;
#pragma unroll 8
        for (int f = 0; f < 256; f += 4) {
            const f32x4 h4 = *(const LAS f32x4*)(hrow + f);
            s0 += h4[0] * w2s[(f + 0) * 64 + lane]; s1 += h4[1] * w2s[(f + 1) * 64 + lane]; s2 += h4[2] * w2s[(f + 2) * 64 + lane]; s3 += h4[3] * w2s[(f + 3) * 64 + lane];
        }
        float sum = (s0 + s1) + (s2 + s3) + bias;
        if (n == 255) sum = 0.f;
        if (br == 0) KCMP[((size_t)(b * 4 + g) * 256 + n) * 64 + lane] = f2bf(sum);
        else VCX[((size_t)(b * 4 + g) * 128 + lane) * 256 + n] = f2bf(sum);
        asm volatile("s_waitcnt lgkmcnt(0)" ::: "memory");
    }
    int gstride = G * NTHR; asm volatile("" : "+s"(gstride));
    for (int i = bx * NTHR + tid; i < 16 * 64 * 256; i += gstride) {
        const int n = i & 255, j = (i >> 8) & 63, bg = i >> 14;
        const bool ov = (n < 255) && (n >= 4 * j - 1) && (n <= 4 * j + 3);
        VCX[((size_t)bg * 128 + 64 + j) * 256 + n] = ov ? (bf16_t)0x3F80 : (bf16_t)0;
    }
    __syncthreads();
}
__device__ __forceinline__ void ph_attn_odd(const Params& p, LAS unsigned char* lds, int bx, int G) {
    const int tid = otid(), lane = tid & 63, w = tid >> 6, r = lane & 31, hi = lane >> 5;
    const bf16_t* P = (const bf16_t*)(p.ws + WS_P); const bf16_t* VT = (const bf16_t*)(p.ws + WS_VT);
    const bf16_t* KCMP = (const bf16_t*)(p.ws + WS_KCMP); const bf16_t* VCX = (const bf16_t*)(p.ws + WS_VCX);
    bf16_t* O = (bf16_t*)(p.ws + WS_O);
    LAS float* imp = (LAS float*)(lds + AT_IMP);
    LAS u64* mks = (LAS u64*)(lds + AT_MASK);
    LAS u64* red = (LAS u64*)(lds + AT_RED);
    for (int c = bx; c < 256; c += G) {
        const int bg = c & 15, qp = c >> 4, b = bg >> 2, g = bg & 3;
#pragma unroll 1
        for (int uu = 0; uu < 4; ++uu) {
            const int qt = uu == 0 ? qp : (uu == 1 ? 31 - qp : (uu == 2 ? 32 + qp : 63 - qp));
            const int head = 4 * g + (w >> 1), qloc = (w & 1) * 32 + r, qpos = qt * 64 + qloc;
            const size_t tok = (size_t)b * SEQ + qpos;
            const bf16_t* qptr = P + tok * PW + head * 64 + hi * 8;
            bf16x8 qf[4];
#pragma unroll
            for (int ks = 0; ks < 4; ++ks) qf[ks] = *(const bf16x8*)(qptr + ks * 16);
            float gt[3];
#pragma unroll
            for (int j = 0; j < 3; ++j) { const float gl = bf2f(VT[(size_t)(512 + head * 3 + j) * NT + tok]); gt[j] = 1.f / (1.f + __expf(-gl)); }
            f32x16 acc[2];
            {
                f32x16 o4[4];
#pragma unroll
                for (int d = 0; d < 4; ++d)
#pragma unroll
                    for (int i = 0; i < 16; ++i) o4[d][i] = 0.f;
                float m = NEGBIG, l = 0.f;
                const int klim = qpos >= 31 ? ((qpos - 31) >> 4) : -1;
                attn_run<4>(lds, KCMP + (size_t)bg * 256 * 64, 64, VCX + (size_t)bg * 128 * 256, 256, tile_range_mask(0, (4 * qt + 2) >> 6), ~0ull, klim, 0, qf, o4, m, l);
                l += __shfl_xor(l, 32);
                const float il = l > 0.f ? 1.f / l : 0.f;
#pragma unroll
                for (int d = 0; d < 2; ++d) acc[d] = o4[d] * (gt[0] * il);
                LAS float* ip = imp + ((w >> 1) * 64 + qloc) * 65 + 4 * hi;
#pragma unroll
                for (int d = 0; d < 2; ++d)
#pragma unroll
                    for (int i = 0; i < 16; ++i) ip[32 * d + (i & 3) + 8 * (i >> 2)] = o4[2 + d][i] * il;
            }
            __syncthreads();
            {
                const int q = tid >> 3, pt = tid & 7, own = qt;
                LAS float* iq = imp + q * 65;
                float vj[8];
#pragma unroll
                for (int k = 0; k < 8; ++k) { const int j = pt * 8 + k;
                    float v = (iq[j] + iq[64 * 65 + j]) + (iq[2 * 64 * 65 + j] + iq[3 * 64 * 65 + j]);
                    if (j > own) v = NEGBIG; else if (j == 0 || j == own || j == own - 1) v = 1e6f;
                    vj[k] = v; }
                __syncthreads();
#pragma unroll
                for (int k = 0; k < 8; ++k) iq[pt * 8 + k] = vj[k];
                __syncthreads();
                int cnt[8];
#pragma unroll
                for (int k = 0; k < 8; ++k) cnt[k] = 0;
#pragma unroll 4
                for (int jj = 0; jj < 64; ++jj) { const float u = iq[jj];
#pragma unroll
                    for (int k = 0; k < 8; ++k) cnt[k] += ((u > vj[k]) || (u == vj[k] && jj < pt * 8 + k)) ? 1 : 0; }
                unsigned bits = 0u;
#pragma unroll
                for (int k = 0; k < 8; ++k) bits |= (cnt[k] < 16) ? (1u << k) : 0u;
                unsigned lo = (pt < 4) ? (bits << (8 * pt)) : 0u, hh = (pt >= 4) ? (bits << (8 * (pt - 4))) : 0u;
#pragma unroll
                for (int off = 1; off <= 4; off <<= 1) { lo |= __shfl_xor(lo, off); hh |= __shfl_xor(hh, off); }
                if (pt == 0) mks[q] = ((u64)hh << 32) | lo;
#pragma unroll
                for (int off = 8; off <= 32; off <<= 1) { lo |= __shfl_xor(lo, off); hh |= __shfl_xor(hh, off); }
                if (lane == 0) red[1 + w] = ((u64)hh << 32) | lo;
            }
            __syncthreads();
            if (tid == 0) { u64 t = 0ull; for (int k = 0; k < 8; ++k) t |= red[1 + k]; red[0] = t; }
            __syncthreads();
            const u64 mymask = mks[qloc];
            const u64 tm_sel = red[0] & tile_range_mask(0, qt);
#pragma unroll 1
            for (int br = 0; br < 2; ++br) {
                f32x16 o2[2];
#pragma unroll
                for (int d = 0; d < 2; ++d)
#pragma unroll
                    for (int i = 0; i < 16; ++i) o2[d][i] = 0.f;
                float m = NEGBIG, l = 0.f;
                const bf16_t* Kg = P + (size_t)b * SEQ * PW + (br == 0 ? 1280 : 1536) + g * 64;
                const bf16_t* Vg = VT + (size_t)((br == 0 ? 0 : 256) + g * 64) * NT + (size_t)b * SEQ;
                const u64 tm = br == 0 ? tm_sel : tile_range_mask(qt >= 8 ? qt - 8 : 0, qt);
                attn_run<2>(lds, Kg, PW, Vg, NT, tm, br == 0 ? mymask : ~0ull, qpos, br == 0 ? 0 : qpos - 511, qf, o2, m, l);
                l += __shfl_xor(l, 32);
                const float sc = (l > 0.f ? 1.f / l : 0.f) * (br == 0 ? gt[1] : gt[2]);
#pragma unroll
                for (int d = 0; d < 2; ++d) acc[d] = acc[d] + o2[d] * sc;
            }
            bf16_t* op = O + tok * 1024 + head * 64 + 4 * hi;
#pragma unroll
            for (int d = 0; d < 2; ++d)
#pragma unroll
                for (int cc = 0; cc < 4; ++cc) {
                    u32x2 wv; wv.x = cvtpk_s(acc[d][4 * cc], acc[d][4 * cc + 1]); wv.y = cvtpk_s(acc[d][4 * cc + 2], acc[d][4 * cc + 3]);
                    *(u32x2*)(op + 32 * d + 8 * cc) = wv;
                }
        }
    }
}


__device__ __forceinline__ float red4(const f32x4& a, int lane) {
    const bool h5 = (lane & 32) != 0, h4 = (lane & 16) != 0;
    float k0 = h5 ? a[2] : a[0], k1 = h5 ? a[3] : a[1]; const float s0 = h5 ? a[0] : a[2], s1 = h5 ? a[1] : a[3];
    k0 += __shfl_xor(s0, 32); k1 += __shfl_xor(s1, 32);
    float k = h4 ? k1 : k0; const float s = h4 ? k0 : k1;
    k += __shfl_xor(s, 16);
    k += __shfl_xor(k, 8); k += __shfl_xor(k, 4); k += __shfl_xor(k, 2); k += __shfl_xor(k, 1);
    return k;
}
template <int MODE>
__device__ __forceinline__ void ph_norm(const Params& p, LAS unsigned char* lds, int l, int bx, int G) {
    const int tid = otid(), lane = tid & 63, w = tid >> 6;
    LAS f32x4* rw = (LAS f32x4*)lds;
    LAS int* ent = (LAS int*)(lds + 81920);
    const int TPB = NT / G;
    if (MODE == 1) {
        const float* wg = p.in[18] + (size_t)l * 1024 * 4; const float* we = p.in[20] + (size_t)l * 1024 * 16;
        for (int s = tid; s < 16 * 5 * 64; s += NTHR) {
            const int ln = s & 63, r = s >> 6, q = r % 5, ie = r / 5, idx = (ie >> 2) * 256 + ln * 4 + (ie & 3);
            rw[s] = (q == 0) ? *(const f32x4*)(wg + idx * 4) : *(const f32x4*)(we + idx * 16 + (q - 1) * 4);
        }
        if (tid < 16) ((LAS float*)(lds + 83456))[tid] = p.in[21][l * 16 + tid];
        __syncthreads();
    }
    bf16_t* X = (bf16_t*)(p.ws + WS_X); bf16_t* H = (bf16_t*)(p.ws + WS_H);
    const float* mod = (const float*)(p.ws + WS_MOD);
    const bf16_t* Y = (const bf16_t*)(p.ws + WS_Y); const int* POS = (const int*)(p.ws + WS_POS);
    int* tok_e = (int*)(p.ws + WS_ROUTE); float* tok_w = (float*)(p.ws + WS_ROUTE + 131072); int* tok_rank = (int*)(p.ws + WS_ROUTE + 262144);
    const bool comb = (MODE == 2) || (MODE == 0 && l > 0);
    const int lc = (MODE == 2) ? DEPTH - 1 : l - 1;
    const bool xf32 = (MODE == 0 && l == 0);
    const float* xin = p.in[0];
    const float* gsrc = (MODE == 0) ? p.in[2] + l * DM : (MODE == 1 ? p.in[3] + l * DM : p.in[4]);
    const int scc = (MODE == 0) ? 1 : 4, shc = (MODE == 0) ? 0 : 3;
    const int nit = TPB / NWAVES, tbase = bx * TPB + w * nit, b = (bx * TPB) / SEQ;
    f32x4 gv[4], scv[4], shv[4], g2v[4];
#pragma unroll
    for (int i = 0; i < 4; ++i) {
        const int idx = i * 256 + lane * 4;
        gv[i] = *(const f32x4*)(gsrc + idx);
        if (MODE != 2) { scv[i] = *(const f32x4*)(mod + (size_t)(l * 4 + b) * 6144 + scc * 1024 + idx) + 1.f; shv[i] = *(const f32x4*)(mod + (size_t)(l * 4 + b) * 6144 + shc * 1024 + idx); }
        if (comb) g2v[i] = *(const f32x4*)(mod + (size_t)(lc * 4 + b) * 6144 + 5 * 1024 + idx);
    }
    int posv = 0;
    if (comb) posv = POS[(size_t)tbase * 2 + (lane < nit * 2 ? lane : 0)];
    u32x4 xn[4]; u32x2 yan[4], ybn[4];
    {
        const int p0 = comb ? __builtin_amdgcn_readlane(posv, 0) : 0, p1 = comb ? __builtin_amdgcn_readlane(posv, 1) : 0;
#pragma unroll
        for (int i = 0; i < 4; ++i) { const int idx = i * 256 + lane * 4;
            if (xf32) xn[i] = *(const u32x4*)(xin + (size_t)tbase * DM + idx); else { const u32x2 t2 = *(const u32x2*)(X + (size_t)tbase * DM + idx); xn[i].x = t2.x; xn[i].y = t2.y; }
            if (comb) { yan[i] = *(const u32x2*)(Y + (size_t)p0 * DM + idx); ybn[i] = *(const u32x2*)(Y + (size_t)p1 * DM + idx); } }
    }
    float bgv[4] = {0.f, 0.f, 0.f, 0.f};
    if (MODE == 1) {
#pragma unroll
        for (int j = 0; j < 4; ++j) bgv[j] = p.in[19][l * 4 + j];
    }
    for (int itn = 0; itn < nit; ++itn) {
        const int t = tbase + itn;
        f32x4 xv[4]; u32x2 ya[4], yb[4];
#pragma unroll
        for (int i = 0; i < 4; ++i) {
            if (xf32) { xv[i][0] = __uint_as_float(xn[i].x); xv[i][1] = __uint_as_float(xn[i].y); xv[i][2] = __uint_as_float(xn[i].z); xv[i][3] = __uint_as_float(xn[i].w); }
            else { xv[i][0] = __uint_as_float(xn[i].x << 16); xv[i][1] = __uint_as_float(xn[i].x & 0xffff0000u); xv[i][2] = __uint_as_float(xn[i].y << 16); xv[i][3] = __uint_as_float(xn[i].y & 0xffff0000u); }
            if (comb) { ya[i] = yan[i]; yb[i] = ybn[i]; } }
        {
            const int nx = (itn + 1 < nit) ? itn + 1 : itn;
            const int p0 = comb ? __builtin_amdgcn_readlane(posv, 2 * nx) : 0, p1 = comb ? __builtin_amdgcn_readlane(posv, 2 * nx + 1) : 0;
#pragma unroll
            for (int i = 0; i < 4; ++i) { const int idx = i * 256 + lane * 4;
                if (xf32) xn[i] = *(const u32x4*)(xin + (size_t)(tbase + nx) * DM + idx); else { const u32x2 t2 = *(const u32x2*)(X + (size_t)(tbase + nx) * DM + idx); xn[i].x = t2.x; xn[i].y = t2.y; }
                if (comb) { yan[i] = *(const u32x2*)(Y + (size_t)p0 * DM + idx); ybn[i] = *(const u32x2*)(Y + (size_t)p1 * DM + idx); } }
        }
        float ss = 0.f;
#pragma unroll
        for (int i = 0; i < 4; ++i) {
            const int idx = i * 256 + lane * 4;
            if (comb) {
                f32x4 ys; ys[0] = bf2f((bf16_t)(ya[i].x & 0xffff)) + bf2f((bf16_t)(yb[i].x & 0xffff)); ys[1] = bf2f((bf16_t)(ya[i].x >> 16)) + bf2f((bf16_t)(yb[i].x >> 16));
                ys[2] = bf2f((bf16_t)(ya[i].y & 0xffff)) + bf2f((bf16_t)(yb[i].y & 0xffff)); ys[3] = bf2f((bf16_t)(ya[i].y >> 16)) + bf2f((bf16_t)(yb[i].y >> 16));
                xv[i] = xv[i] + g2v[i] * ys;
                if (MODE == 0) { u32x2 xo; xo.x = cvt_pk_bf16(xv[i][0], xv[i][1]); xo.y = cvt_pk_bf16(xv[i][2], xv[i][3]); *(u32x2*)(X + (size_t)t * DM + idx) = xo; }
            }
            ss += xv[i][0] * xv[i][0] + xv[i][1] * xv[i][1] + xv[i][2] * xv[i][2] + xv[i][3] * xv[i][3];
        }
        ss = wave_sum(ss);
        const float rs = rsqrtf(ss * (1.f / DM) + 1e-6f);
        float hv[4][4];
#pragma unroll
        for (int i = 0; i < 4; ++i) {
            const int idx = i * 256 + lane * 4;
            f32x4 y = xv[i] * rs * gv[i];
            if (MODE == 2) { *(f32x4*)(p.out + (size_t)t * DM + idx) = y; }
            else {
                y = y * scv[i] + shv[i];
                hv[i][0] = y[0]; hv[i][1] = y[1]; hv[i][2] = y[2]; hv[i][3] = y[3];
                u32x2 o; o.x = pk2(y[0], y[1]); o.y = pk2(y[2], y[3]);
                *(u32x2*)(H + (size_t)t * DM + idx) = o;
            }
        }
        if (MODE == 1) {
            f32x4 ag = {0.f, 0.f, 0.f, 0.f};
#pragma unroll
            for (int i = 0; i < 4; ++i)
#pragma unroll
                for (int e = 0; e < 4; ++e) { const f32x4 w4 = rw[((i * 4 + e) * 5) * 64 + lane]; ag = ag + w4 * hv[i][e]; }
            const float rg = red4(ag, lane);
            f32x4 gl4; gl4[0] = __uint_as_float(__builtin_amdgcn_readlane(__float_as_uint(rg), 0)) + bgv[0]; gl4[1] = __uint_as_float(__builtin_amdgcn_readlane(__float_as_uint(rg), 16)) + bgv[1]; gl4[2] = __uint_as_float(__builtin_amdgcn_readlane(__float_as_uint(rg), 32)) + bgv[2]; gl4[3] = __uint_as_float(__builtin_amdgcn_readlane(__float_as_uint(rg), 48)) + bgv[3];
            int gs = 0; { float gm = gl4[0];
#pragma unroll
                for (int j = 1; j < 4; ++j) if (gl4[j] > gm) { gm = gl4[j]; gs = j; } }
            gs = __builtin_amdgcn_readfirstlane(gs);
            f32x4 ae = {0.f, 0.f, 0.f, 0.f};
            const LAS f32x4* rwe = rw + (1 + gs) * 64 + lane;
#pragma unroll
            for (int i = 0; i < 4; ++i)
#pragma unroll
                for (int e = 0; e < 4; ++e) { const f32x4 w4 = rwe[((i * 4 + e) * 5) * 64]; ae = ae + w4 * hv[i][e]; }
            const float re = red4(ae, lane);
            f32x4 el4; el4[0] = __uint_as_float(__builtin_amdgcn_readlane(__float_as_uint(re), 0)); el4[1] = __uint_as_float(__builtin_amdgcn_readlane(__float_as_uint(re), 16)); el4[2] = __uint_as_float(__builtin_amdgcn_readlane(__float_as_uint(re), 32)); el4[3] = __uint_as_float(__builtin_amdgcn_readlane(__float_as_uint(re), 48));
            LAS float* lres = (LAS float*)(lds + 83968) + w * 256 + itn * 32;
            if (lane == 0) { *(LAS f32x4*)lres = gl4; *(LAS f32x4*)(lres + 4) = el4; }
        }
    }
    if (MODE == 1) {
        asm volatile("s_waitcnt lgkmcnt(0)" ::: "memory");
        if (lane < nit) {
            const int t = tbase + lane;
            const LAS float* lr = (const LAS float*)(lds + 83968) + w * 256 + lane * 32;
            float gl[4];
#pragma unroll
            for (int j = 0; j < 4; ++j) gl[j] = lr[j];
            int gs = 0; float gm = gl[0];
#pragma unroll
            for (int j = 1; j < 4; ++j) if (gl[j] > gm) { gm = gl[j]; gs = j; }
            float den = 0.f;
#pragma unroll
            for (int j = 0; j < 4; ++j) den += expf(gl[j] - gm);
            const float gw = 1.f / den;
            float el[4];
            { const LAS float* bl = (const LAS float*)(lds + 83456) + gs * 4;
#pragma unroll
              for (int j = 0; j < 4; ++j) el[j] = lr[4 + j] + bl[j]; }
            int i1 = 0; float v1 = el[0];
#pragma unroll
            for (int j = 1; j < 4; ++j) if (el[j] > v1) { v1 = el[j]; i1 = j; }
            int i2 = -1; float v2 = -3.0e38f;
#pragma unroll
            for (int j = 0; j < 4; ++j) if (j != i1 && el[j] > v2) { v2 = el[j]; i2 = j; }
            const float t1 = 1.f / (1.f + expf(v2 - v1)), t2 = 1.f - t1;
            const int e1 = gs * 4 + i1, e2 = gs * 4 + i2;
            tok_e[t * 2] = e1; tok_e[t * 2 + 1] = e2; tok_w[t * 2] = gw * t1; tok_w[t * 2 + 1] = gw * t2;
            const int lt = t - bx * TPB; ent[lt * 2] = e1; ent[lt * 2 + 1] = e2;
        }
        __syncthreads();
        const int NE = TPB * 2;
        for (int j = tid; j < NE; j += NTHR) { const int e = ent[j]; int rk = 0; for (int k = 0; k < j; ++k) rk += (ent[k] == e) ? 1 : 0; tok_rank[bx * NE + j] = rk; }
        if (tid < 16) { int c = 0; for (int k = 0; k < NE; ++k) c += (ent[k] == tid) ? 1 : 0; ((int*)(p.ws + WS_BCNT))[bx * 16 + tid] = c; }
    }
}
__device__ __forceinline__ void ph_moe_permute(const Params& p, LAS unsigned char* lds, int l, int bx, int G) {
    const int tid = otid(), lane = tid & 63, w = tid >> 6;
    const int* tok_e = (const int*)(p.ws + WS_ROUTE); const float* tok_w = (const float*)(p.ws + WS_ROUTE + 131072); const int* tok_rank = (const int*)(p.ws + WS_ROUTE + 262144);
    int* POS = (int*)(p.ws + WS_POS); float* wperm = (float*)(p.ws + WS_WPERM); int* tilex = (int*)(p.ws + WS_TILEX);
    const int* bcnt = (const int*)(p.ws + WS_BCNT);
    LAS int* part = (LAS int*)lds;
    LAS int* base = (LAS int*)(lds + 4096);
    {
        const int e = tid & 15, pr = tid >> 4; int tot = 0, pre = 0;
        for (int bb = pr; bb < G; bb += 32) { const int c = bcnt[bb * 16 + e]; tot += c; pre += (bb < bx) ? c : 0; }
        part[pr * 16 + e] = tot; part[512 + pr * 16 + e] = pre;
    }
    __syncthreads();
    if (tid == 0) {
        int off = 0;
        for (int e = 0; e < 16; ++e) { int tot = 0, pre = 0; for (int k = 0; k < 32; ++k) { tot += part[k * 16 + e]; pre += part[512 + k * 16 + e]; }
            base[e] = off + pre; base[16 + e] = off; base[48 + e] = off + tot; off += (tot + 255) & ~255; }
        base[32] = off;
    }
    __syncthreads();
    int* rowtok = (int*)(p.ws + WS_ROWTOK);
    if (bx < 16) {
        const int r1 = (bx == 15) ? base[32] : base[16 + bx + 1];
        for (int r = base[48 + bx] + tid; r < r1; r += NTHR) { rowtok[r] = 0; wperm[r] = 0.f; }
    }
    if (bx == 0 && tid < 160) {
        const int total = base[32];
        if (tid == 0) tilex[0] = total >> 8;
        int ex = 0;
        for (int e = 1; e < 16; ++e) ex = (tid * 256 >= base[16 + e]) ? e : ex;
        if (tid * 256 < total) tilex[1 + tid] = ex;
    }
    const int NE = (NT / G) * 2;
    {
        const int it = bx * NE + w + 8 * (lane & 15);
        const int e = tok_e[it], rk = tok_rank[it]; const float tw = tok_w[it];
        const int posl = base[e] + rk;
        if (lane < 16) { POS[it] = posl; wperm[posl] = tw; rowtok[posl] = it >> 1; }
    }
    __syncthreads();
}
template <bool GA>
struct MoeOrderT {
    static constexpr bool GATHER = GA, SIGNAL = GA;
    int G, c, nct; const int* tilex; const int* rowtok;
    int mode, k, m;
    unsigned* ready;
    __device__ bool next(int i, pg8::Unit& u) const {
        const int nt = tilex[0]; int L;
        if (mode == 0) { L = i * G + c; if (L >= nt * nct) return false; }
        else if (mode == 1) { L = k + i * m; if (L >= 512) return false; }
        else { const int q = m - 1 - k; if (i > 0 || q >= 4 * (nt - 128)) return false; L = 512 + q; }
        const int rt = L / nct, ct = L - rt * nct; u.pm = rt; u.pn = tilex[1 + rt] * nct + ct; return true;
    }
    __device__ size_t aoff(const pg8::Unit& u, size_t tstepA) const { return (size_t)u.pm * tstepA; }
    __device__ size_t boff(const pg8::Unit&) const { return 0; }
};
struct EpiMoeH {
    bf16_t* HID; const float* wperm;
    __device__ __forceinline__ void operator()(const AccT& acc, const pg8::Unit& u, int wr, int wc, int fr, int fq) const {
        const int row0 = u.pm * 256 + wr * 64 + fr, f0 = (u.pn & 1) * 128 + wc * 16 + 4 * fq;
#pragma unroll
        for (int ai = 0; ai < 2; ++ai)
#pragma unroll
            for (int m = 0; m < 4; ++m) {
                const int row = row0 + ai * 128 + m * 16; const float wt = wperm[row];
#pragma unroll
                for (int bj = 0; bj < 2; ++bj) {
                    const f32x4 v0 = acc[ai][bj][m][0], v1 = acc[ai][bj][m][1];
                    const float h0 = v0[0] * __builtin_amdgcn_rcpf(1.f + __expf(-v0[0])) * v0[1] * wt, h1 = v0[2] * __builtin_amdgcn_rcpf(1.f + __expf(-v0[2])) * v0[3] * wt;
                    const float h2 = v1[0] * __builtin_amdgcn_rcpf(1.f + __expf(-v1[0])) * v1[1] * wt, h3 = v1[2] * __builtin_amdgcn_rcpf(1.f + __expf(-v1[2])) * v1[3] * wt;
                    u32x2 o; o.x = cvt_pk_bf16(h0, h1); o.y = cvt_pk_bf16(h2, h3);
                    asm volatile("global_store_dwordx2 %0, %1, off sc0 sc1" :: "v"(HID + (size_t)row * 256 + f0 + bj * 64), "v"(o) : "memory");
                }
            }
    }
};
#define XB_TMO      128
#define XB_XCNT(j)  (256  + 64 * (j))
#define XB_XSUB(j)  (1280 + 64 * (j))
#define XB_XGEN(j)  (2304 + 64 * (j))
#define XB_TOP      3328
#define XB_TOPGEN   3392
#define XCD_BAR_WORDS 3456
#define XB_SPIN_CAP (1u << 18)
__device__ __forceinline__ unsigned xb_ld(unsigned* p)              { return __hip_atomic_load(p, __ATOMIC_RELAXED, __HIP_MEMORY_SCOPE_AGENT); }
__device__ __forceinline__ unsigned xb_add(unsigned* p, unsigned v) { return __hip_atomic_fetch_add(p, v, __ATOMIC_RELAXED, __HIP_MEMORY_SCOPE_AGENT); }
__device__ __forceinline__ unsigned xb_xcc_id() { return (unsigned)__builtin_amdgcn_s_getreg((3 << 11) | 20) & 0xFu; }
#define XB_SPIN(cond, bar) do { unsigned _sp = 0; while (cond) { __builtin_amdgcn_s_sleep(1); \
    if ((++_sp & 255u) == 0u) { if (xb_ld(&(bar)[XB_TMO])) break; if (_sp > XB_SPIN_CAP) { atomicAdd(&(bar)[XB_TMO], 1u); break; } } } } while (0)
constexpr int CW_BAR = 4096;
constexpr int CW_RDY = 16384;
__device__ __forceinline__ void ph_moe_gemm1(const Params& p, LAS unsigned char* lds, int l, int bx, int G) {
    pg8::Gemm g{(const bf16_t*)(p.ws + WS_H), (const bf16_t*)(p.ws + WS_WGU), 1024, 2048u, 128u, 1024};
    MoeOrderT<true> S{G, bx, 2, (const int*)(p.ws + WS_TILEX), (const int*)(p.ws + WS_ROWTOK), 0, 0, 0, (unsigned*)(p.ws + WS_CTL) + CW_RDY + l * 256};
    EpiMoeH E{(bf16_t*)(p.ws + WS_HIDP), (const float*)(p.ws + WS_WPERM)};
    pg8::gemm_phase<EpiMoeH, MoeOrderT<true>>(lds, g, S, E);
}
__device__ __forceinline__ void ph_moe_gemm2(const Params& p, LAS unsigned char* lds, int l, int bx, int G, bool fused) {
    pg8::Gemm g{(const bf16_t*)(p.ws + WS_HIDP), (const bf16_t*)(p.ws + WS_WD), 256, 512u, 128u, 256};
    EpiBf16 E{(bf16_t*)(p.ws + WS_Y), 1024, 3};
    const int* tilex = (const int*)(p.ws + WS_TILEX);
    unsigned* ready = (unsigned*)(p.ws + WS_CTL) + CW_RDY + l * 256;
    int n2 = 2 * tilex[0] - 256; n2 = n2 < 0 ? 0 : n2;
    const int m = 256 - n2, k = bx - n2;
    if (fused && k < 0) return;
#pragma unroll 1
    for (int part = fused ? 1 : 0; part < (fused ? 3 : 1); ++part) {
        MoeOrderT<false> S{G, bx, 4, tilex, (const int*)nullptr, part, k, m, ready};
        pg8::Unit u0;
        if (!S.next(0, u0)) continue;
        if (fused) {
            if (otid() == 0) {
                unsigned* bar = (unsigned*)(p.ws + WS_CTL) + CW_BAR; pg8::Unit u;
                for (int i = 0; S.next(i, u); ++i) XB_SPIN(xb_ld(&ready[u.pm]) < 2u, bar);
                __builtin_amdgcn_fence(__ATOMIC_ACQUIRE, "agent");
                asm volatile("s_waitcnt vmcnt(0)" ::: "memory");
            }
            __syncthreads();
        }
        pg8::gemm_phase<EpiBf16, MoeOrderT<false>>(lds, g, S, E);
    }
}


__device__ __forceinline__ void ph_mod(const Params& p, LAS unsigned char* lds, int bx, int G) {
    const int tid = otid();
    LAS float* cs = (LAS float*)lds;
    LAS float* red = (LAS float*)(lds + 16384);
    float* mod = (float*)(p.ws + WS_MOD);
    for (int i = tid; i < 4096; i += NTHR) { const float v = p.in[1][i]; cs[i] = v / (1.f + expf(-v)); }
    __syncthreads();
    const int col = tid & 127, ch = tid >> 7;
    for (int it = bx; it < 4 * 48; it += G) {
        const int l = it / 48, j = (it % 48) * 128 + col;
        const float* w = p.in[5] + (size_t)l * 1024 * 6144 + (size_t)(ch * 256) * 6144 + j;
        float a0 = 0.f, a1 = 0.f, a2 = 0.f, a3 = 0.f;
#pragma unroll 32
        for (int i = 0; i < 256; ++i) { const float wv = w[(size_t)i * 6144]; const int ii = ch * 256 + i; a0 += cs[ii] * wv; a1 += cs[1024 + ii] * wv; a2 += cs[2048 + ii] * wv; a3 += cs[3072 + ii] * wv; }
        red[(ch * 4 + 0) * 128 + col] = a0; red[(ch * 4 + 1) * 128 + col] = a1; red[(ch * 4 + 2) * 128 + col] = a2; red[(ch * 4 + 3) * 128 + col] = a3;
        __syncthreads();
        {
            const float sum = red[(0 * 4 + ch) * 128 + col] + red[(1 * 4 + ch) * 128 + col] + red[(2 * 4 + ch) * 128 + col] + red[(3 * 4 + ch) * 128 + col];
            mod[(size_t)(l * 4 + ch) * 6144 + j] = sum + p.in[6][l * 6144 + j];
        }
        __syncthreads();
    }
}
__device__ __forceinline__ void ph_rope(const Params& p, int bx, int G) {
    float* tab = (float*)(p.ws + WS_ROPE);
    for (int i = bx * NTHR + otid(); i < SEQ * 8; i += G * NTHR) {
        const int pos = i >> 3, j = i & 7;
        const float inv = (float)pow(500000.0, -(double)j / 8.0);
        const float ang = (float)pos * inv;
        tab[i] = (float)cos((double)ang); tab[SEQ * 8 + i] = (float)sin((double)ang);
    }
}

struct XcdBarrier { unsigned* bar; unsigned x; volatile LAS unsigned* st; };
__device__ __forceinline__ XcdBarrier xcd_barrier_post(unsigned* bar, volatile LAS unsigned* st) {
    XcdBarrier b; b.bar = bar; b.x = xb_xcc_id(); b.st = st;
    if (threadIdx.x == 0) (void)xb_add(&bar[XB_XCNT(b.x)], 1u);
    return b;
}
__device__ __forceinline__ void xcd_barrier_complete(unsigned* bar, unsigned x, unsigned& nloc, unsigned& nx) {
    const unsigned G = gridDim.x * gridDim.y * gridDim.z;
    unsigned sum, cnt, mine, sp = 0u;
    for (;;) {
        sum = 0u; cnt = 0u; mine = 0u;
#pragma unroll
        for (unsigned j = 0; j < 16; ++j) { const unsigned c = xb_ld(&bar[XB_XCNT(j)]); sum += c; cnt += (c > 0u) ? 1u : 0u; mine = (j == x) ? c : mine; }
        if (sum == G) break;
        __builtin_amdgcn_s_sleep(1);
        if ((++sp & 255u) == 0u) { if (xb_ld(&bar[XB_TMO])) break; if (sp > XB_SPIN_CAP) { atomicAdd(&bar[XB_TMO], 1u); break; } }
    }
    nloc = mine > 0u ? mine : 1u; nx = cnt > 0u ? cnt : 1u;
}
__device__ __forceinline__ void xcd_barrier(const XcdBarrier& b) {
    asm volatile("s_waitcnt vmcnt(0)" ::: "memory");
    __syncthreads();
    if (threadIdx.x == 0) {
        unsigned* bar = b.bar;
        __builtin_amdgcn_s_waitcnt(0);
        unsigned nloc = b.st[0], nx = b.st[1];
        if (nloc == 0u) { xcd_barrier_complete(bar, b.x, nloc, nx); b.st[0] = nloc; b.st[1] = nx; }
        const unsigned old = xb_add(&bar[XB_XSUB(b.x)], 1u);
        const unsigned gen = old / nloc;
        if (old + 1u == (gen + 1u) * nloc) {
            __builtin_amdgcn_fence(__ATOMIC_RELEASE, "agent");
            asm volatile("s_waitcnt vmcnt(0)" ::: "memory");
            const unsigned og = xb_add(&bar[XB_TOP], 1u);
            const unsigned tg = og / nx;
            if (og + 1u == (tg + 1u) * nx) xb_add(&bar[XB_TOPGEN], 1u);
            else XB_SPIN(xb_ld(&bar[XB_TOPGEN]) == tg, bar);
            __builtin_amdgcn_fence(__ATOMIC_ACQUIRE, "agent");
            xb_add(&bar[XB_XGEN(b.x)], 1u);
            asm volatile("s_waitcnt vmcnt(0)" ::: "memory");
        } else {
            XB_SPIN(xb_ld(&bar[XB_XGEN(b.x)]) == gen, bar);
            __builtin_amdgcn_fence(__ATOMIC_ACQUIRE, "agent");
            asm volatile("s_waitcnt vmcnt(0)" ::: "memory");
        }
    }
    __syncthreads();
}
constexpr int LDS_XB = 147200;

#ifndef REP_P
#define REP_P 1
#endif
#ifndef REP_T
#define REP_T 1
#endif
#ifndef REP_B
#define REP_B 0
#endif
#ifndef REP_N
#define REP_N 1
#endif
#ifndef REP_O
#define REP_O 1
#endif
#ifndef REP_N1
#define REP_N1 1
#endif
#ifndef REP_AE
#define REP_AE 1
#endif
#ifndef REP_AO
#define REP_AO 1
#endif
#ifndef REP_G
#define REP_G 1
#endif
__global__ void __launch_bounds__(NTHR, 2) mega_fwd(Params p) {
    extern __shared__ __attribute__((aligned(16))) unsigned char lds_raw[];
    LAS unsigned char* lds = (LAS unsigned char*)lds_raw;
    const int bx = blockIdx.x, G = gridDim.x;
    typedef const Params __attribute__((address_space(4)))* CP;
    CP kp = (CP)__builtin_amdgcn_kernarg_segment_ptr();
#define LP() ({ CP q_ = kp; asm volatile("" : "+s"(q_)); Params r_; _Pragma("unroll") for (int i_ = 0; i_ < 25; ++i_) r_.in[i_] = q_->in[i_]; r_.out = q_->out; r_.ws = q_->ws; r_; })
    if (threadIdx.x < 4) ((LAS unsigned*)(lds + LDS_XB))[threadIdx.x] = 0u;
    if (threadIdx.x == 0) *(LAS unsigned*)(lds + LDS_TACC) = 0u;
    __syncthreads();
    const XcdBarrier bar = xcd_barrier_post((unsigned*)(kp->ws + WS_CTL) + CW_BAR, (volatile LAS unsigned*)(lds + LDS_XB));
#define GRID_BAR() do { TSTART(10) XcdBarrier b2_ = bar; asm volatile("" : "+s"(b2_.bar), "+s"(b2_.x)); xcd_barrier(b2_); TSTOP(10) } while (0)
    for (int rep = 0; rep < REP_P; ++rep) {
    { TSTART(15) { const Params pp = LP(); ph_conv_static(pp, lds, bx, G); } TSTOP(15) }
    __syncthreads();
    { TSTART(15) { const Params pp = LP(); ph_mod(pp, lds, bx, G); } TSTOP(15) }
    { TSTART(15) { const Params pp = LP(); ph_rope(pp, bx, G); } TSTOP(15) }
    { TSTART(15) { const Params pp = LP(); ph_misc(pp, lds, bx, G); } TSTOP(15) }
    __syncthreads();
    }
    GRID_BAR();
#pragma unroll 1
    for (int l = 0; l < DEPTH; ++l) {
        { TSTART(11) { const Params pp = LP(); ph_norm<0>(pp, lds, l, bx, G); } TSTOP(11) }
        for (int rep = 0; rep < REP_T; ++rep) { TSTART(16) { const Params pp = LP(); ph_conv_moe(pp, lds, l, bx, G); } TSTOP(16) }
        if ((l & 1) == 0) { const Params pp = LP(); ph_zero_kmsum(pp, bx, G); }
        GRID_BAR();
#pragma unroll 1
        for (int si = 0; si < ((l & 1) ? 2 : 1); ++si) {
            { TSTART(13) { const Params pp = LP(); ph_inproj(pp, lds, l, bx, G, (l & 1) ? 1 + si : 0); } TSTOP(13) }
            GRID_BAR();
        }
        if ((l & 1) == 0) {
            for (int rep = 0; rep < REP_AE; ++rep) { TSTART(14) { const Params pp = LP(); ph_attn_even(pp, lds, l, bx, G); } TSTOP(14) }
            GRID_BAR();
        } else {
            for (int rep = 0; rep < REP_T; ++rep) { TSTART(12) { const Params pp = LP(); ph_compress2(pp, lds, l, bx, G); } TSTOP(12) }
            GRID_BAR();
            for (int rep = 0; rep < REP_AO; ++rep) { TSTART(14) { const Params pp = LP(); ph_attn_odd(pp, lds, bx, G); } TSTOP(14) }
            GRID_BAR();
        }
        for (int rep = 0; rep < (l == 0 ? REP_O : 1); ++rep) { TSTART(13) { const Params pp = LP(); ph_outproj(pp, lds, l, bx, G); } TSTOP(13) }
        GRID_BAR();
        for (int rep = 0; rep < REP_N1; ++rep) { TSTART(18) { const Params pp = LP(); ph_norm<1>(pp, lds, l, bx, G); __syncthreads(); } TSTOP(18) }
        GRID_BAR();
        for (int rep = 0; rep < REP_T; ++rep) { TSTART(17) { const Params pp = LP(); ph_moe_permute(pp, lds, l, bx, G); } TSTOP(17) }
        GRID_BAR();
        { TSTART(20) { const Params pp = LP(); ph_moe_gemm1(pp, lds, l, bx, G); } TSTOP(20) }
        if (G != 256) GRID_BAR();
        { TSTART(21) { const Params pp = LP(); ph_moe_gemm2(pp, lds, l, bx, G, G == 256); } TSTOP(21) }
        GRID_BAR();
    }
    for (int rep = 0; rep < REP_B; ++rep) GRID_BAR();
    for (int rep = 0; rep < REP_N; ++rep) { TSTART(11) { const Params pp = LP(); ph_norm<2>(pp, lds, 0, bx, G); } TSTOP(11) }
#undef GRID_BAR
    if (TSEL != 0 && blockIdx.x == 0 && threadIdx.x == 0) {
        const unsigned long long t0 = __builtin_amdgcn_s_memrealtime(); const unsigned long long dt = *(LAS unsigned*)(lds + LDS_TACC);
        while (__builtin_amdgcn_s_memrealtime() - t0 < dt) __builtin_amdgcn_s_sleep(8);
    }
}

extern "C" void kernel_launch(void* const* d_in, const int* in_sizes, int n_in, void* d_out, int out_size, void* d_ws, size_t ws_size, hipStream_t stream) {
    static int grid = 0;
    if (grid == 0) {
        if (n_in != 25 || out_size != NT * DM || ws_size < WS_END2) { fprintf(stderr, "kernel_launch: unexpected shapes / workspace (n_in %d out %d ws %zu, need %zu)\n", n_in, out_size, ws_size, (size_t)WS_END2); grid = -1; return; }
        int dev = 0, cus = 0;
        if (hipGetDevice(&dev) != hipSuccess || hipDeviceGetAttribute(&cus, hipDeviceAttributeMultiprocessorCount, dev) != hipSuccess) { grid = -1; return; }
        if (hipFuncSetAttribute((const void*)mega_fwd, hipFuncAttributeMaxDynamicSharedMemorySize, LDS_BYTES) != hipSuccess) { fprintf(stderr, "kernel_launch: hipFuncSetAttribute failed\n"); grid = -1; return; }
        int per_cu = 0;
        if (hipOccupancyMaxActiveBlocksPerMultiprocessor(&per_cu, (const void*)mega_fwd, NTHR, LDS_BYTES) != hipSuccess || per_cu < 1) { fprintf(stderr, "kernel_launch: occupancy query says %d\n", per_cu); }
        (void)hipGetLastError();
        grid = cus < 256 ? cus : 256;
    }
    if (grid < 0) return;
    Params prm; memset(&prm, 0, sizeof(prm)); for (int i = 0; i < 25; ++i) prm.in[i] = (const float*)d_in[i]; prm.out = (float*)d_out; prm.ws = (unsigned char*)d_ws;
    (void)hipMemsetAsync(d_ws, 0, 1 * MiB, stream);
    mega_fwd<<<grid, NTHR, LDS_BYTES, stream>>>(prm);
}
```

```cpp
#include <hip/hip_runtime.h>
#include <stdint.h>
#include <stdio.h>
#include <string.h>

typedef unsigned short bf16_t;
typedef unsigned long long u64;

constexpr int NB = 4, SEQ = 4096, DM = 1024, NT = NB * SEQ, DEPTH = 4;
constexpr int PW = 2048;
constexpr float C2 = 0.125f * 1.4426950408889634f;
constexpr float NEGBIG = -1e30f;
constexpr float LINIT0 = 0.2f, LINIT1 = 0.47071301834358416f;

constexpr size_t MiB = 1u << 20;
constexpr size_t WS_CTL = 0;
constexpr size_t WS_MOD = 1 * MiB;
constexpr size_t WS_ROPE = 2 * MiB;
constexpr size_t WS_MISC = 3 * MiB;
constexpr size_t WS_KMEAN = 3 * MiB + 65536;
constexpr size_t WS_MMASK = 4 * MiB;
constexpr size_t WS_SMASK = 5 * MiB;
constexpr size_t WS_KCMP = 6 * MiB;
constexpr size_t WS_VCMPT = 6 * MiB + 524288;
constexpr size_t WS_CH = 7 * MiB;
constexpr size_t WS_ROUTE = 11 * MiB;
constexpr size_t WS_X = 16 * MiB;
constexpr size_t WS_H = 80 * MiB;
constexpr size_t WS_R = 112 * MiB;
constexpr size_t WS_P = WS_R;
constexpr size_t WS_VT = WS_R + 64 * MiB;
constexpr size_t WS_O = WS_R + 96 * MiB;
constexpr size_t WS_DT = WS_R + 128 * MiB;
constexpr size_t WS_PF = WS_R + 64 * MiB;
constexpr size_t WS_END = 304 * MiB;

constexpr int CW_CNT = 64;

__device__ __forceinline__ bf16_t f2bf(float f) { unsigned u = __float_as_uint(f); u = (u + 0x7fffu + ((u >> 16) & 1u)) >> 16; return (bf16_t)u; }
__device__ __forceinline__ float bf2f(bf16_t h) { return __uint_as_float(((unsigned)h) << 16); }
__device__ __forceinline__ float wave_sum(float v) {
#pragma unroll
    for (int o = 32; o >= 1; o >>= 1) v += __shfl_xor(v, o);
    return v;
}

#define LAS __attribute__((address_space(3)))
typedef short bf16x8 __attribute__((ext_vector_type(8)));
typedef float f32x4 __attribute__((ext_vector_type(4)));
typedef float f32x16 __attribute__((ext_vector_type(16)));
typedef unsigned u32x4 __attribute__((ext_vector_type(4)));
typedef unsigned u32x2 __attribute__((ext_vector_type(2)));

constexpr int NWAVES = 8, NTHR = 512;
constexpr int LDS_BYTES = 147456;
constexpr size_t WS_WIN = 304 * MiB;
constexpr size_t WS_WOUT = 328 * MiB;
constexpr size_t WS_W1T = 336 * MiB;
constexpr size_t WS_WGU = 340 * MiB;
constexpr size_t WS_WD = 356 * MiB;
constexpr size_t WS_END2 = 364 * MiB;
constexpr size_t WS_VCX = 12 * MiB;
constexpr size_t WS_FOLD = WS_MISC + 1024;
constexpr int MP_ROWS = 36864;
constexpr size_t WS_APERM = WS_R;
constexpr size_t WS_HIDP = WS_R + 72 * MiB;
constexpr size_t WS_Y = WS_R + 96 * MiB;
constexpr size_t WS_POS = WS_ROUTE + 393216;
constexpr size_t WS_WPERM = WS_ROUTE + 524288;
constexpr size_t WS_TILEX = WS_ROUTE + 786432;
constexpr size_t WS_ROWTOK = WS_ROUTE + 868352;
constexpr size_t WS_BCNT = WS_ROUTE + 851968;

struct Params { const float* in[25]; float* out; unsigned char* ws; };
__device__ __forceinline__ int otid() { int t = threadIdx.x; asm volatile("" : "+v"(t)); return t; }

__device__ __forceinline__ unsigned pk2(float lo, float hi) { return (unsigned)f2bf(lo) | ((unsigned)f2bf(hi) << 16); }
__device__ __forceinline__ unsigned cvt_pk_bf16(float lo, float hi) { unsigned r; asm volatile("v_cvt_pk_bf16_f32 %0, %1, %2" : "=v"(r) : "v"(lo), "v"(hi)); return r; }

__device__ __forceinline__ void conv_item(const float* W, int ldw, int col0, int nvalid, int K, bf16_t* WT, int row0, int rmul, LAS float* scr, int item, int nblk, int lane) {
    const int kb = item / nblk, nb = item % nblk, k0 = 64 * kb, n0 = 64 * nb;
    const int c4 = lane & 15, rr = lane >> 4;
    const bool okc = (n0 + 4 * c4) < nvalid;
    f32x4 v[16];
#pragma unroll
    for (int i = 0; i < 16; ++i) v[i] = okc ? *(const f32x4*)(W + (size_t)(k0 + rr + 4 * i) * ldw + col0 + n0 + 4 * c4) : (f32x4){0.f, 0.f, 0.f, 0.f};
#pragma unroll
    for (int i = 0; i < 16; ++i) { const int kk = rr + 4 * i;
        scr[(4 * c4 + 0) * 65 + kk] = v[i][0]; scr[(4 * c4 + 1) * 65 + kk] = v[i][1]; scr[(4 * c4 + 2) * 65 + kk] = v[i][2]; scr[(4 * c4 + 3) * 65 + kk] = v[i][3]; }
    asm volatile("s_waitcnt lgkmcnt(0)" ::: "memory");
    const int c = lane & 7;
#pragma unroll
    for (int j = 0; j < 8; ++j) { const int n = (lane >> 3) + 8 * j; const LAS float* sp = scr + n * 65 + 8 * c;
        u32x4 o; o.x = pk2(sp[0], sp[1]); o.y = pk2(sp[2], sp[3]); o.z = pk2(sp[4], sp[5]); o.w = pk2(sp[6], sp[7]);
        *(u32x4*)(WT + (size_t)(row0 + (n0 + n) * rmul) * K + k0 + 8 * c) = o; }
    asm volatile("s_waitcnt lgkmcnt(0)" ::: "memory");
}
struct ConvCtx { LAS float* scr; int gw, NGW, lane, base; };
__device__ __forceinline__ void conv_job(ConvCtx& cx, const float* W, int ldw, int col0, int ncols, int nvalid, int K, bf16_t* WT, int row0, int rmul) {
    const int nblk = ncols / 64, nitems = (K / 64) * nblk;
    int it = cx.gw - (cx.base % cx.NGW); if (it < 0) it += cx.NGW;
    for (; it < nitems; it += cx.NGW) conv_item(W, ldw, col0, nvalid, K, WT, row0, rmul, cx.scr, it, nblk, cx.lane);
    cx.base += nitems;
}
__device__ __forceinline__ void ph_conv_static(const Params& p, LAS unsigned char* lds, int vcu, int G) {
    const int tid = otid(), lane = tid & 63, wave = tid >> 6;
    ConvCtx cx; cx.scr = (LAS float*)(lds + wave * 16640); cx.gw = vcu * NWAVES + wave; cx.NGW = G * NWAVES; cx.lane = lane; cx.base = 0;
    for (int l = 0; l < DEPTH; ++l) {
        const int li = l >> 1;
        bf16_t* win = (bf16_t*)(p.ws + WS_WIN) + (size_t)l * 3072 * 1024;
        bf16_t* wout = (bf16_t*)(p.ws + WS_WOUT) + (size_t)l * 1024 * 1024;
        if ((l & 1) == 0) {
            const float* w = p.in[7] + (size_t)li * 1024 * 3072;
            conv_job(cx, w, 3072, 0, 512, 512, 1024, win, 0, 1);
            conv_job(cx, w, 3072, 512, 512, 512, 1024, win, 512, 1);
            conv_job(cx, w, 3072, 1536, 512, 512, 1024, win, 1024, 1);
            conv_job(cx, w, 3072, 2048, 512, 512, 1024, win, 1536, 1);
            conv_job(cx, w, 3072, 1024, 512, 512, 1024, win, 2048, 1);
            conv_job(cx, w, 3072, 2560, 512, 512, 1024, win, 2560, 1);
            conv_job(cx, p.in[8] + (size_t)li * 1024 * 1024, 1024, 0, 1024, 1024, 1024, wout, 0, 1);
        } else {
            const float* w = p.in[11] + (size_t)li * 1024 * 2608;
            conv_job(cx, w, 2608, 0, 1024, 1024, 1024, win, 0, 1);
            conv_job(cx, w, 2608, 1024, 256, 256, 1024, win, 1024, 1);
            conv_job(cx, w, 2608, 1536, 256, 256, 1024, win, 1280, 1);
            conv_job(cx, w, 2608, 2048, 256, 256, 1024, win, 1536, 1);
            conv_job(cx, w, 2608, 1280, 256, 256, 1024, win, 1792, 1);
            conv_job(cx, w, 2608, 1792, 256, 256, 1024, win, 2048, 1);
            conv_job(cx, w, 2608, 2304, 256, 256, 1024, win, 2304, 1);
            conv_job(cx, w, 2608, 2560, 256, 48, 1024, win, 2560, 1);
            conv_job(cx, p.in[12] + (size_t)li * 1024 * 1024, 1024, 0, 1024, 1024, 1024, wout, 0, 1);
            bf16_t* w1t = (bf16_t*)(p.ws + WS_W1T) + (size_t)li * 2 * 256 * 2048;
            conv_job(cx, p.in[14] + (size_t)(li * 2 + 0) * 2048 * 256, 256, 0, 256, 256, 2048, w1t, 0, 1);
            conv_job(cx, p.in[14] + (size_t)(li * 2 + 1) * 2048 * 256, 256, 0, 256, 256, 2048, w1t + (size_t)256 * 2048, 0, 1);
        }
    }
}
#define XB_TMO      128
#define XB_XCNT(j)  (256  + 64 * (j))
#define XB_XSUB(j)  (1280 + 64 * (j))
#define XB_XGEN(j)  (2304 + 64 * (j))
#define XB_TOP      3328
#define XB_TOPGEN   3392
#define XCD_BAR_WORDS 3456
#define XB_SPIN_CAP (1u << 18)
__device__ __forceinline__ unsigned xb_ld(unsigned* p)              { return __hip_atomic_load(p, __ATOMIC_RELAXED, __HIP_MEMORY_SCOPE_AGENT); }
__device__ __forceinline__ unsigned xb_add(unsigned* p, unsigned v) { return __hip_atomic_fetch_add(p, v, __ATOMIC_RELAXED, __HIP_MEMORY_SCOPE_AGENT); }
__device__ __forceinline__ unsigned xb_xcc_id() { return (unsigned)__builtin_amdgcn_s_getreg((3 << 11) | 20) & 0xFu; }
#define XB_SPIN(cond, bar) do { unsigned _sp = 0; while (cond) { __builtin_amdgcn_s_sleep(1); \
    if ((++_sp & 255u) == 0u) { if (xb_ld(&(bar)[XB_TMO])) break; if (_sp > XB_SPIN_CAP) { atomicAdd(&(bar)[XB_TMO], 1u); break; } } } } while (0)
constexpr int CW_BAR = 4096;
constexpr int CW_RDY = 16384;
constexpr int CW_RDH = 20480;
constexpr int CW_RDX = 24576;
#define WAIT_COUNTER(ws_, idx_, need_) do { if (otid() == 0) { unsigned* cw_ = (unsigned*)((ws_) + WS_CTL); XB_SPIN(xb_ld(&cw_[idx_]) < (unsigned)(need_), cw_ + CW_BAR); \
        __builtin_amdgcn_fence(__ATOMIC_ACQUIRE, "agent"); asm volatile("s_waitcnt vmcnt(0)" ::: "memory"); } __syncthreads(); } while (0)
__device__ __forceinline__ void ph_zero_kmsum(const Params& p, int bx, int G) {
    float* km = (float*)(p.ws + WS_KMEAN);
    int gstride = G * NTHR; asm volatile("" : "+s"(gstride));
    float z = 0.f; asm volatile("" : "+v"(z));
    for (int i = bx * NTHR + otid(); i < NB * 8 * 16 * 64; i += gstride) km[i] = z;
}
__device__ __forceinline__ void ph_conv_moe(const Params& p, LAS unsigned char* lds, int l, int vcu, int G) {
    const int tid = otid(), lane = tid & 63, wave = tid >> 6;
    ConvCtx cx; cx.scr = (LAS float*)(lds + wave * 16640); cx.gw = vcu * NWAVES + wave; cx.NGW = G * NWAVES; cx.lane = lane; cx.base = 0;
    bf16_t* wgu = (bf16_t*)(p.ws + WS_WGU); bf16_t* wd = (bf16_t*)(p.ws + WS_WD);
    for (int e = 0; e < 16; ++e) {
        conv_job(cx, p.in[22] + (size_t)(l * 16 + e) * 1024 * 256, 256, 0, 256, 256, 1024, wgu + (size_t)e * 512 * 1024, 0, 2);
        conv_job(cx, p.in[23] + (size_t)(l * 16 + e) * 1024 * 256, 256, 0, 256, 256, 1024, wgu + (size_t)e * 512 * 1024, 1, 2);
        conv_job(cx, p.in[24] + (size_t)(l * 16 + e) * 256 * 1024, 1024, 0, 1024, 1024, 256, wd + (size_t)e * 1024 * 256, 0, 1);
    }
}

namespace pg8 {
constexpr int BM = 256, BK = 64, HALF = 128, HTB = HALF * BK * 2, STAGE_BYTES = 8 * HTB, NXCD = 8, WGM = 8;
__host__ __device__ __forceinline__ int lds_byte(int r, int c) { const int st = (r >> 4) * 2 + (c >> 5), rr = r & 15, cc = c & 31, ob = rr * 64 + cc * 2; return st * 1024 + (ob ^ (((ob >> 9) & 1) << 5)); }
__host__ __device__ __forceinline__ void stage_rc(int b, int& R, int& C) { const int st = b / 1024, sb = b % 1024, swz = sb ^ (((sb >> 9) & 1) << 5); R = (st >> 1) * 16 + swz / 64; C = (st & 1) * 32 + (swz % 64) / 2; }
__host__ __device__ __forceinline__ int perm32(int rho) { const int n = rho >> 4, i = rho & 15; return 8 * (i >> 2) + 4 * n + (i & 3); }
struct Unit { int pm, pn; };
struct Gemm { const bf16_t* A; const bf16_t* Bt; int K; unsigned lda_b; unsigned kstepA; int ldb; };
template <bool SIG>
struct StaticOrderT {
    static constexpr bool GATHER = false, SIGNAL = SIG;
    unsigned* ready = nullptr;
    int nM, nN, nwg, G, c;
    __host__ __device__ void init(int M, int N, int G_, int c_) { nM = M / BM; nN = N / BM; nwg = nM * nN; G = G_; c = c_; }
    __host__ __device__ bool next(int i, Unit& u) const {
        const long L = (long)i * G + c; if (L >= nwg) return false;
        int wgid = (int)L; { const int q = nwg / NXCD, r = nwg % NXCD, xcd = wgid % NXCD, off = wgid / NXCD; wgid = (xcd < r ? xcd * (q + 1) : r * (q + 1) + (xcd - r) * q) + off; }
        const int nig = WGM * nN, gid = wgid / nig, fm = gid * WGM, gsz = (nM - fm) < WGM ? (nM - fm) : WGM;
        u.pm = fm + ((wgid % nig) % gsz); u.pn = (wgid % nig) / gsz; return true;
    }
    __host__ __device__ size_t aoff(const Unit& u, size_t tstepA) const { return (size_t)u.pm * tstepA; }
    __host__ __device__ size_t boff(const Unit&) const { return 0; }
};
typedef StaticOrderT<false> StaticOrder;
template <class Epi, class Sched>
__device__ __forceinline__ void gemm_phase(LAS unsigned char* lds, const Gemm g, const Sched& S, const Epi& E) {
    const int tid = otid(), wid = __builtin_amdgcn_readfirstlane(tid >> 6), lane = tid & 63, wr = wid >> 2, wc = wid & 3, fr = lane & 15, fq = lane >> 4;
    const int K = g.K, nt = K / BK;
    unsigned voffA[2], voffB[2];
#pragma unroll
    for (int i = 0; i < 2; ++i) { int R, C; stage_rc(tid * 16 + i * 8192, R, C); const int Rb = (R & ~31) + perm32(R & 31);
        voffA[i] = (unsigned)R * g.lda_b + (unsigned)C * 2u; voffB[i] = (unsigned)(Rb * g.ldb + C) * 2u; }
    const size_t kstepA = g.kstepA, kstepB = (size_t)(BK * 2);
    const size_t hstepA = (size_t)HALF * g.lda_b, hstepB = (size_t)HALF * g.ldb * 2;
    const size_t tstepA = 2 * hstepA, tstepB = 2 * hstepB;
    const unsigned ldsw = (unsigned)wid * 1024u;
    const int aoff = lds_byte(wr * 64 + fr, fq * 8), boff = lds_byte(wc * 32 + fr, fq * 8);
#define PG8_SA(b, h) (((b) * 2 + (h)) * HTB)
#define PG8_SB(b, h) ((4 + (b) * 2 + (h)) * HTB)
#define PG8_STAGE(bufoff, gbase, voff) do { _Pragma("unroll") for (int _i = 0; _i < 2; ++_i) \
        __builtin_amdgcn_global_load_lds((const unsigned*)((const char*)(gbase) + (voff)[_i]), (LAS unsigned*)(lds + (bufoff) + ldsw + _i * 8192), 16, 0, 0); } while (0)
#define PG8_LDA(dst, b, h) do { _Pragma("unroll") for (int m = 0; m < 4; ++m) _Pragma("unroll") for (int k = 0; k < 2; ++k) dst[m][k] = *(const LAS bf16x8*)(lds + PG8_SA(b, h) + aoff + m * 2048 + k * 1024); } while (0)
#define PG8_LDB(dst, b, h) do { _Pragma("unroll") for (int n = 0; n < 2; ++n) _Pragma("unroll") for (int k = 0; k < 2; ++k) dst[n][k] = *(const LAS bf16x8*)(lds + PG8_SB(b, h) + boff + n * 2048 + k * 1024); } while (0)
#define PG8_MMA(ai, bj, At, Bt) do { __builtin_amdgcn_s_setprio(1); _Pragma("unroll") for (int m = 0; m < 4; ++m) _Pragma("unroll") for (int n = 0; n < 2; ++n) _Pragma("unroll") for (int k = 0; k < 2; ++k) \
        acc[ai][bj][m][n] = __builtin_amdgcn_mfma_f32_16x16x32_bf16(Bt[n][k], At[m][k], acc[ai][bj][m][n], 0, 0, 0); __builtin_amdgcn_s_setprio(0); } while (0)
#define PG8_WAIT_V(n) asm volatile("s_waitcnt vmcnt(" #n ")" ::: "memory")
#define PG8_WAIT_L(n) asm volatile("s_waitcnt lgkmcnt(" #n ")" ::: "memory")
#define PG8_BAR __builtin_amdgcn_s_barrier()
#define PG8_SCHED __builtin_amdgcn_sched_barrier(0)
    Unit cur, nxt; int ui = 0;
    if (!S.next(0, cur)) return;
    unsigned vC[2][2], vN[2][2];
    LAS int* rtl = (LAS int*)(lds + STAGE_BYTES);
    int Rg[2], Cg[2];
    if constexpr (Sched::GATHER) {
        { Unit uu; for (int i = 0; i < 15 && S.next(i, uu); ++i) if (tid < 256) rtl[i * 256 + tid] = S.rowtok[uu.pm * 256 + tid]; }
        __syncthreads();
#pragma unroll
        for (int i = 0; i < 2; ++i) stage_rc(tid * 16 + i * 8192, Rg[i], Cg[i]);
#pragma unroll
        for (int h = 0; h < 2; ++h)
#pragma unroll
            for (int i = 0; i < 2; ++i) { vC[h][i] = (unsigned)rtl[Rg[i] + 128 * h] * g.lda_b + (unsigned)Cg[i] * 2u; vN[h][i] = vC[h][i]; }
    }
#define PG8_STAGE_A(bufoff, kb, h, nx) do { if constexpr (Sched::GATHER) { unsigned vv_[2]; vv_[0] = (nx) ? vN[h][0] : vC[h][0]; vv_[1] = (nx) ? vN[h][1] : vC[h][1]; PG8_STAGE(bufoff, (const char*)g.A + (kb), vv_); } \
        else PG8_STAGE(bufoff, ((nx) ? nA : cA) + (kb) + (h) * hstepA, voffA); } while (0)
    f32x4 acc[2][2][4][2];
#pragma unroll
    for (int a = 0; a < 2; ++a)
#pragma unroll
        for (int b = 0; b < 2; ++b)
#pragma unroll
            for (int m = 0; m < 4; ++m)
#pragma unroll
                for (int n = 0; n < 2; ++n) acc[a][b][m][n] = (f32x4){0.f, 0.f, 0.f, 0.f};
    bf16x8 At[4][2], B0[2][2], B1[2][2];
    const char* cA = (const char*)g.A + S.aoff(cur, tstepA); const char* cB = (const char*)g.Bt + (size_t)cur.pn * tstepB + S.boff(cur);
    {
        const char* nA = cA;
        PG8_STAGE(PG8_SB(0, 0), cB, voffB); PG8_STAGE(PG8_SB(0, 1), cB + hstepB, voffB); PG8_STAGE_A(PG8_SA(0, 0), (size_t)0, 0, false); PG8_STAGE_A(PG8_SA(0, 1), (size_t)0, 1, false);
        if (wr == 1) PG8_BAR;
        PG8_WAIT_V(2); PG8_BAR;
        PG8_STAGE(PG8_SB(1, 0), cB + kstepB, voffB); PG8_STAGE_A(PG8_SA(1, 0), kstepA, 0, false); PG8_STAGE(PG8_SB(1, 1), cB + hstepB + kstepB, voffB);
        PG8_WAIT_V(6); PG8_BAR;
    }
    for (;;) {
        const bool has_next = S.next(ui + 1, nxt);
        const char* nA = has_next ? (const char*)g.A + S.aoff(nxt, tstepA) : cA; const char* nB = has_next ? (const char*)g.Bt + (size_t)nxt.pn * tstepB + S.boff(nxt) : cB;
        if constexpr (Sched::GATHER) {
            if (has_next) {
#pragma unroll
                for (int h = 0; h < 2; ++h)
#pragma unroll
                    for (int i = 0; i < 2; ++i) vN[h][i] = (unsigned)rtl[(ui + 1) * 256 + Rg[i] + 128 * h] * g.lda_b + (unsigned)Cg[i] * 2u;
            }
        }
#pragma unroll 1
        for (int t = 0; t < nt; t += 2) {
            const bool last = (t == nt - 2);
            const size_t k1 = (size_t)(t + 1) * kstepA, k2 = last ? (size_t)0 : (size_t)(t + 2) * kstepA, k3 = k2 + kstepA;
            const char* b2 = last ? nB : cB + (size_t)(t + 2) * kstepB; const char* b3 = b2 + kstepB;
            PG8_LDB(B0, 0, 0); PG8_LDB(B1, 0, 1); PG8_SCHED; PG8_LDA(At, 0, 0); PG8_STAGE_A(PG8_SA(1, 1), k1, 1, false);
            PG8_WAIT_V(8); PG8_WAIT_L(0); PG8_BAR; PG8_MMA(0, 0, At, B0); PG8_MMA(0, 1, At, B1); PG8_BAR; PG8_SCHED;
            PG8_LDA(At, 0, 1); PG8_STAGE(PG8_SB(0, 0), b2, voffB); PG8_STAGE(PG8_SB(0, 1), b2 + hstepB, voffB); PG8_STAGE_A(PG8_SA(0, 0), k2, 0, last);
            PG8_WAIT_V(8); PG8_WAIT_L(0); PG8_BAR; PG8_MMA(1, 0, At, B0); PG8_MMA(1, 1, At, B1); PG8_BAR; PG8_SCHED;
            PG8_LDB(B0, 1, 0); PG8_LDB(B1, 1, 1); PG8_SCHED; PG8_LDA(At, 1, 0); PG8_STAGE_A(PG8_SA(0, 1), k2, 1, last);
            PG8_WAIT_V(8); PG8_WAIT_L(0); PG8_BAR; PG8_MMA(0, 0, At, B0); PG8_MMA(0, 1, At, B1); PG8_BAR; PG8_SCHED;
            PG8_LDA(At, 1, 1); PG8_STAGE(PG8_SB(1, 0), b3, voffB); PG8_STAGE(PG8_SB(1, 1), b3 + hstepB, voffB); PG8_STAGE_A(PG8_SA(1, 0), k3, 0, last);
            PG8_WAIT_V(8); PG8_WAIT_L(0); PG8_BAR; PG8_MMA(1, 0, At, B0); PG8_MMA(1, 1, At, B1); PG8_BAR; PG8_SCHED;
        }
        if (wr == 0) PG8_BAR;
        E(acc, cur, wr, wc, fr, fq);
        if constexpr (Sched::SIGNAL) {
            asm volatile("s_waitcnt vmcnt(0)" ::: "memory"); PG8_BAR;
            if (tid == 0) (void)__hip_atomic_fetch_add(S.ready + cur.pm, 1u, __ATOMIC_RELAXED, __HIP_MEMORY_SCOPE_AGENT);
        }
        if (!has_next) break;
#pragma unroll
        for (int a = 0; a < 2; ++a)
#pragma unroll
            for (int b = 0; b < 2; ++b)
#pragma unroll
                for (int m = 0; m < 4; ++m)
#pragma unroll
                    for (int n = 0; n < 2; ++n) acc[a][b][m][n] = (f32x4){0.f, 0.f, 0.f, 0.f};
        cur = nxt; cA = nA; cB = nB; ++ui;
        if constexpr (Sched::GATHER) {
#pragma unroll
            for (int h = 0; h < 2; ++h)
#pragma unroll
                for (int i = 0; i < 2; ++i) vC[h][i] = vN[h][i];
        }
        if (wr == 1) PG8_BAR;
    }
    PG8_WAIT_V(0);
    PG8_BAR;
#undef PG8_SA
#undef PG8_SB
#undef PG8_STAGE
#undef PG8_STAGE_A
#undef PG8_LDA
#undef PG8_LDB
#undef PG8_MMA
#undef PG8_WAIT_V
#undef PG8_WAIT_L
#undef PG8_BAR
#undef PG8_SCHED
}
}

typedef f32x4 AccT[2][2][4][2];
struct EpiProj {
    bf16_t* P; const float* rope; int rope_tiles; unsigned qmask; float* kmsum; int km_tile0;
    __device__ __forceinline__ void operator()(const AccT& acc, const pg8::Unit& u, int wr, int wc, int fr, int fq) const {
        const int row0 = u.pm * 256 + wr * 64 + fr, col0 = u.pn * 256 + wc * 32 + 8 * fq;
        const bool do_rope = (u.pn < rope_tiles) && ((wc & 1) == 0);
        const float sc = ((qmask >> u.pn) & 1u) ? C2 : 1.f;
        const bool do_km = (kmsum != nullptr) && ((u.pn == km_tile0) || (u.pn == km_tile0 + 1));
#pragma unroll
        for (int bj = 0; bj < 2; ++bj) {
            f32x4 ks0 = {0.f, 0.f, 0.f, 0.f}, ks1 = ks0;
#pragma unroll
            for (int ai = 0; ai < 2; ++ai)
#pragma unroll
                for (int m = 0; m < 4; ++m) {
                    const int row = row0 + ai * 128 + m * 16, pos = row & (SEQ - 1);
                    f32x4 v0 = acc[ai][bj][m][0], v1 = acc[ai][bj][m][1];
                    if (do_rope) {
                        const f32x4 c0 = *(const f32x4*)(rope + pos * 8), c1 = *(const f32x4*)(rope + pos * 8 + 4), s0 = *(const f32x4*)(rope + SEQ * 8 + pos * 8), s1 = *(const f32x4*)(rope + SEQ * 8 + pos * 8 + 4);
                        f32x4 p0, p1;
#pragma unroll
                        for (int e = 0; e < 4; ++e) { p0[e] = __shfl_xor(v0[e], 16); p1[e] = __shfl_xor(v1[e], 16); }
                        const f32x4 a0 = v0 * c0 - p0 * s0, a1 = v1 * c1 - p1 * s1, b0 = v0 * c0 + p0 * s0, b1 = v1 * c1 + p1 * s1;
                        v0 = fq == 0 ? a0 : (fq == 1 ? b0 : v0); v1 = fq == 0 ? a1 : (fq == 1 ? b1 : v1);
                    }
                    ks0 = ks0 + v0; ks1 = ks1 + v1;
                    v0 = v0 * sc; v1 = v1 * sc;
                    u32x4 w; w.x = cvt_pk_bf16(v0[0], v0[1]); w.y = cvt_pk_bf16(v0[2], v0[3]); w.z = cvt_pk_bf16(v1[0], v1[1]); w.w = cvt_pk_bf16(v1[2], v1[3]);
                    *(u32x4*)(P + (size_t)row * PW + col0 + bj * 128) = w;
                }
            if (do_km) {
                const int b = u.pm >> 4, blk = u.pm & 15;
#pragma unroll
                for (int n = 0; n < 2; ++n)
#pragma unroll
                    for (int e = 0; e < 4; ++e) {
                        float t = n == 0 ? ks0[e] : ks1[e];
                        t += __shfl_xor(t, 1); t += __shfl_xor(t, 2); t += __shfl_xor(t, 4); t += __shfl_xor(t, 8);
                        if (fr == 0) { const int c = (u.pn - km_tile0) * 256 + bj * 128 + wc * 32 + 8 * fq + 4 * n + e;
                            atomicAdd(kmsum + ((size_t)(b * 8 + (c >> 6)) * 16 + blk) * 64 + (c & 63), t); }
                    }
            }
        }
    }
};
struct EpiBf16 {
    bf16_t* O; int ldc; int pnmask;
    __device__ __forceinline__ void operator()(const AccT& acc, const pg8::Unit& u, int wr, int wc, int fr, int fq) const {
        const int row0 = u.pm * 256 + wr * 64 + fr, col0 = (u.pn & pnmask) * 256 + wc * 32 + 8 * fq;
#pragma unroll
        for (int ai = 0; ai < 2; ++ai)
#pragma unroll
            for (int m = 0; m < 4; ++m) {
                bf16_t* rowp = O + (size_t)(row0 + ai * 128 + m * 16) * ldc + col0;
#pragma unroll
                for (int bj = 0; bj < 2; ++bj) { const f32x4 v0 = acc[ai][bj][m][0], v1 = acc[ai][bj][m][1];
                    u32x4 w; w.x = cvt_pk_bf16(v0[0], v0[1]); w.y = cvt_pk_bf16(v0[2], v0[3]); w.z = cvt_pk_bf16(v1[0], v1[1]); w.w = cvt_pk_bf16(v1[2], v1[3]);
                    *(u32x4*)(rowp + bj * 128) = w; }
            }
    }
};
struct EpiResid {
    const float* x0; bf16_t* X; const float* g;
    __device__ __forceinline__ void operator()(const AccT& acc, const pg8::Unit& u, int wr, int wc, int fr, int fq) const {
        const int row0 = u.pm * 256 + wr * 64 + fr, col0 = u.pn * 256 + wc * 32 + 8 * fq;
        const float* gb = g + (u.pm / 16) * 6144;
#pragma unroll
        for (int bj = 0; bj < 2; ++bj) {
            const f32x4 g0 = *(const f32x4*)(gb + col0 + bj * 128), g1 = *(const f32x4*)(gb + col0 + bj * 128 + 4);
#pragma unroll
            for (int ai = 0; ai < 2; ++ai)
#pragma unroll
                for (int m = 0; m < 4; ++m) {
                    const size_t off = (size_t)(row0 + ai * 128 + m * 16) * DM + col0 + bj * 128;
                    f32x4 x0v, x1v;
                    if (x0 != nullptr) { x0v = *(const f32x4*)(x0 + off); x1v = *(const f32x4*)(x0 + off + 4); }
                    else { const u32x4 xr = *(const u32x4*)(X + off);
                        x0v[0] = __uint_as_float(xr.x << 16); x0v[1] = __uint_as_float(xr.x & 0xffff0000u); x0v[2] = __uint_as_float(xr.y << 16); x0v[3] = __uint_as_float(xr.y & 0xffff0000u);
                        x1v[0] = __uint_as_float(xr.z << 16); x1v[1] = __uint_as_float(xr.z & 0xffff0000u); x1v[2] = __uint_as_float(xr.w << 16); x1v[3] = __uint_as_float(xr.w & 0xffff0000u); }
                    const f32x4 y0 = x0v + g0 * acc[ai][bj][m][0], y1 = x1v + g1 * acc[ai][bj][m][1];
                    u32x4 w; w.x = cvt_pk_bf16(y0[0], y0[1]); w.y = cvt_pk_bf16(y0[2], y0[3]); w.z = cvt_pk_bf16(y1[0], y1[1]); w.w = cvt_pk_bf16(y1[2], y1[3]);
                    asm volatile("global_store_dwordx4 %0, %1, off sc0 sc1\n\ts_nop 1" :: "v"(X + off), "v"(w) : "memory");
                }
        }
    }
};

struct CmpOrder {
    static constexpr bool GATHER = false, SIGNAL = false;
    int G, c;
    __device__ bool next(int i, pg8::Unit& u) const { const int L = i * G + c; if (c < 0 || L >= 64) return false; u.pm = L; u.pn = (L & 31) >> 4; return true; }
    __device__ size_t aoff(const pg8::Unit& u, size_t tstepA) const { const int ks = u.pm >> 5, br = (u.pm >> 4) & 1, g = (u.pm >> 2) & 3, rt = u.pm & 3; return (size_t)rt * tstepA + (size_t)(((br ? 1792 : 1024) + g * 64) * 2) + (size_t)ks * 16 * PW * 2; }
    __device__ size_t boff(const pg8::Unit& u) const { return (size_t)(u.pm >> 5) * 1024 * 2; }
};
__device__ __forceinline__ float gelu_tanh_fast(float x) {
    const float y = 0.7978845608028654f * (x + 0.044715f * x * x * x);
    const float t = 1.f - 2.f * __builtin_amdgcn_rcpf(1.f + __expf(2.f * y));
    return 0.5f * x * (1.f + t);
}
struct EpiCmp1 {
    float* CHP;
    __device__ __forceinline__ void operator()(const AccT& acc, const pg8::Unit& u, int wr, int wc, int fr, int fq) const {
        const int ks = u.pm >> 5, br = (u.pm >> 4) & 1, g = (u.pm >> 2) & 3, rt = u.pm & 3;
        const int row0 = rt * 256 + wr * 64 + fr, col0 = wc * 32 + 8 * fq;
        float* base = CHP + ((size_t)ks * 8192 + (size_t)(br * 4 + g) * 1024) * 256;
#pragma unroll
        for (int bj = 0; bj < 2; ++bj)
#pragma unroll
            for (int ai = 0; ai < 2; ++ai)
#pragma unroll
                for (int m = 0; m < 4; ++m) {
                    float* dst = base + (size_t)(row0 + ai * 128 + m * 16) * 256 + col0 + bj * 128;
                    *(f32x4*)dst = acc[ai][bj][m][0]; *(f32x4*)(dst + 4) = acc[ai][bj][m][1];
                }
    }
};
__device__ __forceinline__ void ph_inproj(const Params& p, LAS unsigned char* lds, int l, int bx, int G, int stage) {
    const bf16_t* H = (const bf16_t*)(p.ws + WS_H);
    const bf16_t* win = (const bf16_t*)(p.ws + WS_WIN) + (size_t)l * 3072 * 1024;
    const bool even = (l & 1) == 0;
    const bool split = (G >= 224);
    const bool hwait = (G == 256) && (stage != 2);
    if (stage != 2) {
        pg8::Gemm g{H, win, 1024, 2048u, 128u, 1024}; pg8::StaticOrder S; S.init(NT, PW, G, bx);
        if (hwait) { if (otid() == 0) { unsigned* cw = (unsigned*)(p.ws + WS_CTL); pg8::Unit u; for (int i = 0; S.next(i, u); ++i) XB_SPIN(xb_ld(&cw[CW_RDH + l * 64 + u.pm]) < 4u, cw + CW_BAR);
                __builtin_amdgcn_fence(__ATOMIC_ACQUIRE, "agent"); asm volatile("s_waitcnt vmcnt(0)" ::: "memory"); } __syncthreads(); }
        EpiProj E{(bf16_t*)(p.ws + WS_P), (const float*)(p.ws + WS_ROPE), even ? 8 : 7, even ? 0x33u : 0x0Fu, even ? (float*)(p.ws + WS_KMEAN) : nullptr, 2};
        pg8::gemm_phase<EpiProj, pg8::StaticOrder>(lds, g, S, E);
    }
    const bool doV = (stage == 0) || (stage == 2 && (!split || bx < 192));
    if (doV) {
        pg8::Gemm g{win + (size_t)2048 * 1024, H, 1024, 2048u, 128u, 1024}; pg8::StaticOrder S; S.init(even ? 1024 : 768, NT, (stage == 2 && split) ? 192 : G, bx);
        if (hwait) { if (otid() == 0) { unsigned* cw = (unsigned*)(p.ws + WS_CTL); pg8::Unit u; for (int i = 0; S.next(i, u); ++i) XB_SPIN(xb_ld(&cw[CW_RDH + l * 64 + u.pn]) < 4u, cw + CW_BAR);
                __builtin_amdgcn_fence(__ATOMIC_ACQUIRE, "agent"); asm volatile("s_waitcnt vmcnt(0)" ::: "memory"); } __syncthreads(); }
        EpiBf16 E{(bf16_t*)(p.ws + WS_VT), NT, 0x7fffffff};
        pg8::gemm_phase<EpiBf16, pg8::StaticOrder>(lds, g, S, E);
    }
    if (stage == 2 && (!split || bx >= 192)) {
        const int li = l >> 1;
        pg8::Gemm g{(const bf16_t*)(p.ws + WS_P), (const bf16_t*)(p.ws + WS_W1T) + (size_t)li * 2 * 256 * 2048, 1024, 16u * PW * 2u, PW * 2u, 2048};
        CmpOrder S{split ? 64 : G, split ? bx - 192 : bx};
        EpiCmp1 E{(float*)(p.ws + WS_DT)};
        pg8::gemm_phase<EpiCmp1, CmpOrder>(lds, g, S, E);
    }
}
__device__ __forceinline__ void ph_outproj(const Params& p, LAS unsigned char* lds, int l, int bx, int G) {
    const bf16_t* O = (const bf16_t*)(p.ws + WS_O);
    const bf16_t* wout = (const bf16_t*)(p.ws + WS_WOUT) + (size_t)l * 1024 * 1024;
    bf16_t* X = (bf16_t*)(p.ws + WS_X);
    pg8::Gemm g{O, wout, 1024, 2048u, 128u, 1024}; pg8::StaticOrderT<true> S; S.init(NT, DM, G, bx); S.ready = (unsigned*)(p.ws + WS_CTL) + CW_RDX + l * 64;
    EpiResid E{l == 0 ? p.in[0] : (const float*)nullptr, X, (const float*)(p.ws + WS_MOD) + (size_t)l * 4 * 6144 + 2 * 1024};
    pg8::gemm_phase<EpiResid, pg8::StaticOrderT<true>>(lds, g, S, E);
}


typedef float f32x2_t __attribute__((ext_vector_type(2))); typedef __bf16 bf16x2_t __attribute__((ext_vector_type(2)));
__device__ __forceinline__ unsigned cvtpk_s(float lo, float hi) { f32x2_t v = {lo, hi}; bf16x2_t b = __builtin_convertvector(v, bf16x2_t); return __builtin_bit_cast(unsigned, b); }
#define MFMA32(a, b, c) __builtin_amdgcn_mfma_f32_32x32x16_bf16((a), (b), (c), 0, 0, 0)
constexpr int AT_KB = 64 * 144, AT_VB = 128 * 144;
constexpr int AT_KOFF = 0, AT_VOFF = 2 * AT_KB;
constexpr int AT_MASK = AT_VOFF + 3 * AT_VB;
constexpr int AT_RED = AT_MASK + 2048;
constexpr int AT_KM = AT_RED + 1024;
constexpr int AT_K2OFF = 81920;
constexpr int AT_IMP = 0;
static_assert(AT_IMP + 4 * 64 * 65 * 4 <= AT_MASK && AT_KM + 4096 <= 131072, "attention LDS map");

template <int DVB>
__device__ __forceinline__ bool attn_part1(LAS unsigned char* lds, int j, int kbuf, u64 mymask, int klim, int kmin, int r, int hi,
                                           const bf16x8 (&qf)[4], f32x16 (&o)[DVB], float& l, float& m_run, bool& fresh, f32x16& negm, bf16x8 (&pbo)[2][2], int kring = AT_KOFF) {
    bool done = false;
        {
            const int k0 = j * 64;
            const bool bit = ((mymask >> j) & 1ull) != 0ull;
            const bool any = bit && (k0 <= klim) && (k0 + 63 >= kmin);
            if (__ballot(any) != 0ull) {
                const bool rfull = (k0 + 63 <= klim) && (k0 >= kmin);
                const bool range_full = (__ballot(rfull) == ~0ull);
                const LAS unsigned char* kb = lds + kring + kbuf * AT_KB + r * 144 + hi * 16;
                f32x16 p0, p1;
                {
                    const bf16x8 ka = *(const LAS bf16x8*)(kb), kb2 = *(const LAS bf16x8*)(kb + 32 * 144);
                    p0 = MFMA32(ka, qf[0], negm); p1 = MFMA32(kb2, qf[0], negm);
                }
#pragma unroll
                for (int ks = 1; ks < 4; ++ks) {
                    const bf16x8 ka = *(const LAS bf16x8*)(kb + ks * 32), kb2 = *(const LAS bf16x8*)(kb + 32 * 144 + ks * 32);
                    p0 = MFMA32(ka, qf[ks], p0); p1 = MFMA32(kb2, qf[ks], p1);
                }
                if (!range_full) {
#pragma unroll
                    for (int i = 0; i < 16; ++i) { const int key = k0 + (i & 3) + 8 * (i >> 2) + 4 * hi;
                        const bool ok0 = (key <= klim) && (key >= kmin), ok1 = (key + 32 <= klim) && (key + 32 >= kmin);
                        p0[i] = ok0 ? p0[i] : NEGBIG; p1[i] = ok1 ? p1[i] : NEGBIG; }
                }
                float mx;
                {
                    float t[11];
#pragma unroll
                    for (int i = 0; i < 5; ++i) { t[2 * i] = fmaxf(fmaxf(p0[3 * i], p0[3 * i + 1]), p0[3 * i + 2]); t[2 * i + 1] = fmaxf(fmaxf(p1[3 * i], p1[3 * i + 1]), p1[3 * i + 2]); }
                    t[10] = fmaxf(fmaxf(p0[15], p1[15]), t[0]);
                    const float u0 = fmaxf(fmaxf(t[1], t[2]), t[3]), u1 = fmaxf(fmaxf(t[4], t[5]), t[6]), u2 = fmaxf(fmaxf(t[7], t[8]), t[9]);
                    mx = fmaxf(fmaxf(u0, u1), fmaxf(u2, t[10]));
                }
                { const auto sw = __builtin_amdgcn_permlane32_swap(__float_as_uint(mx), __float_as_uint(mx), false, false); mx = fmaxf(__uint_as_float(sw[0]), __uint_as_float(sw[1])); }
                const bool valid = bit && (mx > -1e29f);
                float d = 0.f;
                if (valid && (fresh || mx > 8.f)) d = mx;
                if (__ballot(d != 0.f) != 0ull) {
                    const float alpha = fresh ? 1.f : __builtin_amdgcn_exp2f(-d);
                    l *= alpha; m_run += d;
#pragma unroll
                    for (int dd = 0; dd < DVB; ++dd) o[dd] = o[dd] * alpha;
#pragma unroll
                    for (int i = 0; i < 16; ++i) { negm[i] = -m_run; p0[i] -= d; p1[i] -= d; }
                }
                fresh = fresh && !valid;
                float ls;
                {
#pragma unroll
                    for (int i = 0; i < 16; ++i) { p0[i] = __builtin_amdgcn_exp2f(p0[i]); p1[i] = __builtin_amdgcn_exp2f(p1[i]); }
                    float s8[8];
#pragma unroll
                    for (int i = 0; i < 8; ++i) s8[i] = (p0[i] + p0[i + 8]) + (p1[i] + p1[i + 8]);
                    ls = ((s8[0] + s8[1]) + (s8[2] + s8[3])) + ((s8[4] + s8[5]) + (s8[6] + s8[7]));
                }
                l += valid ? ls : 0.f;
                                u32x4 wq[2][2];
#pragma unroll
                for (int s2 = 0; s2 < 2; ++s2) {
                    wq[0][s2].x = cvtpk_s(p0[8 * s2 + 0], p0[8 * s2 + 1]); wq[0][s2].y = cvtpk_s(p0[8 * s2 + 2], p0[8 * s2 + 3]); wq[0][s2].z = cvtpk_s(p0[8 * s2 + 4], p0[8 * s2 + 5]); wq[0][s2].w = cvtpk_s(p0[8 * s2 + 6], p0[8 * s2 + 7]);
                    wq[1][s2].x = cvtpk_s(p1[8 * s2 + 0], p1[8 * s2 + 1]); wq[1][s2].y = cvtpk_s(p1[8 * s2 + 2], p1[8 * s2 + 3]); wq[1][s2].z = cvtpk_s(p1[8 * s2 + 4], p1[8 * s2 + 5]); wq[1][s2].w = cvtpk_s(p1[8 * s2 + 6], p1[8 * s2 + 7]);
                }
                if (__ballot(!valid) != 0ull) {
                    const unsigned vm = valid ? 0xffffffffu : 0u;
#pragma unroll
                    for (int a2 = 0; a2 < 2; ++a2)
#pragma unroll
                        for (int s2 = 0; s2 < 2; ++s2) { wq[a2][s2].x &= vm; wq[a2][s2].y &= vm; wq[a2][s2].z &= vm; wq[a2][s2].w &= vm; }
                }
#pragma unroll
                for (int s2 = 0; s2 < 2; ++s2) { pbo[0][s2] = __builtin_bit_cast(bf16x8, wq[0][s2]); pbo[1][s2] = __builtin_bit_cast(bf16x8, wq[1][s2]); }
                done = true;
            }
        }
    return done;
}
template <int DVB>
__device__ __forceinline__ void attn_part2(LAS unsigned char* lds, int vbuf, int r, int hi, const bf16x8 (&pb)[2][2], f32x16 (&o)[DVB]) {
    const LAS unsigned char* vb = lds + AT_VOFF + vbuf * AT_VB + r * 144 + hi * 16;
#pragma unroll
    for (int dd = 0; dd < DVB; ++dd)
#pragma unroll
        for (int kg = 0; kg < 2; ++kg)
#pragma unroll
            for (int s2 = 0; s2 < 2; ++s2) {
                const bf16x8 va = *(const LAS bf16x8*)(vb + dd * 32 * 144 + (kg * 32 + s2 * 16) * 2);
                o[dd] = MFMA32(va, pb[kg][s2], o[dd]);
            }
}
#ifndef TSEL
#define TSEL 0
#endif
constexpr int LDS_TACC = 147264;
#define TSTART(k) unsigned long long t_s_ = 0; if (TSEL == (k)) t_s_ = __builtin_amdgcn_s_memrealtime();
#define TSTOP(k) if (TSEL == (k)) { const unsigned long long t_e_ = __builtin_amdgcn_s_memrealtime(); if (otid() == 0) *(LAS unsigned*)(lds + LDS_TACC) += (unsigned)(t_e_ - t_s_); }
template <int DVB>
__device__ __forceinline__ void attn_stage_load(const bf16_t* __restrict__ Kg, int kpitch, const bf16_t* __restrict__ Vg, int vpitch, int jl, int lrow, int lch, u32x4& kreg, u32x4 (&vreg)[DVB / 2]) {
    kreg = *(const u32x4*)(Kg + (size_t)(jl * 64 + lrow) * kpitch + lch * 8);
#pragma unroll
    for (int i = 0; i < DVB / 2; ++i) vreg[i] = *(const u32x4*)(Vg + (size_t)(lrow + 64 * i) * vpitch + jl * 64 + lch * 8);
}
template <int DVB>
__device__ __forceinline__ void attn_stage_write(LAS unsigned char* lds, int nkb, int nvb, int lrow, int lch, const u32x4& kreg, const u32x4 (&vreg)[DVB / 2]) {
    *(LAS u32x4*)(lds + AT_KOFF + nkb * AT_KB + lrow * 144 + lch * 16) = kreg;
#pragma unroll
    for (int i = 0; i < DVB / 2; ++i) { LAS unsigned char* vp = lds + AT_VOFF + nvb * AT_VB + (lrow + 64 * i) * 144 + (lch >> 1) * 32 + (lch & 1) * 8;
        *(LAS u32x2*)vp = (u32x2){vreg[i].x, vreg[i].y}; *(LAS u32x2*)(vp + 16) = (u32x2){vreg[i].z, vreg[i].w}; }
}
template <int DVB, bool DUAL = false>
__device__ __forceinline__ void attn_run(LAS unsigned char* lds, const bf16_t* __restrict__ Kg, int kpitch, const bf16_t* __restrict__ Vg, int vpitch,
                                         u64 tmask, u64 mymask, int klim, int kmin, const bf16x8 (&qf)[4], f32x16 (&o)[DVB], float& m, float& l) {
    const int tid = otid(), lane = tid & 63, r = lane & 31, hi = lane >> 5;
    const int lrow = tid >> 3, lch = tid & 7;
    const bool grpB = __builtin_amdgcn_readfirstlane(tid >> 8) != 0;
    if (tmask == 0ull) return;
    float m_run = 0.f; bool fresh = true; f32x16 negm;
#pragma unroll
    for (int i = 0; i < 16; ++i) negm[i] = 0.f;
    (void)m;
    int j = __builtin_ctzll(tmask); tmask &= tmask - 1ull;
    int jn = -1; if (tmask != 0ull) { jn = __builtin_ctzll(tmask); tmask &= tmask - 1ull; }
    u32x4 kA, vA[DVB / 2], kA2;
    const int kring = (DUAL && grpB) ? AT_K2OFF : AT_KOFF;
    attn_stage_load<DVB>(Kg, kpitch, Vg, vpitch, j, lrow, lch, kA, vA);
    if (DUAL) kA2 = *(const u32x4*)(Kg + (size_t)(j * 64 + lrow) * kpitch + 64 + lch * 8);
    attn_stage_write<DVB>(lds, 0, 0, lrow, lch, kA, vA);
    if (DUAL) *(LAS u32x4*)(lds + AT_K2OFF + lrow * 144 + lch * 16) = kA2;
    __syncthreads();
    int kb = 0, vbc = 0, vbp = 0;
    bool havep = false; bf16x8 pbp[2][2];
#pragma unroll
    for (int a2 = 0; a2 < 2; ++a2)
#pragma unroll
        for (int b2 = 0; b2 < 2; ++b2) pbp[a2][b2] = (bf16x8){0, 0, 0, 0, 0, 0, 0, 0};
    for (;;) {
        { TSTART(1) attn_stage_load<DVB>(Kg, kpitch, Vg, vpitch, jn >= 0 ? jn : j, lrow, lch, kA, vA);
          if (DUAL) kA2 = *(const u32x4*)(Kg + (size_t)((jn >= 0 ? jn : j) * 64 + lrow) * kpitch + 64 + lch * 8); TSTOP(1) }
        { TSTART(2)
        if (grpB && havep) attn_part2<DVB>(lds, vbp, r, hi, pbp, o);
        havep = attn_part1<DVB>(lds, j, kb, mymask, klim, kmin, r, hi, qf, o, l, m_run, fresh, negm, pbp, kring);
        vbp = vbc;
        if (!grpB && havep) attn_part2<DVB>(lds, vbc, r, hi, pbp, o);
        TSTOP(2) }
        const int vbn = (vbc == 2) ? 0 : vbc + 1;
        { TSTART(3) if (jn >= 0) { attn_stage_write<DVB>(lds, kb ^ 1, vbn, lrow, lch, kA, vA); if (DUAL) *(LAS u32x4*)(lds + AT_K2OFF + (kb ^ 1) * AT_KB + lrow * 144 + lch * 16) = kA2; } TSTOP(3) }
        { TSTART(4) __syncthreads(); TSTOP(4) }
        if (jn < 0) break;
        j = jn; kb ^= 1; vbc = vbn;
        jn = -1; if (tmask != 0ull) { jn = __builtin_ctzll(tmask); tmask &= tmask - 1ull; }
    }
    if (grpB && havep) attn_part2<DVB>(lds, vbp, r, hi, pbp, o);
    __syncthreads();
}
__device__ __forceinline__ u64 tile_range_mask(int lo, int hi) {
    const u64 up = (hi >= 63) ? ~0ull : ((1ull << (hi + 1)) - 1ull);
    return up & ~((1ull << lo) - 1ull);
}

__device__ __forceinline__ void ph_moba_kmean(const Params& p, LAS unsigned char* lds, int bx, int G) {
    const int tid = otid(), lane = tid & 63, w = tid >> 6;
    const bf16_t* P = (const bf16_t*)(p.ws + WS_P); float* kmean = (float*)(p.ws + WS_KMEAN);
    LAS float* red = (LAS float*)lds;
    for (int it = bx; it < NB * 8 * 16; it += G) {
        const int blk = it & 15, h = (it >> 4) & 7, b = it >> 7;
        const bf16_t* kp = P + (size_t)(b * SEQ + blk * 256 + w * 32) * PW + 512 + h * 64 + lane;
        float s = 0.f;
#pragma unroll 32
        for (int i = 0; i < 32; ++i) s += bf2f(kp[(size_t)i * PW]);
        red[w * 64 + lane] = s;
        __syncthreads();
        if (w == 0) { float t = 0.f;
#pragma unroll
            for (int i = 0; i < 8; ++i) t += red[i * 64 + lane];
            kmean[((b * 8 + h) * 16 + blk) * 64 + lane] = t * (1.f / 256.f); }
        __syncthreads();
    }
}
__device__ __forceinline__ void ph_attn_even(const Params& p, LAS unsigned char* lds, int lyr, int bx, int G) {
    const int tid = otid(), lane = tid & 63, w = tid >> 6, r = lane & 31, hi = lane >> 5;
    const bf16_t* P = (const bf16_t*)(p.ws + WS_P); const bf16_t* VT = (const bf16_t*)(p.ws + WS_VT);
    const float* kmean = (const float*)(p.ws + WS_KMEAN);
    bf16_t* O = (bf16_t*)(p.ws + WS_O);
    LAS float* kml = (LAS float*)(lds + AT_KM);
    for (int c = bx; c < 256; c += G) {
        const int bh = c & 31, qtp = c >> 5;
#pragma unroll 1
        for (int uu = 0; uu < 4; ++uu) {
            const int kind = uu >> 1, qt = (uu & 1) ? (15 - qtp) : qtp;
            const int b = bh >> 3, hh = bh & 7;
            const int qpos = qt * 256 + w * 32 + r;
            const size_t tok = (size_t)b * SEQ + qpos;
            if (kind == 0) {
                const bf16_t* qp = P + tok * PW + hh * 64 + hi * 8;
                bf16x8 qf[4];
#pragma unroll
                for (int ks = 0; ks < 4; ++ks) qf[ks] = *(const bf16x8*)(qp + ks * 16);
                __syncthreads();
                for (int i = tid; i < 1024; i += NTHR) kml[i] = kmean[(size_t)(b * 8 + hh) * 1024 + i] * (1.f / 256.f);
                __syncthreads();
                const int own = qt;
                float g0 = NEGBIG, g1 = NEGBIG, g2 = NEGBIG; int i0 = -1, i1 = -1, i2 = -1;
                for (int blk = 0; blk < own; ++blk) {
                    float s = 0.f;
#pragma unroll
                    for (int ks = 0; ks < 4; ++ks)
#pragma unroll
                        for (int e = 0; e < 8; ++e) s += bf2f((bf16_t)qf[ks][e]) * kml[blk * 64 + ks * 16 + hi * 8 + e];
                    s += __shfl_xor(s, 32);
                    if (s > g0) { g2 = g1; i2 = i1; g1 = g0; i1 = i0; g0 = s; i0 = blk; }
                    else if (s > g1) { g2 = g1; i2 = i1; g1 = s; i1 = blk; }
                    else if (s > g2) { g2 = s; i2 = blk; }
                }
                u64 mk = 0xFull << (4 * own);
                if (i0 >= 0) mk |= 0xFull << (4 * i0);
                if (i1 >= 0) mk |= 0xFull << (4 * i1);
                if (i2 >= 0) mk |= 0xFull << (4 * i2);
                f32x16 o[2];
#pragma unroll
                for (int d = 0; d < 2; ++d)
#pragma unroll
                    for (int i = 0; i < 16; ++i) o[d][i] = 0.f;
                float m = NEGBIG, l = 0.f;
                attn_run<2>(lds, P + (size_t)b * SEQ * PW + 512 + hh * 64, PW, VT + (size_t)(hh * 64) * NT + (size_t)b * SEQ, NT,
                            tile_range_mask(0, 4 * qt + 3), mk, qpos, 0, qf, o, m, l);
                l += __shfl_xor(l, 32);
                const float il = l > 0.f ? 1.f / l : 0.f;
                bf16_t* op = O + tok * 1024 + hh * 64 + 4 * hi;
#pragma unroll
                for (int d = 0; d < 2; ++d)
#pragma unroll
                    for (int cc = 0; cc < 4; ++cc) {
                        u32x2 wv; wv.x = cvtpk_s(o[d][4 * cc] * il, o[d][4 * cc + 1] * il); wv.y = cvtpk_s(o[d][4 * cc + 2] * il, o[d][4 * cc + 3] * il);
                        *(u32x2*)(op + 32 * d + 8 * cc) = wv;
                    }
            } else {
                const int bh16 = c & 15, jq = c >> 4, qt2 = (uu & 1) ? (31 - jq) : jq;
                const int b2 = bh16 >> 2, head = bh16 & 3, map = w >> 2;
                const int qpos2 = qt2 * 128 + (w & 3) * 32 + r;
                const size_t tok2 = (size_t)b2 * SEQ + qpos2;
                const bf16_t* qp = P + tok2 * PW + 1024 + (head * 2 + map) * 64 + hi * 8;
                bf16x8 qf[4];
#pragma unroll
                for (int ks = 0; ks < 4; ++ks) qf[ks] = *(const bf16x8*)(qp + ks * 16);
                f32x16 o[4];
#pragma unroll
                for (int d = 0; d < 4; ++d)
#pragma unroll
                    for (int i = 0; i < 16; ++i) o[d][i] = 0.f;
                float m = NEGBIG, l = 0.f;
                attn_run<4, true>(lds, P + (size_t)b2 * SEQ * PW + 1536 + head * 128, PW, VT + (size_t)(512 + head * 128) * NT + (size_t)b2 * SEQ, NT,
                                  tile_range_mask(0, 2 * qt2 + 1), ~0ull, qpos2, 0, qf, o, m, l);
                l += __shfl_xor(l, 32);
                const float il = l > 0.f ? 1.f / l : 0.f;
                LAS float* xb = (LAS float*)lds + (w & 3) * 4096 + r;
                if (map == 1) {
#pragma unroll
                    for (int d = 0; d < 4; ++d)
#pragma unroll
                        for (int i = 0; i < 16; ++i) xb[(32 * d + (i & 3) + 8 * (i >> 2) + 4 * hi) * 32] = o[d][i] * il;
                }
                __syncthreads();
                if (map == 0) {
                    const int li = lyr >> 1;
                    const float lam = ((const float*)(p.ws + WS_MISC))[li], linit = li == 0 ? LINIT0 : LINIT1;
                    float ss = 0.f;
#pragma unroll
                    for (int d = 0; d < 4; ++d)
#pragma unroll
                        for (int i = 0; i < 16; ++i) { const float v = o[d][i] * il - lam * xb[(32 * d + (i & 3) + 8 * (i >> 2) + 4 * hi) * 32]; o[d][i] = v; ss += v * v; }
                    ss += __shfl_xor(ss, 32);
                    const float rs = rsqrtf(ss * (1.f / 128.f) + 1e-6f) * (1.f - linit);
                    const float* subg = p.in[10] + li * 128 + 4 * hi;
                    bf16_t* op = O + tok2 * 1024 + 512 + head * 128 + 4 * hi;
#pragma unroll
                    for (int d = 0; d < 4; ++d)
#pragma unroll
                        for (int cc = 0; cc < 4; ++cc) {
                            const f32x4 sg = *(const f32x4*)(subg + 32 * d + 8 * cc);
                            u32x2 wv; wv.x = cvtpk_s(o[d][4 * cc] * rs * sg[0], o[d][4 * cc + 1] * rs * sg[1]); wv.y = cvtpk_s(o[d][4 * cc + 2] * rs * sg[2], o[d][4 * cc + 3] * rs * sg[3]);
                            *(u32x2*)(op + 32 * d + 8 * cc) = wv;
                        }
                }
                __syncthreads();
            }
        }
    }
}

__device__ __forceinline__ void ph_misc(const Params& p, LAS unsigned char* lds, int bx, int G) {
    const int tid = otid();
    float* misc = (float*)(p.ws + WS_MISC); float* fold = (float*)(p.ws + WS_FOLD);
    if (bx == 0 && tid < 64) {
        for (int i = 0; i < 2; ++i) { const float* lp = p.in[9] + i * 256;
            const float s1 = wave_sum(lp[tid] * lp[64 + tid]), s2 = wave_sum(lp[128 + tid] * lp[192 + tid]);
            if (tid == 0) misc[i] = expf(s1) - expf(s2) + (i == 0 ? LINIT0 : LINIT1); }
    }
    {
        LAS float* red = (LAS float*)lds;
        for (int it = bx; it < 64; it += G) {
            const int lb = it >> 4, f = (it & 15) * 16 + (tid & 15), ch = tid >> 4;
            const float* pos = p.in[13] + (size_t)lb * 2048 + ch * 64; const float* w1 = p.in[14] + (size_t)lb * 2048 * 256 + (size_t)(ch * 64) * 256 + f;
            float s0 = 0.f;
#pragma unroll 16
            for (int i = 0; i < 64; ++i) s0 += pos[i] * w1[(size_t)i * 256];
            red[tid] = s0;
            __syncthreads();
            if (tid < 16) { float t = p.in[15][lb * 256 + f]; for (int k = 0; k < 32; ++k) t += red[k * 16 + tid]; fold[lb * 256 + f] = t; }
            __syncthreads();
        }
    }
}
__device__ __forceinline__ void ph_compress2(const Params& p, LAS unsigned char* lds, int l, int bx, int G) {
    const int tid = otid(), lane = tid & 63, w = tid >> 6, li = l >> 1;
    const float* CHP = (const float*)(p.ws + WS_DT); bf16_t* KCMP = (bf16_t*)(p.ws + WS_KCMP); bf16_t* VCX = (bf16_t*)(p.ws + WS_VCX);
    LAS float* w2s = (LAS float*)lds;
    LAS float* hrow = (LAS float*)(lds + 65536) + w * 256;
    const int ipb = 8192 / G, it0 = bx * ipb, br = it0 >> 12;
    {
        const float* w2 = p.in[16] + (size_t)(li * 2 + br) * 256 * 64;
        for (int i = tid; i < 4096; i += NTHR) ((LAS f32x4*)w2s)[i] = *(const f32x4*)(w2 + i * 4);
    }
    __syncthreads();
    const float bias = p.in[17][(li * 2 + br) * 64 + lane];
    const f32x4 foldv = *(const f32x4*)((const float*)(p.ws + WS_FOLD) + li * 512 + br * 256 + lane * 4);
    for (int k = w; k < ipb; k += NWAVES) {
        const int it = it0 + k, r = it & 1023, g = (it >> 10) & 3, b = r >> 8, n = r & 255;
        const f32x4 pa = *(const f32x4*)(CHP + (size_t)it * 256 + lane * 4), pb = *(const f32x4*)(CHP + ((size_t)8192 + it) * 256 + lane * 4);
        const f32x4 hs = pa + pb + foldv;
        *(LAS f32x4*)(hrow + lane * 4) = (f32x4){gelu_tanh_fast(hs[0]), gelu_tanh_fast(hs[1]), gelu_tanh_fast(hs[2]), gelu_tanh_fast(hs[3])};
        asm volatile("s_waitcnt lgkmcnt(0)" ::: "memory");
        float s0 = 0.f, s1 = 0.f, s2 = 0.f, s3 = 0.f;
#pragma unroll 8
        for (int f = 0; f < 256; f += 4) {
            const f32x4 h4 = *(const LAS f32x4*)(hrow + f);
            s0 += h4[0] * w2s[(f + 0) * 64 + lane]; s1 += h4[1] * w2s[(f + 1) * 64 + lane]; s2 += h4[2] * w2s[(f + 2) * 64 + lane]; s3 += h4[3] * w2s[(f + 3) * 64 + lane];
        }
        float sum = (s0 + s1) + (s2 + s3) + bias;
        if (n == 255) sum = 0.f;
        if (br == 0) KCMP[((size_t)(b * 4 + g) * 256 + n) * 64 + lane] = f2bf(sum);
        else VCX[((size_t)(b * 4 + g) * 128 + lane) * 256 + n] = f2bf(sum);
        asm volatile("s_waitcnt lgkmcnt(0)" ::: "memory");
    }
    int gstride = G * NTHR; asm volatile("" : "+s"(gstride));
    for (int i = bx * NTHR + tid; i < 16 * 64 * 256; i += gstride) {
        const int n = i & 255, j = (i >> 8) & 63, bg = i >> 14;
        const bool ov = (n < 255) && (n >= 4 * j - 1) && (n <= 4 * j + 3);
        VCX[((size_t)bg * 128 + 64 + j) * 256 + n] = ov ? (bf16_t)0x3F80 : (bf16_t)0;
    }
    __syncthreads();
}
__device__ __forceinline__ void ph_attn_odd(const Params& p, LAS unsigned char* lds, int bx, int G) {
    const int tid = otid(), lane = tid & 63, w = tid >> 6, r = lane & 31, hi = lane >> 5;
    const bf16_t* P = (const bf16_t*)(p.ws + WS_P); const bf16_t* VT = (const bf16_t*)(p.ws + WS_VT);
    const bf16_t* KCMP = (const bf16_t*)(p.ws + WS_KCMP); const bf16_t* VCX = (const bf16_t*)(p.ws + WS_VCX);
    bf16_t* O = (bf16_t*)(p.ws + WS_O);
    LAS float* imp = (LAS float*)(lds + AT_IMP);
    LAS u64* mks = (LAS u64*)(lds + AT_MASK);
    LAS u64* red = (LAS u64*)(lds + AT_RED);
    for (int c = bx; c < 256; c += G) {
        const int bg = c & 15, qp = c >> 4, b = bg >> 2, g = bg & 3;
#pragma unroll 1
        for (int uu = 0; uu < 4; ++uu) {
            const int qt = uu == 0 ? qp : (uu == 1 ? 31 - qp : (uu == 2 ? 32 + qp : 63 - qp));
            const int head = 4 * g + (w >> 1), qloc = (w & 1) * 32 + r, qpos = qt * 64 + qloc;
            const size_t tok = (size_t)b * SEQ + qpos;
            const bf16_t* qptr = P + tok * PW + head * 64 + hi * 8;
            bf16x8 qf[4];
#pragma unroll
            for (int ks = 0; ks < 4; ++ks) qf[ks] = *(const bf16x8*)(qptr + ks * 16);
            float gt[3];
#pragma unroll
            for (int j = 0; j < 3; ++j) { const float gl = bf2f(VT[(size_t)(512 + head * 3 + j) * NT + tok]); gt[j] = 1.f / (1.f + __expf(-gl)); }
            f32x16 acc[2];
            {
                f32x16 o4[4];
#pragma unroll
                for (int d = 0; d < 4; ++d)
#pragma unroll
                    for (int i = 0; i < 16; ++i) o4[d][i] = 0.f;
                float m = NEGBIG, l = 0.f;
                const int klim = qpos >= 31 ? ((qpos - 31) >> 4) : -1;
                attn_run<4>(lds, KCMP + (size_t)bg * 256 * 64, 64, VCX + (size_t)bg * 128 * 256, 256, tile_range_mask(0, (4 * qt + 2) >> 6), ~0ull, klim, 0, qf, o4, m, l);
                l += __shfl_xor(l, 32);
                const float il = l > 0.f ? 1.f / l : 0.f;
#pragma unroll
                for (int d = 0; d < 2; ++d) acc[d] = o4[d] * (gt[0] * il);
                LAS float* ip = imp + ((w >> 1) * 64 + qloc) * 65 + 4 * hi;
#pragma unroll
                for (int d = 0; d < 2; ++d)
#pragma unroll
                    for (int i = 0; i < 16; ++i) ip[32 * d + (i & 3) + 8 * (i >> 2)] = o4[2 + d][i] * il;
            }
            __syncthreads();
            {
                const int q = tid >> 3, pt = tid & 7, own = qt;
                LAS float* iq = imp + q * 65;
                float vj[8];
#pragma unroll
                for (int k = 0; k < 8; ++k) { const int j = pt * 8 + k;
                    float v = (iq[j] + iq[64 * 65 + j]) + (iq[2 * 64 * 65 + j] + iq[3 * 64 * 65 + j]);
                    if (j > own) v = NEGBIG; else if (j == 0 || j == own || j == own - 1) v = 1e6f;
                    vj[k] = v; }
                __syncthreads();
#pragma unroll
                for (int k = 0; k < 8; ++k) iq[pt * 8 + k] = vj[k];
                __syncthreads();
                int cnt[8];
#pragma unroll
                for (int k = 0; k < 8; ++k) cnt[k] = 0;
#pragma unroll 4
                for (int jj = 0; jj < 64; ++jj) { const float u = iq[jj];
#pragma unroll
                    for (int k = 0; k < 8; ++k) cnt[k] += ((u > vj[k]) || (u == vj[k] && jj < pt * 8 + k)) ? 1 : 0; }
                unsigned bits = 0u;
#pragma unroll
                for (int k = 0; k < 8; ++k) bits |= (cnt[k] < 16) ? (1u << k) : 0u;
                unsigned lo = (pt < 4) ? (bits << (8 * pt)) : 0u, hh = (pt >= 4) ? (bits << (8 * (pt - 4))) : 0u;
#pragma unroll
                for (int off = 1; off <= 4; off <<= 1) { lo |= __shfl_xor(lo, off); hh |= __shfl_xor(hh, off); }
                if (pt == 0) mks[q] = ((u64)hh << 32) | lo;
#pragma unroll
                for (int off = 8; off <= 32; off <<= 1) { lo |= __shfl_xor(lo, off); hh |= __shfl_xor(hh, off); }
                if (lane == 0) red[1 + w] = ((u64)hh << 32) | lo;
            }
            __syncthreads();
            if (tid == 0) { u64 t = 0ull; for (int k = 0; k < 8; ++k) t |= red[1 + k]; red[0] = t; }
            __syncthreads();
            const u64 mymask = mks[qloc];
            const u64 tm_sel = red[0] & tile_range_mask(0, qt);
#pragma unroll 1
            for (int br = 0; br < 2; ++br) {
                f32x16 o2[2];
#pragma unroll
                for (int d = 0; d < 2; ++d)
#pragma unroll
                    for (int i = 0; i < 16; ++i) o2[d][i] = 0.f;
                float m = NEGBIG, l = 0.f;
                const bf16_t* Kg = P + (size_t)b * SEQ * PW + (br == 0 ? 1280 : 1536) + g * 64;
                const bf16_t* Vg = VT + (size_t)((br == 0 ? 0 : 256) + g * 64) * NT + (size_t)b * SEQ;
                const u64 tm = br == 0 ? tm_sel : tile_range_mask(qt >= 8 ? qt - 8 : 0, qt);
                attn_run<2>(lds, Kg, PW, Vg, NT, tm, br == 0 ? mymask : ~0ull, qpos, br == 0 ? 0 : qpos - 511, qf, o2, m, l);
                l += __shfl_xor(l, 32);
                const float sc = (l > 0.f ? 1.f / l : 0.f) * (br == 0 ? gt[1] : gt[2]);
#pragma unroll
                for (int d = 0; d < 2; ++d) acc[d] = acc[d] + o2[d] * sc;
            }
            bf16_t* op = O + tok * 1024 + head * 64 + 4 * hi;
#pragma unroll
            for (int d = 0; d < 2; ++d)
#pragma unroll
                for (int cc = 0; cc < 4; ++cc) {
                    u32x2 wv; wv.x = cvtpk_s(acc[d][4 * cc], acc[d][4 * cc + 1]); wv.y = cvtpk_s(acc[d][4 * cc + 2], acc[d][4 * cc + 3]);
                    *(u32x2*)(op + 32 * d + 8 * cc) = wv;
                }
        }
    }
}


__device__ __forceinline__ float red4(const f32x4& a, int lane) {
    const bool h5 = (lane & 32) != 0, h4 = (lane & 16) != 0;
    float k0 = h5 ? a[2] : a[0], k1 = h5 ? a[3] : a[1]; const float s0 = h5 ? a[0] : a[2], s1 = h5 ? a[1] : a[3];
    k0 += __shfl_xor(s0, 32); k1 += __shfl_xor(s1, 32);
    float k = h4 ? k1 : k0; const float s = h4 ? k0 : k1;
    k += __shfl_xor(s, 16);
    k += __shfl_xor(k, 8); k += __shfl_xor(k, 4); k += __shfl_xor(k, 2); k += __shfl_xor(k, 1);
    return k;
}
template <int MODE>
__device__ __forceinline__ void ph_norm(const Params& p, LAS unsigned char* lds, int l, int bx, int G) {
    const int tid = otid(), lane = tid & 63, w = tid >> 6;
    LAS f32x4* rw = (LAS f32x4*)lds;
    LAS int* ent = (LAS int*)(lds + 81920);
    const int TPB = NT / G;
    if (MODE == 1) {
        const float* wg = p.in[18] + (size_t)l * 1024 * 4; const float* we = p.in[20] + (size_t)l * 1024 * 16;
        for (int s = tid; s < 16 * 5 * 64; s += NTHR) {
            const int ln = s & 63, r = s >> 6, q = r % 5, ie = r / 5, idx = (ie >> 2) * 256 + ln * 4 + (ie & 3);
            rw[s] = (q == 0) ? *(const f32x4*)(wg + idx * 4) : *(const f32x4*)(we + idx * 16 + (q - 1) * 4);
        }
        if (tid < 16) ((LAS float*)(lds + 83456))[tid] = p.in[21][l * 16 + tid];
        __syncthreads();
    }
    bf16_t* X = (bf16_t*)(p.ws + WS_X); bf16_t* H = (bf16_t*)(p.ws + WS_H);
    const float* mod = (const float*)(p.ws + WS_MOD);
    const bf16_t* Y = (const bf16_t*)(p.ws + WS_Y); const int* POS = (const int*)(p.ws + WS_POS);
    int* tok_e = (int*)(p.ws + WS_ROUTE); float* tok_w = (float*)(p.ws + WS_ROUTE + 131072); int* tok_rank = (int*)(p.ws + WS_ROUTE + 262144);
    const bool comb = (MODE == 2) || (MODE == 0 && l > 0);
    const int lc = (MODE == 2) ? DEPTH - 1 : l - 1;
    const bool xf32 = (MODE == 0 && l == 0);
    const float* xin = p.in[0];
    const float* gsrc = (MODE == 0) ? p.in[2] + l * DM : (MODE == 1 ? p.in[3] + l * DM : p.in[4]);
    const int scc = (MODE == 0) ? 1 : 4, shc = (MODE == 0) ? 0 : 3;
    const int nit = TPB / NWAVES, tbase = bx * TPB + w * nit, b = (bx * TPB) / SEQ;
    f32x4 gv[4], scv[4], shv[4], g2v[4];
#pragma unroll
    for (int i = 0; i < 4; ++i) {
        const int idx = i * 256 + lane * 4;
        gv[i] = *(const f32x4*)(gsrc + idx);
        if (MODE != 2) { scv[i] = *(const f32x4*)(mod + (size_t)(l * 4 + b) * 6144 + scc * 1024 + idx) + 1.f; shv[i] = *(const f32x4*)(mod + (size_t)(l * 4 + b) * 6144 + shc * 1024 + idx); }
        if (comb) g2v[i] = *(const f32x4*)(mod + (size_t)(lc * 4 + b) * 6144 + 5 * 1024 + idx);
    }
    int posv = 0;
    if (comb) posv = POS[(size_t)tbase * 2 + (lane < nit * 2 ? lane : 0)];
    u32x4 xn[4]; u32x2 yan[4], ybn[4];
    {
        const int p0 = comb ? __builtin_amdgcn_readlane(posv, 0) : 0, p1 = comb ? __builtin_amdgcn_readlane(posv, 1) : 0;
#pragma unroll
        for (int i = 0; i < 4; ++i) { const int idx = i * 256 + lane * 4;
            if (xf32) xn[i] = *(const u32x4*)(xin + (size_t)tbase * DM + idx); else { const u32x2 t2 = *(const u32x2*)(X + (size_t)tbase * DM + idx); xn[i].x = t2.x; xn[i].y = t2.y; }
            if (comb) { yan[i] = *(const u32x2*)(Y + (size_t)p0 * DM + idx); ybn[i] = *(const u32x2*)(Y + (size_t)p1 * DM + idx); } }
    }
    float bgv[4] = {0.f, 0.f, 0.f, 0.f};
    if (MODE == 1) {
#pragma unroll
        for (int j = 0; j < 4; ++j) bgv[j] = p.in[19][l * 4 + j];
    }
    for (int itn = 0; itn < nit; ++itn) {
        const int t = tbase + itn;
        f32x4 xv[4]; u32x2 ya[4], yb[4];
#pragma unroll
        for (int i = 0; i < 4; ++i) {
            if (xf32) { xv[i][0] = __uint_as_float(xn[i].x); xv[i][1] = __uint_as_float(xn[i].y); xv[i][2] = __uint_as_float(xn[i].z); xv[i][3] = __uint_as_float(xn[i].w); }
            else { xv[i][0] = __uint_as_float(xn[i].x << 16); xv[i][1] = __uint_as_float(xn[i].x & 0xffff0000u); xv[i][2] = __uint_as_float(xn[i].y << 16); xv[i][3] = __uint_as_float(xn[i].y & 0xffff0000u); }
            if (comb) { ya[i] = yan[i]; yb[i] = ybn[i]; } }
        {
            const int nx = (itn + 1 < nit) ? itn + 1 : itn;
            const int p0 = comb ? __builtin_amdgcn_readlane(posv, 2 * nx) : 0, p1 = comb ? __builtin_amdgcn_readlane(posv, 2 * nx + 1) : 0;
#pragma unroll
            for (int i = 0; i < 4; ++i) { const int idx = i * 256 + lane * 4;
                if (xf32) xn[i] = *(const u32x4*)(xin + (size_t)(tbase + nx) * DM + idx); else { const u32x2 t2 = *(const u32x2*)(X + (size_t)(tbase + nx) * DM + idx); xn[i].x = t2.x; xn[i].y = t2.y; }
                if (comb) { yan[i] = *(const u32x2*)(Y + (size_t)p0 * DM + idx); ybn[i] = *(const u32x2*)(Y + (size_t)p1 * DM + idx); } }
        }
        float ss = 0.f;
#pragma unroll
        for (int i = 0; i < 4; ++i) {
            const int idx = i * 256 + lane * 4;
            if (comb) {
                f32x4 ys; ys[0] = bf2f((bf16_t)(ya[i].x & 0xffff)) + bf2f((bf16_t)(yb[i].x & 0xffff)); ys[1] = bf2f((bf16_t)(ya[i].x >> 16)) + bf2f((bf16_t)(yb[i].x >> 16));
                ys[2] = bf2f((bf16_t)(ya[i].y & 0xffff)) + bf2f((bf16_t)(yb[i].y & 0xffff)); ys[3] = bf2f((bf16_t)(ya[i].y >> 16)) + bf2f((bf16_t)(yb[i].y >> 16));
                xv[i] = xv[i] + g2v[i] * ys;
                if (MODE == 0) { u32x2 xo; xo.x = cvt_pk_bf16(xv[i][0], xv[i][1]); xo.y = cvt_pk_bf16(xv[i][2], xv[i][3]); *(u32x2*)(X + (size_t)t * DM + idx) = xo; }
            }
            ss += xv[i][0] * xv[i][0] + xv[i][1] * xv[i][1] + xv[i][2] * xv[i][2] + xv[i][3] * xv[i][3];
        }
        ss = wave_sum(ss);
        const float rs = rsqrtf(ss * (1.f / DM) + 1e-6f);
        float hv[4][4];
#pragma unroll
        for (int i = 0; i < 4; ++i) {
            const int idx = i * 256 + lane * 4;
            f32x4 y = xv[i] * rs * gv[i];
            if (MODE == 2) { *(f32x4*)(p.out + (size_t)t * DM + idx) = y; }
            else {
                y = y * scv[i] + shv[i];
                hv[i][0] = y[0]; hv[i][1] = y[1]; hv[i][2] = y[2]; hv[i][3] = y[3];
                u32x2 o; o.x = pk2(y[0], y[1]); o.y = pk2(y[2], y[3]);
                if (MODE == 0) asm volatile("global_store_dwordx2 %0, %1, off sc0 sc1" :: "v"(H + (size_t)t * DM + idx), "v"(o) : "memory");
                else *(u32x2*)(H + (size_t)t * DM + idx) = o;
            }
        }
        if (MODE == 1) {
            f32x4 ag = {0.f, 0.f, 0.f, 0.f};
#pragma unroll
            for (int i = 0; i < 4; ++i)
#pragma unroll
                for (int e = 0; e < 4; ++e) { const f32x4 w4 = rw[((i * 4 + e) * 5) * 64 + lane]; ag = ag + w4 * hv[i][e]; }
            const float rg = red4(ag, lane);
            f32x4 gl4; gl4[0] = __uint_as_float(__builtin_amdgcn_readlane(__float_as_uint(rg), 0)) + bgv[0]; gl4[1] = __uint_as_float(__builtin_amdgcn_readlane(__float_as_uint(rg), 16)) + bgv[1]; gl4[2] = __uint_as_float(__builtin_amdgcn_readlane(__float_as_uint(rg), 32)) + bgv[2]; gl4[3] = __uint_as_float(__builtin_amdgcn_readlane(__float_as_uint(rg), 48)) + bgv[3];
            int gs = 0; { float gm = gl4[0];
#pragma unroll
                for (int j = 1; j < 4; ++j) if (gl4[j] > gm) { gm = gl4[j]; gs = j; } }
            gs = __builtin_amdgcn_readfirstlane(gs);
            f32x4 ae = {0.f, 0.f, 0.f, 0.f};
            const LAS f32x4* rwe = rw + (1 + gs) * 64 + lane;
#pragma unroll
            for (int i = 0; i < 4; ++i)
#pragma unroll
                for (int e = 0; e < 4; ++e) { const f32x4 w4 = rwe[((i * 4 + e) * 5) * 64]; ae = ae + w4 * hv[i][e]; }
            const float re = red4(ae, lane);
            f32x4 el4; el4[0] = __uint_as_float(__builtin_amdgcn_readlane(__float_as_uint(re), 0)); el4[1] = __uint_as_float(__builtin_amdgcn_readlane(__float_as_uint(re), 16)); el4[2] = __uint_as_float(__builtin_amdgcn_readlane(__float_as_uint(re), 32)); el4[3] = __uint_as_float(__builtin_amdgcn_readlane(__float_as_uint(re), 48));
            LAS float* lres = (LAS float*)(lds + 83968) + w * 256 + itn * 32;
            if (lane == 0) { *(LAS f32x4*)lres = gl4; *(LAS f32x4*)(lres + 4) = el4; }
        }
    }
    if (MODE == 0 && G == 256) {
        asm volatile("s_waitcnt vmcnt(0)" ::: "memory"); __syncthreads();
        if (tid == 0) (void)xb_add((unsigned*)(p.ws + WS_CTL) + CW_RDH + l * 64 + (bx >> 2), 1u);
    }
    if (MODE == 1) {
        asm volatile("s_waitcnt lgkmcnt(0)" ::: "memory");
        if (lane < nit) {
            const int t = tbase + lane;
            const LAS float* lr = (const LAS float*)(lds + 83968) + w * 256 + lane * 32;
            float gl[4];
#pragma unroll
            for (int j = 0; j < 4; ++j) gl[j] = lr[j];
            int gs = 0; float gm = gl[0];
#pragma unroll
            for (int j = 1; j < 4; ++j) if (gl[j] > gm) { gm = gl[j]; gs = j; }
            float den = 0.f;
#pragma unroll
            for (int j = 0; j < 4; ++j) den += expf(gl[j] - gm);
            const float gw = 1.f / den;
            float el[4];
            { const LAS float* bl = (const LAS float*)(lds + 83456) + gs * 4;
#pragma unroll
              for (int j = 0; j < 4; ++j) el[j] = lr[4 + j] + bl[j]; }
            int i1 = 0; float v1 = el[0];
#pragma unroll
            for (int j = 1; j < 4; ++j) if (el[j] > v1) { v1 = el[j]; i1 = j; }
            int i2 = -1; float v2 = -3.0e38f;
#pragma unroll
            for (int j = 0; j < 4; ++j) if (j != i1 && el[j] > v2) { v2 = el[j]; i2 = j; }
            const float t1 = 1.f / (1.f + expf(v2 - v1)), t2 = 1.f - t1;
            const int e1 = gs * 4 + i1, e2 = gs * 4 + i2;
            tok_e[t * 2] = e1; tok_e[t * 2 + 1] = e2; tok_w[t * 2] = gw * t1; tok_w[t * 2 + 1] = gw * t2;
            const int lt = t - bx * TPB; ent[lt * 2] = e1; ent[lt * 2 + 1] = e2;
        }
        __syncthreads();
        const int NE = TPB * 2;
        for (int j = tid; j < NE; j += NTHR) { const int e = ent[j]; int rk = 0; for (int k = 0; k < j; ++k) rk += (ent[k] == e) ? 1 : 0; tok_rank[bx * NE + j] = rk; }
        if (tid < 16) { int c = 0; for (int k = 0; k < NE; ++k) c += (ent[k] == tid) ? 1 : 0; ((int*)(p.ws + WS_BCNT))[bx * 16 + tid] = c; }
    }
}
__device__ __forceinline__ void ph_moe_permute(const Params& p, LAS unsigned char* lds, int l, int bx, int G) {
    const int tid = otid(), lane = tid & 63, w = tid >> 6;
    const int* tok_e = (const int*)(p.ws + WS_ROUTE); const float* tok_w = (const float*)(p.ws + WS_ROUTE + 131072); const int* tok_rank = (const int*)(p.ws + WS_ROUTE + 262144);
    int* POS = (int*)(p.ws + WS_POS); float* wperm = (float*)(p.ws + WS_WPERM); int* tilex = (int*)(p.ws + WS_TILEX);
    const int* bcnt = (const int*)(p.ws + WS_BCNT);
    LAS int* part = (LAS int*)lds;
    LAS int* base = (LAS int*)(lds + 4096);
    {
        const int e = tid & 15, pr = tid >> 4; int tot = 0, pre = 0;
        for (int bb = pr; bb < G; bb += 32) { const int c = bcnt[bb * 16 + e]; tot += c; pre += (bb < bx) ? c : 0; }
        part[pr * 16 + e] = tot; part[512 + pr * 16 + e] = pre;
    }
    __syncthreads();
    if (tid == 0) {
        int off = 0;
        for (int e = 0; e < 16; ++e) { int tot = 0, pre = 0; for (int k = 0; k < 32; ++k) { tot += part[k * 16 + e]; pre += part[512 + k * 16 + e]; }
            base[e] = off + pre; base[16 + e] = off; base[48 + e] = off + tot; off += (tot + 255) & ~255; }
        base[32] = off;
    }
    __syncthreads();
    int* rowtok = (int*)(p.ws + WS_ROWTOK);
    if (bx < 16) {
        const int r1 = (bx == 15) ? base[32] : base[16 + bx + 1];
        for (int r = base[48 + bx] + tid; r < r1; r += NTHR) { rowtok[r] = 0; wperm[r] = 0.f; }
    }
    if (bx == 0 && tid < 160) {
        const int total = base[32];
        if (tid == 0) tilex[0] = total >> 8;
        int ex = 0;
        for (int e = 1; e < 16; ++e) ex = (tid * 256 >= base[16 + e]) ? e : ex;
        if (tid * 256 < total) tilex[1 + tid] = ex;
    }
    const int NE = (NT / G) * 2;
    {
        const int it = bx * NE + w + 8 * (lane & 15);
        const int e = tok_e[it], rk = tok_rank[it]; const float tw = tok_w[it];
        const int posl = base[e] + rk;
        if (lane < 16) { POS[it] = posl; wperm[posl] = tw; rowtok[posl] = it >> 1; }
    }
    __syncthreads();
}
template <bool GA>
struct MoeOrderT {
    static constexpr bool GATHER = GA, SIGNAL = GA;
    int G, c, nct; const int* tilex; const int* rowtok;
    int mode, k, m;
    unsigned* ready;
    __device__ bool next(int i, pg8::Unit& u) const {
        const int nt = tilex[0]; int L;
        if (mode == 0) { L = i * G + c; if (L >= nt * nct) return false; }
        else if (mode == 1) { L = k + i * m; if (L >= 512) return false; }
        else { const int q = m - 1 - k; if (i > 0 || q >= 4 * (nt - 128)) return false; L = 512 + q; }
        const int rt = L / nct, ct = L - rt * nct; u.pm = rt; u.pn = tilex[1 + rt] * nct + ct; return true;
    }
    __device__ size_t aoff(const pg8::Unit& u, size_t tstepA) const { return (size_t)u.pm * tstepA; }
    __device__ size_t boff(const pg8::Unit&) const { return 0; }
};
struct EpiMoeH {
    bf16_t* HID; const float* wperm;
    __device__ __forceinline__ void operator()(const AccT& acc, const pg8::Unit& u, int wr, int wc, int fr, int fq) const {
        const int row0 = u.pm * 256 + wr * 64 + fr, f0 = (u.pn & 1) * 128 + wc * 16 + 4 * fq;
#pragma unroll
        for (int ai = 0; ai < 2; ++ai)
#pragma unroll
            for (int m = 0; m < 4; ++m) {
                const int row = row0 + ai * 128 + m * 16; const float wt = wperm[row];
#pragma unroll
                for (int bj = 0; bj < 2; ++bj) {
                    const f32x4 v0 = acc[ai][bj][m][0], v1 = acc[ai][bj][m][1];
                    const float h0 = v0[0] * __builtin_amdgcn_rcpf(1.f + __expf(-v0[0])) * v0[1] * wt, h1 = v0[2] * __builtin_amdgcn_rcpf(1.f + __expf(-v0[2])) * v0[3] * wt;
                    const float h2 = v1[0] * __builtin_amdgcn_rcpf(1.f + __expf(-v1[0])) * v1[1] * wt, h3 = v1[2] * __builtin_amdgcn_rcpf(1.f + __expf(-v1[2])) * v1[3] * wt;
                    u32x2 o; o.x = cvt_pk_bf16(h0, h1); o.y = cvt_pk_bf16(h2, h3);
                    asm volatile("global_store_dwordx2 %0, %1, off sc0 sc1" :: "v"(HID + (size_t)row * 256 + f0 + bj * 64), "v"(o) : "memory");
                }
            }
    }
};
__device__ __forceinline__ void ph_moe_gemm1(const Params& p, LAS unsigned char* lds, int l, int bx, int G) {
    pg8::Gemm g{(const bf16_t*)(p.ws + WS_H), (const bf16_t*)(p.ws + WS_WGU), 1024, 2048u, 128u, 1024};
    MoeOrderT<true> S{G, bx, 2, (const int*)(p.ws + WS_TILEX), (const int*)(p.ws + WS_ROWTOK), 0, 0, 0, (unsigned*)(p.ws + WS_CTL) + CW_RDY + l * 256};
    EpiMoeH E{(bf16_t*)(p.ws + WS_HIDP), (const float*)(p.ws + WS_WPERM)};
    pg8::gemm_phase<EpiMoeH, MoeOrderT<true>>(lds, g, S, E);
}
__device__ __forceinline__ void ph_moe_gemm2(const Params& p, LAS unsigned char* lds, int l, int bx, int G, bool fused) {
    pg8::Gemm g{(const bf16_t*)(p.ws + WS_HIDP), (const bf16_t*)(p.ws + WS_WD), 256, 512u, 128u, 256};
    EpiBf16 E{(bf16_t*)(p.ws + WS_Y), 1024, 3};
    const int* tilex = (const int*)(p.ws + WS_TILEX);
    unsigned* ready = (unsigned*)(p.ws + WS_CTL) + CW_RDY + l * 256;
    int n2 = 2 * tilex[0] - 256; n2 = n2 < 0 ? 0 : n2;
    const int m = 256 - n2, k = bx - n2;
    if (fused && k < 0) return;
#pragma unroll 1
    for (int part = fused ? 1 : 0; part < (fused ? 3 : 1); ++part) {
        MoeOrderT<false> S{G, bx, 4, tilex, (const int*)nullptr, part, k, m, ready};
        pg8::Unit u0;
        if (!S.next(0, u0)) continue;
        if (fused) {
            if (otid() == 0) {
                unsigned* bar = (unsigned*)(p.ws + WS_CTL) + CW_BAR; pg8::Unit u;
                for (int i = 0; S.next(i, u); ++i) XB_SPIN(xb_ld(&ready[u.pm]) < 2u, bar);
                __builtin_amdgcn_fence(__ATOMIC_ACQUIRE, "agent");
                asm volatile("s_waitcnt vmcnt(0)" ::: "memory");
            }
            __syncthreads();
        }
        pg8::gemm_phase<EpiBf16, MoeOrderT<false>>(lds, g, S, E);
    }
}


__device__ __forceinline__ void ph_mod(const Params& p, LAS unsigned char* lds, int bx, int G) {
    const int tid = otid();
    LAS float* cs = (LAS float*)lds;
    LAS float* red = (LAS float*)(lds + 16384);
    float* mod = (float*)(p.ws + WS_MOD);
    for (int i = tid; i < 4096; i += NTHR) { const float v = p.in[1][i]; cs[i] = v / (1.f + expf(-v)); }
    __syncthreads();
    const int col = tid & 127, ch = tid >> 7;
    for (int it = bx; it < 4 * 48; it += G) {
        const int l = it / 48, j = (it % 48) * 128 + col;
        const float* w = p.in[5] + (size_t)l * 1024 * 6144 + (size_t)(ch * 256) * 6144 + j;
        float a0 = 0.f, a1 = 0.f, a2 = 0.f, a3 = 0.f;
#pragma unroll 32
        for (int i = 0; i < 256; ++i) { const float wv = w[(size_t)i * 6144]; const int ii = ch * 256 + i; a0 += cs[ii] * wv; a1 += cs[1024 + ii] * wv; a2 += cs[2048 + ii] * wv; a3 += cs[3072 + ii] * wv; }
        red[(ch * 4 + 0) * 128 + col] = a0; red[(ch * 4 + 1) * 128 + col] = a1; red[(ch * 4 + 2) * 128 + col] = a2; red[(ch * 4 + 3) * 128 + col] = a3;
        __syncthreads();
        {
            const float sum = red[(0 * 4 + ch) * 128 + col] + red[(1 * 4 + ch) * 128 + col] + red[(2 * 4 + ch) * 128 + col] + red[(3 * 4 + ch) * 128 + col];
            mod[(size_t)(l * 4 + ch) * 6144 + j] = sum + p.in[6][l * 6144 + j];
        }
        __syncthreads();
    }
}
__device__ __forceinline__ void ph_rope(const Params& p, int bx, int G) {
    float* tab = (float*)(p.ws + WS_ROPE);
    for (int i = bx * NTHR + otid(); i < SEQ * 8; i += G * NTHR) {
        const int pos = i >> 3, j = i & 7;
        const float inv = (float)pow(500000.0, -(double)j / 8.0);
        const float ang = (float)pos * inv;
        tab[i] = (float)cos((double)ang); tab[SEQ * 8 + i] = (float)sin((double)ang);
    }
}

struct XcdBarrier { unsigned* bar; unsigned x; volatile LAS unsigned* st; };
__device__ __forceinline__ XcdBarrier xcd_barrier_post(unsigned* bar, volatile LAS unsigned* st) {
    XcdBarrier b; b.bar = bar; b.x = xb_xcc_id(); b.st = st;
    if (threadIdx.x == 0) (void)xb_add(&bar[XB_XCNT(b.x)], 1u);
    return b;
}
__device__ __forceinline__ void xcd_barrier_complete(unsigned* bar, unsigned x, unsigned& nloc, unsigned& nx) {
    const unsigned G = gridDim.x * gridDim.y * gridDim.z;
    unsigned sum, cnt, mine, sp = 0u;
    for (;;) {
        sum = 0u; cnt = 0u; mine = 0u;
#pragma unroll
        for (unsigned j = 0; j < 16; ++j) { const unsigned c = xb_ld(&bar[XB_XCNT(j)]); sum += c; cnt += (c > 0u) ? 1u : 0u; mine = (j == x) ? c : mine; }
        if (sum == G) break;
        __builtin_amdgcn_s_sleep(1);
        if ((++sp & 255u) == 0u) { if (xb_ld(&bar[XB_TMO])) break; if (sp > XB_SPIN_CAP) { atomicAdd(&bar[XB_TMO], 1u); break; } }
    }
    nloc = mine > 0u ? mine : 1u; nx = cnt > 0u ? cnt : 1u;
}
__device__ __forceinline__ void xcd_barrier(const XcdBarrier& b) {
    asm volatile("s_waitcnt vmcnt(0)" ::: "memory");
    __syncthreads();
    if (threadIdx.x == 0) {
        unsigned* bar = b.bar;
        __builtin_amdgcn_s_waitcnt(0);
        unsigned nloc = b.st[0], nx = b.st[1];
        if (nloc == 0u) { xcd_barrier_complete(bar, b.x, nloc, nx); b.st[0] = nloc; b.st[1] = nx; }
        const unsigned old = xb_add(&bar[XB_XSUB(b.x)], 1u);
        const unsigned gen = old / nloc;
        if (old + 1u == (gen + 1u) * nloc) {
            __builtin_amdgcn_fence(__ATOMIC_RELEASE, "agent");
            asm volatile("s_waitcnt vmcnt(0)" ::: "memory");
            const unsigned og = xb_add(&bar[XB_TOP], 1u);
            const unsigned tg = og / nx;
            if (og + 1u == (tg + 1u) * nx) xb_add(&bar[XB_TOPGEN], 1u);
            else XB_SPIN(xb_ld(&bar[XB_TOPGEN]) == tg, bar);
            __builtin_amdgcn_fence(__ATOMIC_ACQUIRE, "agent");
            xb_add(&bar[XB_XGEN(b.x)], 1u);
            asm volatile("s_waitcnt vmcnt(0)" ::: "memory");
        } else {
            XB_SPIN(xb_ld(&bar[XB_XGEN(b.x)]) == gen, bar);
            __builtin_amdgcn_fence(__ATOMIC_ACQUIRE, "agent");
            asm volatile("s_waitcnt vmcnt(0)" ::: "memory");
        }
    }
    __syncthreads();
}
constexpr int LDS_XB = 147200;

#ifndef REP_P
#define REP_P 1
#endif
#ifndef REP_T
#define REP_T 1
#endif
#ifndef REP_B
#define REP_B 0
#endif
#ifndef REP_N
#define REP_N 1
#endif
#ifndef REP_O
#define REP_O 1
#endif
#ifndef REP_N1
#define REP_N1 1
#endif
#ifndef REP_AE
#define REP_AE 1
#endif
#ifndef REP_AO
#define REP_AO 1
#endif
#ifndef REP_G
#define REP_G 1
#endif
__global__ void __launch_bounds__(NTHR, 2) mega_fwd(Params p) {
    extern __shared__ __attribute__((aligned(16))) unsigned char lds_raw[];
    LAS unsigned char* lds = (LAS unsigned char*)lds_raw;
    const int bx = blockIdx.x, G = gridDim.x;
    typedef const Params __attribute__((address_space(4)))* CP;
    CP kp = (CP)__builtin_amdgcn_kernarg_segment_ptr();
#define LP() ({ CP q_ = kp; asm volatile("" : "+s"(q_)); Params r_; _Pragma("unroll") for (int i_ = 0; i_ < 25; ++i_) r_.in[i_] = q_->in[i_]; r_.out = q_->out; r_.ws = q_->ws; r_; })
    if (threadIdx.x < 4) ((LAS unsigned*)(lds + LDS_XB))[threadIdx.x] = 0u;
    if (threadIdx.x == 0) *(LAS unsigned*)(lds + LDS_TACC) = 0u;
    __syncthreads();
    const XcdBarrier bar = xcd_barrier_post((unsigned*)(kp->ws + WS_CTL) + CW_BAR, (volatile LAS unsigned*)(lds + LDS_XB));
#define GRID_BAR() do { TSTART(10) XcdBarrier b2_ = bar; asm volatile("" : "+s"(b2_.bar), "+s"(b2_.x)); xcd_barrier(b2_); TSTOP(10) } while (0)
    for (int rep = 0; rep < REP_P; ++rep) {
    { TSTART(15) { const Params pp = LP(); ph_conv_static(pp, lds, bx, G); } TSTOP(15) }
    __syncthreads();
    { TSTART(15) { const Params pp = LP(); ph_mod(pp, lds, bx, G); } TSTOP(15) }
    { TSTART(15) { const Params pp = LP(); ph_rope(pp, bx, G); } TSTOP(15) }
    { TSTART(15) { const Params pp = LP(); ph_misc(pp, lds, bx, G); } TSTOP(15) }
    { const Params pp = LP(); ph_zero_kmsum(pp, bx, G); }
    __syncthreads();
    }
    GRID_BAR();
#pragma unroll 1
    for (int l = 0; l < DEPTH; ++l) {
        { TSTART(11) { const Params pp = LP(); ph_norm<0>(pp, lds, l, bx, G); } TSTOP(11) }
        for (int rep = 0; rep < REP_T; ++rep) { TSTART(16) { const Params pp = LP(); ph_conv_moe(pp, lds, l, bx, G); } TSTOP(16) }
        if ((l & 1) == 1 && l + 1 < DEPTH) { const Params pp = LP(); ph_zero_kmsum(pp, bx, G); }
        if (G != 256) GRID_BAR();
#pragma unroll 1
        for (int si = 0; si < ((l & 1) ? 2 : 1); ++si) {
            { TSTART(13) { const Params pp = LP(); ph_inproj(pp, lds, l, bx, G, (l & 1) ? 1 + si : 0); } TSTOP(13) }
            GRID_BAR();
        }
        if ((l & 1) == 0) {
            for (int rep = 0; rep < REP_AE; ++rep) { TSTART(14) { const Params pp = LP(); ph_attn_even(pp, lds, l, bx, G); } TSTOP(14) }
            GRID_BAR();
        } else {
            for (int rep = 0; rep < REP_T; ++rep) { TSTART(12) { const Params pp = LP(); ph_compress2(pp, lds, l, bx, G); } TSTOP(12) }
            GRID_BAR();
            for (int rep = 0; rep < REP_AO; ++rep) { TSTART(14) { const Params pp = LP(); ph_attn_odd(pp, lds, bx, G); } TSTOP(14) }
            GRID_BAR();
        }
        { TSTART(13) { const Params pp = LP(); ph_outproj(pp, lds, l, bx, G); } TSTOP(13) }
        if (G != 256) GRID_BAR();
        for (int rep = 0; rep < REP_N1; ++rep) { TSTART(18) { const Params pp = LP(); if (G == 256) WAIT_COUNTER(pp.ws, CW_RDX + l * 64 + (bx >> 2), 4);
                      ph_norm<1>(pp, lds, l, bx, G); __syncthreads(); } TSTOP(18) }
        GRID_BAR();
        for (int rep = 0; rep < REP_T; ++rep) { TSTART(17) { const Params pp = LP(); ph_moe_permute(pp, lds, l, bx, G); } TSTOP(17) }
        GRID_BAR();
        { TSTART(20) { const Params pp = LP(); ph_moe_gemm1(pp, lds, l, bx, G); } TSTOP(20) }
        if (G != 256) GRID_BAR();
        { TSTART(21) { const Params pp = LP(); ph_moe_gemm2(pp, lds, l, bx, G, G == 256); } TSTOP(21) }
        GRID_BAR();
    }
    for (int rep = 0; rep < REP_B; ++rep) GRID_BAR();
    for (int rep = 0; rep < REP_N; ++rep) { TSTART(11) { const Params pp = LP(); ph_norm<2>(pp, lds, 0, bx, G); } TSTOP(11) }
#undef GRID_BAR
    if (TSEL != 0 && blockIdx.x == 0 && threadIdx.x == 0) {
        const unsigned long long t0 = __builtin_amdgcn_s_memrealtime(); const unsigned long long dt = *(LAS unsigned*)(lds + LDS_TACC);
        while (__builtin_amdgcn_s_memrealtime() - t0 < dt) __builtin_amdgcn_s_sleep(8);
    }
}

extern "C" void kernel_launch(void* const* d_in, const int* in_sizes, int n_in, void* d_out, int out_size, void* d_ws, size_t ws_size, hipStream_t stream) {
    static int grid = 0;
    if (grid == 0) {
        if (n_in != 25 || out_size != NT * DM || ws_size < WS_END2) { fprintf(stderr, "kernel_launch: unexpected shapes / workspace (n_in %d out %d ws %zu, need %zu)\n", n_in, out_size, ws_size, (size_t)WS_END2); grid = -1; return; }
        int dev = 0, cus = 0;
        if (hipGetDevice(&dev) != hipSuccess || hipDeviceGetAttribute(&cus, hipDeviceAttributeMultiprocessorCount, dev) != hipSuccess) { grid = -1; return; }
        if (hipFuncSetAttribute((const void*)mega_fwd, hipFuncAttributeMaxDynamicSharedMemorySize, LDS_BYTES) != hipSuccess) { fprintf(stderr, "kernel_launch: hipFuncSetAttribute failed\n"); grid = -1; return; }
        int per_cu = 0;
        if (hipOccupancyMaxActiveBlocksPerMultiprocessor(&per_cu, (const void*)mega_fwd, NTHR, LDS_BYTES) != hipSuccess || per_cu < 1) { fprintf(stderr, "kernel_launch: occupancy query says %d\n", per_cu); }
        (void)hipGetLastError();
        grid = cus < 256 ? cus : 256;
    }
    if (grid < 0) return;
    Params prm; memset(&prm, 0, sizeof(prm)); for (int i = 0; i < 25; ++i) prm.in[i] = (const float*)d_in[i]; prm.out = (float*)d_out; prm.ws = (unsigned char*)d_ws;
    (void)hipMemsetAsync(d_ws, 0, 1 * MiB, stream);
    mega_fwd<<<grid, NTHR, LDS_BYTES, stream>>>(prm);
}
```

```cpp
#include <hip/hip_runtime.h>
#include <stdint.h>
#include <stdio.h>
#include <string.h>

typedef unsigned short bf16_t;
typedef unsigned long long u64;

constexpr int NB = 4, SEQ = 4096, DM = 1024, NT = NB * SEQ, DEPTH = 4;
constexpr int PW = 2048;
constexpr float C2 = 0.125f * 1.4426950408889634f;
constexpr float NEGBIG = -1e30f;
constexpr float LINIT0 = 0.2f, LINIT1 = 0.47071301834358416f;

constexpr size_t MiB = 1u << 20;
constexpr size_t WS_CTL = 0;
constexpr size_t WS_MOD = 1 * MiB;
constexpr size_t WS_ROPE = 2 * MiB;
constexpr size_t WS_MISC = 3 * MiB;
constexpr size_t WS_KMEAN = 3 * MiB + 65536;
constexpr size_t WS_MMASK = 4 * MiB;
constexpr size_t WS_SMASK = 5 * MiB;
constexpr size_t WS_KCMP = 6 * MiB;
constexpr size_t WS_VCMPT = 6 * MiB + 524288;
constexpr size_t WS_CH = 7 * MiB;
constexpr size_t WS_ROUTE = 11 * MiB;
constexpr size_t WS_X = 16 * MiB;
constexpr size_t WS_H = 80 * MiB;
constexpr size_t WS_R = 112 * MiB;
constexpr size_t WS_P = WS_R;
constexpr size_t WS_VT = WS_R + 64 * MiB;
constexpr size_t WS_O = WS_R + 96 * MiB;
constexpr size_t WS_DT = WS_R + 128 * MiB;
constexpr size_t WS_PF = WS_R + 64 * MiB;
constexpr size_t WS_END = 304 * MiB;

constexpr int CW_CNT = 64;

__device__ __forceinline__ bf16_t f2bf(float f) { unsigned u = __float_as_uint(f); u = (u + 0x7fffu + ((u >> 16) & 1u)) >> 16; return (bf16_t)u; }
__device__ __forceinline__ float bf2f(bf16_t h) { return __uint_as_float(((unsigned)h) << 16); }
template <int CTRL> __device__ __forceinline__ float dpp_f(float v) { return __int_as_float(__builtin_amdgcn_update_dpp(0, __float_as_int(v), CTRL, 0xF, 0xF, true)); }
__device__ __forceinline__ float row_sum16(float v) {
    v += dpp_f<0xB1>(v); v += dpp_f<0x4E>(v); v += dpp_f<0x141>(v); v += dpp_f<0x140>(v); return v;
}
__device__ __forceinline__ float xchg16(float v, int lane) {
    const auto r = __builtin_amdgcn_permlane16_swap(__float_as_uint(v), __float_as_uint(v), false, false); return __uint_as_float((lane & 16) ? r[0] : r[1]);
}
__device__ __forceinline__ float xchg32(float v, int lane) {
    const auto r = __builtin_amdgcn_permlane32_swap(__float_as_uint(v), __float_as_uint(v), false, false); return __uint_as_float((lane & 32) ? r[0] : r[1]);
}
__device__ __forceinline__ float wave_sum(float v) {
    v = row_sum16(v);
    { const auto r = __builtin_amdgcn_permlane16_swap(__float_as_uint(v), __float_as_uint(v), false, false); v = __uint_as_float(r[0]) + __uint_as_float(r[1]); }
    { const auto r = __builtin_amdgcn_permlane32_swap(__float_as_uint(v), __float_as_uint(v), false, false); v = __uint_as_float(r[0]) + __uint_as_float(r[1]); }
    return v;
}

#define LAS __attribute__((address_space(3)))
typedef short bf16x8 __attribute__((ext_vector_type(8)));
typedef float f32x4 __attribute__((ext_vector_type(4)));
typedef float f32x16 __attribute__((ext_vector_type(16)));
typedef unsigned u32x4 __attribute__((ext_vector_type(4)));
typedef unsigned u32x2 __attribute__((ext_vector_type(2)));

constexpr int NWAVES = 8, NTHR = 512;
constexpr int LDS_BYTES = 147456;
constexpr size_t WS_WIN = 304 * MiB;
constexpr size_t WS_WOUT = 328 * MiB;
constexpr size_t WS_W1T = 336 * MiB;
constexpr size_t WS_WGU = 340 * MiB;
constexpr size_t WS_WD = 356 * MiB;
constexpr size_t WS_END2 = 364 * MiB;
constexpr size_t WS_VCX = 12 * MiB;
constexpr size_t WS_FOLD = WS_MISC + 1024;
constexpr int MP_ROWS = 36864;
constexpr size_t WS_APERM = WS_R;
constexpr size_t WS_HIDP = WS_R + 72 * MiB;
constexpr size_t WS_Y = WS_R + 96 * MiB;
constexpr size_t WS_POS = WS_ROUTE + 393216;
constexpr size_t WS_WPERM = WS_ROUTE + 524288;
constexpr size_t WS_TILEX = WS_ROUTE + 786432;
constexpr size_t WS_ROWTOK = WS_ROUTE + 868352;
constexpr size_t WS_BLTOK = WS_CH;
constexpr size_t WS_BLW = WS_CH + 2 * MiB;
constexpr size_t WS_BCNT = WS_ROUTE + 851968;

struct Params { const float* in[25]; float* out; unsigned char* ws; };
__device__ __forceinline__ int otid() { int t = threadIdx.x; asm volatile("" : "+v"(t)); return t; }

__device__ __forceinline__ unsigned pk2(float lo, float hi) { return (unsigned)f2bf(lo) | ((unsigned)f2bf(hi) << 16); }
__device__ __forceinline__ unsigned cvt_pk_bf16(float lo, float hi) { unsigned r; asm volatile("v_cvt_pk_bf16_f32 %0, %1, %2" : "=v"(r) : "v"(lo), "v"(hi)); return r; }

__device__ __forceinline__ void conv_item(const float* W, int ldw, int col0, int nvalid, int K, bf16_t* WT, int row0, int rmul, LAS float* scr, int item, int nblk, int lane) {
    const int kb = item / nblk, nb = item % nblk, k0 = 64 * kb, n0 = 64 * nb;
    const int c4 = lane & 15, rr = lane >> 4;
    const bool okc = (n0 + 4 * c4) < nvalid;
    f32x4 v[16];
#pragma unroll
    for (int i = 0; i < 16; ++i) v[i] = okc ? *(const f32x4*)(W + (size_t)(k0 + rr + 4 * i) * ldw + col0 + n0 + 4 * c4) : (f32x4){0.f, 0.f, 0.f, 0.f};
#pragma unroll
    for (int i = 0; i < 16; ++i) { const int kk = rr + 4 * i;
        scr[(4 * c4 + 0) * 65 + kk] = v[i][0]; scr[(4 * c4 + 1) * 65 + kk] = v[i][1]; scr[(4 * c4 + 2) * 65 + kk] = v[i][2]; scr[(4 * c4 + 3) * 65 + kk] = v[i][3]; }
    asm volatile("s_waitcnt lgkmcnt(0)" ::: "memory");
    const int c = lane & 7;
#pragma unroll
    for (int j = 0; j < 8; ++j) { const int n = (lane >> 3) + 8 * j; const LAS float* sp = scr + n * 65 + 8 * c;
        u32x4 o; o.x = pk2(sp[0], sp[1]); o.y = pk2(sp[2], sp[3]); o.z = pk2(sp[4], sp[5]); o.w = pk2(sp[6], sp[7]);
        *(u32x4*)(WT + (size_t)(row0 + (n0 + n) * rmul) * K + k0 + 8 * c) = o; }
    asm volatile("s_waitcnt lgkmcnt(0)" ::: "memory");
}
struct ConvCtx { LAS float* scr; int gw, NGW, lane, base; };
__device__ __forceinline__ void conv_job(ConvCtx& cx, const float* W, int ldw, int col0, int ncols, int nvalid, int K, bf16_t* WT, int row0, int rmul) {
    const int nblk = ncols / 64, nitems = (K / 64) * nblk;
    int it = cx.gw - (cx.base % cx.NGW); if (it < 0) it += cx.NGW;
    for (; it < nitems; it += cx.NGW) conv_item(W, ldw, col0, nvalid, K, WT, row0, rmul, cx.scr, it, nblk, cx.lane);
    cx.base += nitems;
}
__device__ __forceinline__ void ph_conv_static(const Params& p, LAS unsigned char* lds, int vcu, int G) {
    const int tid = otid(), lane = tid & 63, wave = tid >> 6;
    ConvCtx cx; cx.scr = (LAS float*)(lds + wave * 16640); cx.gw = vcu * NWAVES + wave; cx.NGW = G * NWAVES; cx.lane = lane; cx.base = 0;
    for (int l = 0; l < DEPTH; ++l) {
        const int li = l >> 1;
        bf16_t* win = (bf16_t*)(p.ws + WS_WIN) + (size_t)l * 3072 * 1024;
        bf16_t* wout = (bf16_t*)(p.ws + WS_WOUT) + (size_t)l * 1024 * 1024;
        if ((l & 1) == 0) {
            const float* w = p.in[7] + (size_t)li * 1024 * 3072;
            conv_job(cx, w, 3072, 0, 512, 512, 1024, win, 0, 1);
            conv_job(cx, w, 3072, 512, 512, 512, 1024, win, 512, 1);
            conv_job(cx, w, 3072, 1536, 512, 512, 1024, win, 1024, 1);
            conv_job(cx, w, 3072, 2048, 512, 512, 1024, win, 1536, 1);
            conv_job(cx, w, 3072, 1024, 512, 512, 1024, win, 2048, 1);
            conv_job(cx, w, 3072, 2560, 512, 512, 1024, win, 2560, 1);
            conv_job(cx, p.in[8] + (size_t)li * 1024 * 1024, 1024, 0, 1024, 1024, 1024, wout, 0, 1);
        } else {
            const float* w = p.in[11] + (size_t)li * 1024 * 2608;
            conv_job(cx, w, 2608, 0, 1024, 1024, 1024, win, 0, 1);
            conv_job(cx, w, 2608, 1024, 256, 256, 1024, win, 1024, 1);
            conv_job(cx, w, 2608, 1536, 256, 256, 1024, win, 1280, 1);
            conv_job(cx, w, 2608, 2048, 256, 256, 1024, win, 1536, 1);
            conv_job(cx, w, 2608, 1280, 256, 256, 1024, win, 1792, 1);
            conv_job(cx, w, 2608, 1792, 256, 256, 1024, win, 2048, 1);
            conv_job(cx, w, 2608, 2304, 256, 256, 1024, win, 2304, 1);
            conv_job(cx, w, 2608, 2560, 256, 48, 1024, win, 2560, 1);
            conv_job(cx, p.in[12] + (size_t)li * 1024 * 1024, 1024, 0, 1024, 1024, 1024, wout, 0, 1);
            bf16_t* w1t = (bf16_t*)(p.ws + WS_W1T) + (size_t)li * 2 * 256 * 2048;
            conv_job(cx, p.in[14] + (size_t)(li * 2 + 0) * 2048 * 256, 256, 0, 256, 256, 2048, w1t, 0, 1);
            conv_job(cx, p.in[14] + (size_t)(li * 2 + 1) * 2048 * 256, 256, 0, 256, 256, 2048, w1t + (size_t)256 * 2048, 0, 1);
        }
    }
}
#define XB_TMO      128
#define XB_XCNT(j)  (256  + 64 * (j))
#define XB_XSUB(j)  (1280 + 64 * (j))
#define XB_XGEN(j)  (2304 + 64 * (j))
#define XB_TOP      3328
#define XB_TOPGEN   3392
#define XCD_BAR_WORDS 3456
#define XB_SPIN_CAP (1u << 18)
__device__ __forceinline__ unsigned xb_ld(unsigned* p)              { return __hip_atomic_load(p, __ATOMIC_RELAXED, __HIP_MEMORY_SCOPE_AGENT); }
__device__ __forceinline__ unsigned xb_add(unsigned* p, unsigned v) { return __hip_atomic_fetch_add(p, v, __ATOMIC_RELAXED, __HIP_MEMORY_SCOPE_AGENT); }
__device__ __forceinline__ unsigned xb_xcc_id() { return (unsigned)__builtin_amdgcn_s_getreg((3 << 11) | 20) & 0xFu; }
#define XB_SPIN(cond, bar) do { unsigned _sp = 0; while (cond) { __builtin_amdgcn_s_sleep(1); \
    if ((++_sp & 255u) == 0u) { if (xb_ld(&(bar)[XB_TMO])) break; if (_sp > XB_SPIN_CAP) { atomicAdd(&(bar)[XB_TMO], 1u); break; } } } } while (0)
constexpr int CW_BAR = 4096;
constexpr int CW_RDY = 16384;
constexpr int CW_RDH = 20480;
constexpr int CW_RDX = 24576;
#define WAIT_COUNTER(ws_, idx_, need_) do { if (otid() == 0) { unsigned* cw_ = (unsigned*)((ws_) + WS_CTL); XB_SPIN(xb_ld(&cw_[idx_]) < (unsigned)(need_), cw_ + CW_BAR); \
        __builtin_amdgcn_fence(__ATOMIC_ACQUIRE, "agent"); asm volatile("s_waitcnt vmcnt(0)" ::: "memory"); } __syncthreads(); } while (0)
__device__ __forceinline__ void ph_zero_kmsum(const Params& p, int bx, int G) {
    float* km = (float*)(p.ws + WS_KMEAN);
    int gstride = G * NTHR; asm volatile("" : "+s"(gstride));
    float z = 0.f; asm volatile("" : "+v"(z));
    for (int i = bx * NTHR + otid(); i < NB * 8 * 16 * 64; i += gstride) km[i] = z;
}
__device__ __forceinline__ void ph_conv_moe(const Params& p, LAS unsigned char* lds, int l, int vcu, int G) {
    const int tid = otid(), lane = tid & 63, wave = tid >> 6;
    ConvCtx cx; cx.scr = (LAS float*)(lds + wave * 16640); cx.gw = vcu * NWAVES + wave; cx.NGW = G * NWAVES; cx.lane = lane; cx.base = 0;
    bf16_t* wgu = (bf16_t*)(p.ws + WS_WGU); bf16_t* wd = (bf16_t*)(p.ws + WS_WD);
    for (int e = 0; e < 16; ++e) {
        conv_job(cx, p.in[22] + (size_t)(l * 16 + e) * 1024 * 256, 256, 0, 256, 256, 1024, wgu + (size_t)e * 512 * 1024, 0, 2);
        conv_job(cx, p.in[23] + (size_t)(l * 16 + e) * 1024 * 256, 256, 0, 256, 256, 1024, wgu + (size_t)e * 512 * 1024, 1, 2);
        conv_job(cx, p.in[24] + (size_t)(l * 16 + e) * 256 * 1024, 1024, 0, 1024, 1024, 256, wd + (size_t)e * 1024 * 256, 0, 1);
    }
}

namespace pg8 {
constexpr int BM = 256, BK = 64, HALF = 128, HTB = HALF * BK * 2, STAGE_BYTES = 8 * HTB, NXCD = 8, WGM = 8;
__host__ __device__ __forceinline__ int lds_byte(int r, int c) { const int st = (r >> 4) * 2 + (c >> 5), rr = r & 15, cc = c & 31, ob = rr * 64 + cc * 2; return st * 1024 + (ob ^ (((ob >> 9) & 1) << 5)); }
__host__ __device__ __forceinline__ void stage_rc(int b, int& R, int& C) { const int st = b / 1024, sb = b % 1024, swz = sb ^ (((sb >> 9) & 1) << 5); R = (st >> 1) * 16 + swz / 64; C = (st & 1) * 32 + (swz % 64) / 2; }
__host__ __device__ __forceinline__ int perm32(int rho) { const int n = rho >> 4, i = rho & 15; return 8 * (i >> 2) + 4 * n + (i & 3); }
struct Unit { int pm, pn; };
struct Gemm { const bf16_t* A; const bf16_t* Bt; int K; unsigned lda_b; unsigned kstepA; int ldb; };
template <bool SIG>
struct StaticOrderT {
    static constexpr bool GATHER = false, SIGNAL = SIG;
    unsigned* ready = nullptr;
    int nM, nN, nwg, G, c;
    __host__ __device__ void init(int M, int N, int G_, int c_) { nM = M / BM; nN = N / BM; nwg = nM * nN; G = G_; c = c_; }
    __host__ __device__ bool next(int i, Unit& u) const {
        const long L = (long)i * G + c; if (L >= nwg) return false;
        int wgid = (int)L; { const int q = nwg / NXCD, r = nwg % NXCD, xcd = wgid % NXCD, off = wgid / NXCD; wgid = (xcd < r ? xcd * (q + 1) : r * (q + 1) + (xcd - r) * q) + off; }
        const int nig = WGM * nN, gid = wgid / nig, fm = gid * WGM, gsz = (nM - fm) < WGM ? (nM - fm) : WGM;
        u.pm = fm + ((wgid % nig) % gsz); u.pn = (wgid % nig) / gsz; return true;
    }
    __host__ __device__ size_t aoff(const Unit& u, size_t tstepA) const { return (size_t)u.pm * tstepA; }
    __host__ __device__ size_t boff(const Unit&) const { return 0; }
};
typedef StaticOrderT<false> StaticOrder;
template <class Epi, class Sched>
__device__ __forceinline__ void gemm_phase(LAS unsigned char* lds, const Gemm g, const Sched& S, const Epi& E) {
    const int tid = otid(), wid = __builtin_amdgcn_readfirstlane(tid >> 6), lane = tid & 63, wr = wid >> 2, wc = wid & 3, fr = lane & 15, fq = lane >> 4;
    const int K = g.K, nt = K / BK;
    unsigned voffA[2], voffB[2];
#pragma unroll
    for (int i = 0; i < 2; ++i) { int R, C; stage_rc(tid * 16 + i * 8192, R, C); const int Rb = (R & ~31) + perm32(R & 31);
        voffA[i] = (unsigned)R * g.lda_b + (unsigned)C * 2u; voffB[i] = (unsigned)(Rb * g.ldb + C) * 2u; }
    const size_t kstepA = g.kstepA, kstepB = (size_t)(BK * 2);
    const size_t hstepA = (size_t)HALF * g.lda_b, hstepB = (size_t)HALF * g.ldb * 2;
    const size_t tstepA = 2 * hstepA, tstepB = 2 * hstepB;
    const unsigned ldsw = (unsigned)wid * 1024u;
    const int aoff = lds_byte(wr * 64 + fr, fq * 8), boff = lds_byte(wc * 32 + fr, fq * 8);
#define PG8_SA(b, h) (((b) * 2 + (h)) * HTB)
#define PG8_SB(b, h) ((4 + (b) * 2 + (h)) * HTB)
#define PG8_STAGE(bufoff, gbase, voff) do { _Pragma("unroll") for (int _i = 0; _i < 2; ++_i) \
        __builtin_amdgcn_global_load_lds((const unsigned*)((const char*)(gbase) + (voff)[_i]), (LAS unsigned*)(lds + (bufoff) + ldsw + _i * 8192), 16, 0, 0); } while (0)
#define PG8_LDA(dst, b, h) do { _Pragma("unroll") for (int m = 0; m < 4; ++m) _Pragma("unroll") for (int k = 0; k < 2; ++k) dst[m][k] = *(const LAS bf16x8*)(lds + PG8_SA(b, h) + aoff + m * 2048 + k * 1024); } while (0)
#define PG8_LDB(dst, b, h) do { _Pragma("unroll") for (int n = 0; n < 2; ++n) _Pragma("unroll") for (int k = 0; k < 2; ++k) dst[n][k] = *(const LAS bf16x8*)(lds + PG8_SB(b, h) + boff + n * 2048 + k * 1024); } while (0)
#define PG8_MMA(ai, bj, At, Bt) do { __builtin_amdgcn_s_setprio(1); _Pragma("unroll") for (int m = 0; m < 4; ++m) _Pragma("unroll") for (int n = 0; n < 2; ++n) _Pragma("unroll") for (int k = 0; k < 2; ++k) \
        acc[ai][bj][m][n] = __builtin_amdgcn_mfma_f32_16x16x32_bf16(Bt[n][k], At[m][k], acc[ai][bj][m][n], 0, 0, 0); __builtin_amdgcn_s_setprio(0); } while (0)
#define PG8_WAIT_V(n) asm volatile("s_waitcnt vmcnt(" #n ")" ::: "memory")
#define PG8_WAIT_L(n) asm volatile("s_waitcnt lgkmcnt(" #n ")" ::: "memory")
#define PG8_BAR __builtin_amdgcn_s_barrier()
#define PG8_SCHED __builtin_amdgcn_sched_barrier(0)
    Unit cur, nxt; int ui = 0;
    if (!S.next(0, cur)) return;
    unsigned vC[2][2], vN[2][2];
    LAS int* rtl = (LAS int*)(lds + STAGE_BYTES);
    int Rg[2], Cg[2];
    if constexpr (Sched::GATHER) {
        if (S.rowtok != nullptr) { Unit uu; for (int i = 0; i < 15 && S.next(i, uu); ++i) if (tid < 256) rtl[i * 256 + tid] = S.rowtok[uu.pm * 256 + tid]; }
        __syncthreads();
#pragma unroll
        for (int i = 0; i < 2; ++i) stage_rc(tid * 16 + i * 8192, Rg[i], Cg[i]);
#pragma unroll
        for (int h = 0; h < 2; ++h)
#pragma unroll
            for (int i = 0; i < 2; ++i) { vC[h][i] = (unsigned)rtl[Rg[i] + 128 * h] * g.lda_b + (unsigned)Cg[i] * 2u; vN[h][i] = vC[h][i]; }
    }
#define PG8_STAGE_A(bufoff, kb, h, nx) do { if constexpr (Sched::GATHER) { unsigned vv_[2]; vv_[0] = (nx) ? vN[h][0] : vC[h][0]; vv_[1] = (nx) ? vN[h][1] : vC[h][1]; PG8_STAGE(bufoff, (const char*)g.A + (kb), vv_); } \
        else PG8_STAGE(bufoff, ((nx) ? nA : cA) + (kb) + (h) * hstepA, voffA); } while (0)
    f32x4 acc[2][2][4][2];
#pragma unroll
    for (int a = 0; a < 2; ++a)
#pragma unroll
        for (int b = 0; b < 2; ++b)
#pragma unroll
            for (int m = 0; m < 4; ++m)
#pragma unroll
                for (int n = 0; n < 2; ++n) acc[a][b][m][n] = (f32x4){0.f, 0.f, 0.f, 0.f};
    bf16x8 At[4][2], B0[2][2], B1[2][2];
    const char* cA = (const char*)g.A + S.aoff(cur, tstepA); const char* cB = (const char*)g.Bt + (size_t)cur.pn * tstepB + S.boff(cur);
    {
        const char* nA = cA;
        PG8_STAGE(PG8_SB(0, 0), cB, voffB); PG8_STAGE(PG8_SB(0, 1), cB + hstepB, voffB); PG8_STAGE_A(PG8_SA(0, 0), (size_t)0, 0, false); PG8_STAGE_A(PG8_SA(0, 1), (size_t)0, 1, false);
        if (wr == 1) PG8_BAR;
        PG8_WAIT_V(2); PG8_BAR;
        PG8_STAGE(PG8_SB(1, 0), cB + kstepB, voffB); PG8_STAGE_A(PG8_SA(1, 0), kstepA, 0, false); PG8_STAGE(PG8_SB(1, 1), cB + hstepB + kstepB, voffB);
        PG8_WAIT_V(6); PG8_BAR;
    }
    for (;;) {
        const bool has_next = S.next(ui + 1, nxt);
        const char* nA = has_next ? (const char*)g.A + S.aoff(nxt, tstepA) : cA; const char* nB = has_next ? (const char*)g.Bt + (size_t)nxt.pn * tstepB + S.boff(nxt) : cB;
        if constexpr (Sched::GATHER) {
            if (has_next) {
#pragma unroll
                for (int h = 0; h < 2; ++h)
#pragma unroll
                    for (int i = 0; i < 2; ++i) vN[h][i] = (unsigned)rtl[(ui + 1) * 256 + Rg[i] + 128 * h] * g.lda_b + (unsigned)Cg[i] * 2u;
            }
        }
#pragma unroll 1
        for (int t = 0; t < nt; t += 2) {
            const bool last = (t == nt - 2);
            const size_t k1 = (size_t)(t + 1) * kstepA, k2 = last ? (size_t)0 : (size_t)(t + 2) * kstepA, k3 = k2 + kstepA;
            const char* b2 = last ? nB : cB + (size_t)(t + 2) * kstepB; const char* b3 = b2 + kstepB;
            PG8_LDB(B0, 0, 0); PG8_LDB(B1, 0, 1); PG8_SCHED; PG8_LDA(At, 0, 0); PG8_STAGE_A(PG8_SA(1, 1), k1, 1, false);
            PG8_WAIT_V(8); PG8_WAIT_L(0); PG8_BAR; PG8_MMA(0, 0, At, B0); PG8_MMA(0, 1, At, B1); PG8_BAR; PG8_SCHED;
            PG8_LDA(At, 0, 1); PG8_STAGE(PG8_SB(0, 0), b2, voffB); PG8_STAGE(PG8_SB(0, 1), b2 + hstepB, voffB); PG8_STAGE_A(PG8_SA(0, 0), k2, 0, last);
            PG8_WAIT_V(8); PG8_WAIT_L(0); PG8_BAR; PG8_MMA(1, 0, At, B0); PG8_MMA(1, 1, At, B1); PG8_BAR; PG8_SCHED;
            PG8_LDB(B0, 1, 0); PG8_LDB(B1, 1, 1); PG8_SCHED; PG8_LDA(At, 1, 0); PG8_STAGE_A(PG8_SA(0, 1), k2, 1, last);
            PG8_WAIT_V(8); PG8_WAIT_L(0); PG8_BAR; PG8_MMA(0, 0, At, B0); PG8_MMA(0, 1, At, B1); PG8_BAR; PG8_SCHED;
            PG8_LDA(At, 1, 1); PG8_STAGE(PG8_SB(1, 0), b3, voffB); PG8_STAGE(PG8_SB(1, 1), b3 + hstepB, voffB); PG8_STAGE_A(PG8_SA(1, 0), k3, 0, last);
            PG8_WAIT_V(8); PG8_WAIT_L(0); PG8_BAR; PG8_MMA(1, 0, At, B0); PG8_MMA(1, 1, At, B1); PG8_BAR; PG8_SCHED;
        }
        if (wr == 0) PG8_BAR;
        E(acc, cur, wr, wc, fr, fq);
        if constexpr (Sched::SIGNAL) {
            asm volatile("s_waitcnt vmcnt(0)" ::: "memory"); PG8_BAR;
            if (tid == 0) (void)__hip_atomic_fetch_add(S.ready + cur.pm, 1u, __ATOMIC_RELAXED, __HIP_MEMORY_SCOPE_AGENT);
        }
        if (!has_next) break;
#pragma unroll
        for (int a = 0; a < 2; ++a)
#pragma unroll
            for (int b = 0; b < 2; ++b)
#pragma unroll
                for (int m = 0; m < 4; ++m)
#pragma unroll
                    for (int n = 0; n < 2; ++n) acc[a][b][m][n] = (f32x4){0.f, 0.f, 0.f, 0.f};
        cur = nxt; cA = nA; cB = nB; ++ui;
        if constexpr (Sched::GATHER) {
#pragma unroll
            for (int h = 0; h < 2; ++h)
#pragma unroll
                for (int i = 0; i < 2; ++i) vC[h][i] = vN[h][i];
        }
        if (wr == 1) PG8_BAR;
    }
    PG8_WAIT_V(0);
    PG8_BAR;
#undef PG8_SA
#undef PG8_SB
#undef PG8_STAGE
#undef PG8_STAGE_A
#undef PG8_LDA
#undef PG8_LDB
#undef PG8_MMA
#undef PG8_WAIT_V
#undef PG8_WAIT_L
#undef PG8_BAR
#undef PG8_SCHED
}
}

typedef f32x4 AccT[2][2][4][2];
struct EpiProj {
    bf16_t* P; const float* rope; int rope_tiles; unsigned qmask; float* kmsum; int km_tile0;
    __device__ __forceinline__ void operator()(const AccT& acc, const pg8::Unit& u, int wr, int wc, int fr, int fq) const {
        const int row0 = u.pm * 256 + wr * 64 + fr, col0 = u.pn * 256 + wc * 32 + 8 * fq;
        const bool do_rope = (u.pn < rope_tiles) && ((wc & 1) == 0);
        const float sc = ((qmask >> u.pn) & 1u) ? C2 : 1.f;
        const bool do_km = (kmsum != nullptr) && ((u.pn == km_tile0) || (u.pn == km_tile0 + 1));
#pragma unroll
        for (int bj = 0; bj < 2; ++bj) {
            f32x4 ks0 = {0.f, 0.f, 0.f, 0.f}, ks1 = ks0;
#pragma unroll
            for (int ai = 0; ai < 2; ++ai)
#pragma unroll
                for (int m = 0; m < 4; ++m) {
                    const int row = row0 + ai * 128 + m * 16, pos = row & (SEQ - 1);
                    f32x4 v0 = acc[ai][bj][m][0], v1 = acc[ai][bj][m][1];
                    if (do_rope) {
                        const f32x4 c0 = *(const f32x4*)(rope + pos * 8), c1 = *(const f32x4*)(rope + pos * 8 + 4), s0 = *(const f32x4*)(rope + SEQ * 8 + pos * 8), s1 = *(const f32x4*)(rope + SEQ * 8 + pos * 8 + 4);
                        f32x4 p0, p1;
#pragma unroll
                        for (int e = 0; e < 4; ++e) { p0[e] = xchg16(v0[e], fq << 4); p1[e] = xchg16(v1[e], fq << 4); }
                        const f32x4 a0 = v0 * c0 - p0 * s0, a1 = v1 * c1 - p1 * s1, b0 = v0 * c0 + p0 * s0, b1 = v1 * c1 + p1 * s1;
                        v0 = fq == 0 ? a0 : (fq == 1 ? b0 : v0); v1 = fq == 0 ? a1 : (fq == 1 ? b1 : v1);
                    }
                    ks0 = ks0 + v0; ks1 = ks1 + v1;
                    v0 = v0 * sc; v1 = v1 * sc;
                    u32x4 w; w.x = cvt_pk_bf16(v0[0], v0[1]); w.y = cvt_pk_bf16(v0[2], v0[3]); w.z = cvt_pk_bf16(v1[0], v1[1]); w.w = cvt_pk_bf16(v1[2], v1[3]);
                    *(u32x4*)(P + (size_t)row * PW + col0 + bj * 128) = w;
                }
            if (do_km) {
                const int b = u.pm >> 4, blk = u.pm & 15;
#pragma unroll
                for (int n = 0; n < 2; ++n)
#pragma unroll
                    for (int e = 0; e < 4; ++e) {
                        float t = n == 0 ? ks0[e] : ks1[e];
                        t = row_sum16(t);
                        if (fr == 0) { const int c = (u.pn - km_tile0) * 256 + bj * 128 + wc * 32 + 8 * fq + 4 * n + e;
                            atomicAdd(kmsum + ((size_t)(b * 8 + (c >> 6)) * 16 + blk) * 64 + (c & 63), t); }
                    }
            }
        }
    }
};
struct EpiBf16 {
    bf16_t* O; int ldc; int pnmask;
    __device__ __forceinline__ void operator()(const AccT& acc, const pg8::Unit& u, int wr, int wc, int fr, int fq) const {
        const int row0 = u.pm * 256 + wr * 64 + fr, col0 = (u.pn & pnmask) * 256 + wc * 32 + 8 * fq;
#pragma unroll
        for (int ai = 0; ai < 2; ++ai)
#pragma unroll
            for (int m = 0; m < 4; ++m) {
                bf16_t* rowp = O + (size_t)(row0 + ai * 128 + m * 16) * ldc + col0;
#pragma unroll
                for (int bj = 0; bj < 2; ++bj) { const f32x4 v0 = acc[ai][bj][m][0], v1 = acc[ai][bj][m][1];
                    u32x4 w; w.x = cvt_pk_bf16(v0[0], v0[1]); w.y = cvt_pk_bf16(v0[2], v0[3]); w.z = cvt_pk_bf16(v1[0], v1[1]); w.w = cvt_pk_bf16(v1[2], v1[3]);
                    *(u32x4*)(rowp + bj * 128) = w; }
            }
    }
};
struct EpiResid {
    const float* x0; bf16_t* X; const float* g;
    __device__ __forceinline__ void operator()(const AccT& acc, const pg8::Unit& u, int wr, int wc, int fr, int fq) const {
        const int row0 = u.pm * 256 + wr * 64 + fr, col0 = u.pn * 256 + wc * 32 + 8 * fq;
        const float* gb = g + (u.pm / 16) * 6144;
#pragma unroll
        for (int bj = 0; bj < 2; ++bj) {
            const f32x4 g0 = *(const f32x4*)(gb + col0 + bj * 128), g1 = *(const f32x4*)(gb + col0 + bj * 128 + 4);
#pragma unroll
            for (int ai = 0; ai < 2; ++ai)
#pragma unroll
                for (int m = 0; m < 4; ++m) {
                    const size_t off = (size_t)(row0 + ai * 128 + m * 16) * DM + col0 + bj * 128;
                    f32x4 x0v, x1v;
                    if (x0 != nullptr) { x0v = *(const f32x4*)(x0 + off); x1v = *(const f32x4*)(x0 + off + 4); }
                    else { const u32x4 xr = *(const u32x4*)(X + off);
                        x0v[0] = __uint_as_float(xr.x << 16); x0v[1] = __uint_as_float(xr.x & 0xffff0000u); x0v[2] = __uint_as_float(xr.y << 16); x0v[3] = __uint_as_float(xr.y & 0xffff0000u);
                        x1v[0] = __uint_as_float(xr.z << 16); x1v[1] = __uint_as_float(xr.z & 0xffff0000u); x1v[2] = __uint_as_float(xr.w << 16); x1v[3] = __uint_as_float(xr.w & 0xffff0000u); }
                    const f32x4 y0 = x0v + g0 * acc[ai][bj][m][0], y1 = x1v + g1 * acc[ai][bj][m][1];
                    u32x4 w; w.x = cvt_pk_bf16(y0[0], y0[1]); w.y = cvt_pk_bf16(y0[2], y0[3]); w.z = cvt_pk_bf16(y1[0], y1[1]); w.w = cvt_pk_bf16(y1[2], y1[3]);
                    asm volatile("global_store_dwordx4 %0, %1, off sc0 sc1\n\ts_nop 1" :: "v"(X + off), "v"(w) : "memory");
                }
        }
    }
};

struct CmpOrder {
    static constexpr bool GATHER = false, SIGNAL = false;
    int G, c;
    __device__ bool next(int i, pg8::Unit& u) const { const int L = i * G + c; if (c < 0 || L >= 64) return false; u.pm = L; u.pn = (L & 31) >> 4; return true; }
    __device__ size_t aoff(const pg8::Unit& u, size_t tstepA) const { const int ks = u.pm >> 5, br = (u.pm >> 4) & 1, g = (u.pm >> 2) & 3, rt = u.pm & 3; return (size_t)rt * tstepA + (size_t)(((br ? 1792 : 1024) + g * 64) * 2) + (size_t)ks * 16 * PW * 2; }
    __device__ size_t boff(const pg8::Unit& u) const { return (size_t)(u.pm >> 5) * 1024 * 2; }
};
__device__ __forceinline__ float gelu_tanh_fast(float x) {
    const float y = 0.7978845608028654f * (x + 0.044715f * x * x * x);
    const float t = 1.f - 2.f * __builtin_amdgcn_rcpf(1.f + __expf(2.f * y));
    return 0.5f * x * (1.f + t);
}
struct EpiCmp1 {
    float* CHP;
    __device__ __forceinline__ void operator()(const AccT& acc, const pg8::Unit& u, int wr, int wc, int fr, int fq) const {
        const int ks = u.pm >> 5, br = (u.pm >> 4) & 1, g = (u.pm >> 2) & 3, rt = u.pm & 3;
        const int row0 = rt * 256 + wr * 64 + fr, col0 = wc * 32 + 8 * fq;
        float* base = CHP + ((size_t)ks * 8192 + (size_t)(br * 4 + g) * 1024) * 256;
#pragma unroll
        for (int bj = 0; bj < 2; ++bj)
#pragma unroll
            for (int ai = 0; ai < 2; ++ai)
#pragma unroll
                for (int m = 0; m < 4; ++m) {
                    float* dst = base + (size_t)(row0 + ai * 128 + m * 16) * 256 + col0 + bj * 128;
                    *(f32x4*)dst = acc[ai][bj][m][0]; *(f32x4*)(dst + 4) = acc[ai][bj][m][1];
                }
    }
};
__device__ __forceinline__ void ph_inproj(const Params& p, LAS unsigned char* lds, int l, int bx, int G, int stage) {
    const bf16_t* H = (const bf16_t*)(p.ws + WS_H);
    const bf16_t* win = (const bf16_t*)(p.ws + WS_WIN) + (size_t)l * 3072 * 1024;
    const bool even = (l & 1) == 0;
    const bool split = (G >= 224);
    const bool hwait = (G == 256) && (stage != 2);
    if (stage != 2) {
        pg8::Gemm g{H, win, 1024, 2048u, 128u, 1024}; pg8::StaticOrder S; S.init(NT, PW, G, bx);
        if (hwait) { if (otid() == 0) { unsigned* cw = (unsigned*)(p.ws + WS_CTL); pg8::Unit u; for (int i = 0; S.next(i, u); ++i) XB_SPIN(xb_ld(&cw[CW_RDH + l * 64 + u.pm]) < 4u, cw + CW_BAR);
                __builtin_amdgcn_fence(__ATOMIC_ACQUIRE, "agent"); asm volatile("s_waitcnt vmcnt(0)" ::: "memory"); } __syncthreads(); }
        EpiProj E{(bf16_t*)(p.ws + WS_P), (const float*)(p.ws + WS_ROPE), even ? 8 : 7, even ? 0x33u : 0x0Fu, even ? (float*)(p.ws + WS_KMEAN) : nullptr, 2};
        pg8::gemm_phase<EpiProj, pg8::StaticOrder>(lds, g, S, E);
    }
    const bool doV = (stage == 0) || (stage == 2 && (!split || bx < 192));
    if (doV) {
        pg8::Gemm g{win + (size_t)2048 * 1024, H, 1024, 2048u, 128u, 1024}; pg8::StaticOrder S; S.init(even ? 1024 : 768, NT, (stage == 2 && split) ? 192 : G, bx);
        if (hwait) { if (otid() == 0) { unsigned* cw = (unsigned*)(p.ws + WS_CTL); pg8::Unit u; for (int i = 0; S.next(i, u); ++i) XB_SPIN(xb_ld(&cw[CW_RDH + l * 64 + u.pn]) < 4u, cw + CW_BAR);
                __builtin_amdgcn_fence(__ATOMIC_ACQUIRE, "agent"); asm volatile("s_waitcnt vmcnt(0)" ::: "memory"); } __syncthreads(); }
        EpiBf16 E{(bf16_t*)(p.ws + WS_VT), NT, 0x7fffffff};
        pg8::gemm_phase<EpiBf16, pg8::StaticOrder>(lds, g, S, E);
    }
    if (stage == 2 && (!split || bx >= 192)) {
        const int li = l >> 1;
        pg8::Gemm g{(const bf16_t*)(p.ws + WS_P), (const bf16_t*)(p.ws + WS_W1T) + (size_t)li * 2 * 256 * 2048, 1024, 16u * PW * 2u, PW * 2u, 2048};
        CmpOrder S{split ? 64 : G, split ? bx - 192 : bx};
        EpiCmp1 E{(float*)(p.ws + WS_DT)};
        pg8::gemm_phase<EpiCmp1, CmpOrder>(lds, g, S, E);
    }
}
__device__ __forceinline__ void ph_outproj(const Params& p, LAS unsigned char* lds, int l, int bx, int G) {
    const bf16_t* O = (const bf16_t*)(p.ws + WS_O);
    const bf16_t* wout = (const bf16_t*)(p.ws + WS_WOUT) + (size_t)l * 1024 * 1024;
    bf16_t* X = (bf16_t*)(p.ws + WS_X);
    pg8::Gemm g{O, wout, 1024, 2048u, 128u, 1024}; pg8::StaticOrderT<true> S; S.init(NT, DM, G, bx); S.ready = (unsigned*)(p.ws + WS_CTL) + CW_RDX + l * 64;
    EpiResid E{l == 0 ? p.in[0] : (const float*)nullptr, X, (const float*)(p.ws + WS_MOD) + (size_t)l * 4 * 6144 + 2 * 1024};
    pg8::gemm_phase<EpiResid, pg8::StaticOrderT<true>>(lds, g, S, E);
}


typedef float f32x2_t __attribute__((ext_vector_type(2))); typedef __bf16 bf16x2_t __attribute__((ext_vector_type(2)));
__device__ __forceinline__ unsigned cvtpk_s(float lo, float hi) { f32x2_t v = {lo, hi}; bf16x2_t b = __builtin_convertvector(v, bf16x2_t); return __builtin_bit_cast(unsigned, b); }
#define MFMA32(a, b, c) __builtin_amdgcn_mfma_f32_32x32x16_bf16((a), (b), (c), 0, 0, 0)
constexpr int AT_KB = 64 * 144, AT_VB = 128 * 144;
constexpr int AT_KOFF = 0, AT_VOFF = 2 * AT_KB;
constexpr int AT_MASK = AT_VOFF + 3 * AT_VB;
constexpr int AT_RED = AT_MASK + 2048;
constexpr int AT_KM = AT_RED + 1024;
constexpr int AT_K2OFF = 81920;
constexpr int AT_IMP = 0;
static_assert(AT_IMP + 4 * 64 * 65 * 4 <= AT_MASK && AT_KM + 4096 <= 131072, "attention LDS map");

template <int DVB>
__device__ __forceinline__ bool attn_part1(LAS unsigned char* lds, int j, int kbuf, u64 mymask, int klim, int kmin, int r, int hi,
                                           const bf16x8 (&qf)[4], f32x16 (&o)[DVB], float& l, float& m_run, bool& fresh, f32x16& negm, bf16x8 (&pbo)[2][2], int kring = AT_KOFF) {
    bool done = false;
        {
            const int k0 = j * 64;
            const bool bit = ((mymask >> j) & 1ull) != 0ull;
            const bool any = bit && (k0 <= klim) && (k0 + 63 >= kmin);
            if (__ballot(any) != 0ull) {
                const bool rfull = (k0 + 63 <= klim) && (k0 >= kmin);
                const bool range_full = (__ballot(rfull) == ~0ull);
                const LAS unsigned char* kb = lds + kring + kbuf * AT_KB + r * 144 + hi * 16;
                f32x16 p0, p1;
                {
                    const bf16x8 ka = *(const LAS bf16x8*)(kb), kb2 = *(const LAS bf16x8*)(kb + 32 * 144);
                    p0 = MFMA32(ka, qf[0], negm); p1 = MFMA32(kb2, qf[0], negm);
                }
#pragma unroll
                for (int ks = 1; ks < 4; ++ks) {
                    const bf16x8 ka = *(const LAS bf16x8*)(kb + ks * 32), kb2 = *(const LAS bf16x8*)(kb + 32 * 144 + ks * 32);
                    p0 = MFMA32(ka, qf[ks], p0); p1 = MFMA32(kb2, qf[ks], p1);
                }
                if (!range_full) {
#pragma unroll
                    for (int i = 0; i < 16; ++i) { const int key = k0 + (i & 3) + 8 * (i >> 2) + 4 * hi;
                        const bool ok0 = (key <= klim) && (key >= kmin), ok1 = (key + 32 <= klim) && (key + 32 >= kmin);
                        p0[i] = ok0 ? p0[i] : NEGBIG; p1[i] = ok1 ? p1[i] : NEGBIG; }
                }
                float mx;
                {
                    float t[11];
#pragma unroll
                    for (int i = 0; i < 5; ++i) { t[2 * i] = fmaxf(fmaxf(p0[3 * i], p0[3 * i + 1]), p0[3 * i + 2]); t[2 * i + 1] = fmaxf(fmaxf(p1[3 * i], p1[3 * i + 1]), p1[3 * i + 2]); }
                    t[10] = fmaxf(fmaxf(p0[15], p1[15]), t[0]);
                    const float u0 = fmaxf(fmaxf(t[1], t[2]), t[3]), u1 = fmaxf(fmaxf(t[4], t[5]), t[6]), u2 = fmaxf(fmaxf(t[7], t[8]), t[9]);
                    mx = fmaxf(fmaxf(u0, u1), fmaxf(u2, t[10]));
                }
                { const auto sw = __builtin_amdgcn_permlane32_swap(__float_as_uint(mx), __float_as_uint(mx), false, false); mx = fmaxf(__uint_as_float(sw[0]), __uint_as_float(sw[1])); }
                const bool valid = bit && (mx > -1e29f);
                float d = 0.f;
                if (valid && (fresh || mx > 8.f)) d = mx;
                if (__ballot(d != 0.f) != 0ull) {
                    const float alpha = fresh ? 1.f : __builtin_amdgcn_exp2f(-d);
                    l *= alpha; m_run += d;
#pragma unroll
                    for (int dd = 0; dd < DVB; ++dd) o[dd] = o[dd] * alpha;
#pragma unroll
                    for (int i = 0; i < 16; ++i) { negm[i] = -m_run; p0[i] -= d; p1[i] -= d; }
                }
                fresh = fresh && !valid;
                float ls;
                {
#pragma unroll
                    for (int i = 0; i < 16; ++i) { p0[i] = __builtin_amdgcn_exp2f(p0[i]); p1[i] = __builtin_amdgcn_exp2f(p1[i]); }
                    float s8[8];
#pragma unroll
                    for (int i = 0; i < 8; ++i) s8[i] = (p0[i] + p0[i + 8]) + (p1[i] + p1[i + 8]);
                    ls = ((s8[0] + s8[1]) + (s8[2] + s8[3])) + ((s8[4] + s8[5]) + (s8[6] + s8[7]));
                }
                l += valid ? ls : 0.f;
                                u32x4 wq[2][2];
#pragma unroll
                for (int s2 = 0; s2 < 2; ++s2) {
                    wq[0][s2].x = cvtpk_s(p0[8 * s2 + 0], p0[8 * s2 + 1]); wq[0][s2].y = cvtpk_s(p0[8 * s2 + 2], p0[8 * s2 + 3]); wq[0][s2].z = cvtpk_s(p0[8 * s2 + 4], p0[8 * s2 + 5]); wq[0][s2].w = cvtpk_s(p0[8 * s2 + 6], p0[8 * s2 + 7]);
                    wq[1][s2].x = cvtpk_s(p1[8 * s2 + 0], p1[8 * s2 + 1]); wq[1][s2].y = cvtpk_s(p1[8 * s2 + 2], p1[8 * s2 + 3]); wq[1][s2].z = cvtpk_s(p1[8 * s2 + 4], p1[8 * s2 + 5]); wq[1][s2].w = cvtpk_s(p1[8 * s2 + 6], p1[8 * s2 + 7]);
                }
                if (__ballot(!valid) != 0ull) {
                    const unsigned vm = valid ? 0xffffffffu : 0u;
#pragma unroll
                    for (int a2 = 0; a2 < 2; ++a2)
#pragma unroll
                        for (int s2 = 0; s2 < 2; ++s2) { wq[a2][s2].x &= vm; wq[a2][s2].y &= vm; wq[a2][s2].z &= vm; wq[a2][s2].w &= vm; }
                }
#pragma unroll
                for (int s2 = 0; s2 < 2; ++s2) { pbo[0][s2] = __builtin_bit_cast(bf16x8, wq[0][s2]); pbo[1][s2] = __builtin_bit_cast(bf16x8, wq[1][s2]); }
                done = true;
            }
        }
    return done;
}
template <int DVB>
__device__ __forceinline__ void attn_part2(LAS unsigned char* lds, int vbuf, int r, int hi, const bf16x8 (&pb)[2][2], f32x16 (&o)[DVB]) {
    const LAS unsigned char* vb = lds + AT_VOFF + vbuf * AT_VB + r * 144 + hi * 16;
#pragma unroll
    for (int dd = 0; dd < DVB; ++dd)
#pragma unroll
        for (int kg = 0; kg < 2; ++kg)
#pragma unroll
            for (int s2 = 0; s2 < 2; ++s2) {
                const bf16x8 va = *(const LAS bf16x8*)(vb + dd * 32 * 144 + (kg * 32 + s2 * 16) * 2);
                o[dd] = MFMA32(va, pb[kg][s2], o[dd]);
            }
}
#ifndef TSEL
#define TSEL 0
#endif
constexpr int LDS_TACC = 147264;
#define TSTART(k) unsigned long long t_s_ = 0; if (TSEL == (k)) t_s_ = __builtin_amdgcn_s_memrealtime();
#define TSTOP(k) if (TSEL == (k)) { const unsigned long long t_e_ = __builtin_amdgcn_s_memrealtime(); if (otid() == 0) *(LAS unsigned*)(lds + LDS_TACC) += (unsigned)(t_e_ - t_s_); }
template <int DVB>
__device__ __forceinline__ void attn_stage_load(const bf16_t* __restrict__ Kg, int kpitch, const bf16_t* __restrict__ Vg, int vpitch, int jl, int lrow, int lch, u32x4& kreg, u32x4 (&vreg)[DVB / 2]) {
    kreg = *(const u32x4*)(Kg + (size_t)(jl * 64 + lrow) * kpitch + lch * 8);
#pragma unroll
    for (int i = 0; i < DVB / 2; ++i) vreg[i] = *(const u32x4*)(Vg + (size_t)(lrow + 64 * i) * vpitch + jl * 64 + lch * 8);
}
template <int DVB>
__device__ __forceinline__ void attn_stage_write(LAS unsigned char* lds, int nkb, int nvb, int lrow, int lch, const u32x4& kreg, const u32x4 (&vreg)[DVB / 2]) {
    *(LAS u32x4*)(lds + AT_KOFF + nkb * AT_KB + lrow * 144 + lch * 16) = kreg;
#pragma unroll
    for (int i = 0; i < DVB / 2; ++i) { LAS unsigned char* vp = lds + AT_VOFF + nvb * AT_VB + (lrow + 64 * i) * 144 + (lch >> 1) * 32 + (lch & 1) * 8;
        *(LAS u32x2*)vp = (u32x2){vreg[i].x, vreg[i].y}; *(LAS u32x2*)(vp + 16) = (u32x2){vreg[i].z, vreg[i].w}; }
}
template <int DVB, bool DUAL = false>
__device__ __forceinline__ void attn_run(LAS unsigned char* lds, const bf16_t* __restrict__ Kg, int kpitch, const bf16_t* __restrict__ Vg, int vpitch,
                                         u64 tmask, u64 mymask, int klim, int kmin, const bf16x8 (&qf)[4], f32x16 (&o)[DVB], float& m, float& l) {
    const int tid = otid(), lane = tid & 63, r = lane & 31, hi = lane >> 5;
    const int lrow = tid >> 3, lch = tid & 7;
    const bool grpB = __builtin_amdgcn_readfirstlane(tid >> 8) != 0;
    if (tmask == 0ull) return;
    float m_run = 0.f; bool fresh = true; f32x16 negm;
#pragma unroll
    for (int i = 0; i < 16; ++i) negm[i] = 0.f;
    (void)m;
    int j = __builtin_ctzll(tmask); tmask &= tmask - 1ull;
    int jn = -1; if (tmask != 0ull) { jn = __builtin_ctzll(tmask); tmask &= tmask - 1ull; }
    u32x4 kA, vA[DVB / 2], kA2;
    const int kring = (DUAL && grpB) ? AT_K2OFF : AT_KOFF;
    attn_stage_load<DVB>(Kg, kpitch, Vg, vpitch, j, lrow, lch, kA, vA);
    if (DUAL) kA2 = *(const u32x4*)(Kg + (size_t)(j * 64 + lrow) * kpitch + 64 + lch * 8);
    attn_stage_write<DVB>(lds, 0, 0, lrow, lch, kA, vA);
    if (DUAL) *(LAS u32x4*)(lds + AT_K2OFF + lrow * 144 + lch * 16) = kA2;
    __syncthreads();
    int kb = 0, vbc = 0, vbp = 0;
    bool havep = false; bf16x8 pbp[2][2];
#pragma unroll
    for (int a2 = 0; a2 < 2; ++a2)
#pragma unroll
        for (int b2 = 0; b2 < 2; ++b2) pbp[a2][b2] = (bf16x8){0, 0, 0, 0, 0, 0, 0, 0};
    for (;;) {
        { TSTART(1) attn_stage_load<DVB>(Kg, kpitch, Vg, vpitch, jn >= 0 ? jn : j, lrow, lch, kA, vA);
          if (DUAL) kA2 = *(const u32x4*)(Kg + (size_t)((jn >= 0 ? jn : j) * 64 + lrow) * kpitch + 64 + lch * 8); TSTOP(1) }
        { TSTART(2)
        if (grpB && havep) attn_part2<DVB>(lds, vbp, r, hi, pbp, o);
        havep = attn_part1<DVB>(lds, j, kb, mymask, klim, kmin, r, hi, qf, o, l, m_run, fresh, negm, pbp, kring);
        vbp = vbc;
        if (!grpB && havep) attn_part2<DVB>(lds, vbc, r, hi, pbp, o);
        TSTOP(2) }
        const int vbn = (vbc == 2) ? 0 : vbc + 1;
        { TSTART(3) if (jn >= 0) { attn_stage_write<DVB>(lds, kb ^ 1, vbn, lrow, lch, kA, vA); if (DUAL) *(LAS u32x4*)(lds + AT_K2OFF + (kb ^ 1) * AT_KB + lrow * 144 + lch * 16) = kA2; } TSTOP(3) }
        { TSTART(4) __syncthreads(); TSTOP(4) }
        if (jn < 0) break;
        j = jn; kb ^= 1; vbc = vbn;
        jn = -1; if (tmask != 0ull) { jn = __builtin_ctzll(tmask); tmask &= tmask - 1ull; }
    }
    if (grpB && havep) attn_part2<DVB>(lds, vbp, r, hi, pbp, o);
    __syncthreads();
}
__device__ __forceinline__ u64 tile_range_mask(int lo, int hi) {
    const u64 up = (hi >= 63) ? ~0ull : ((1ull << (hi + 1)) - 1ull);
    return up & ~((1ull << lo) - 1ull);
}

__device__ __forceinline__ void ph_moba_kmean(const Params& p, LAS unsigned char* lds, int bx, int G) {
    const int tid = otid(), lane = tid & 63, w = tid >> 6;
    const bf16_t* P = (const bf16_t*)(p.ws + WS_P); float* kmean = (float*)(p.ws + WS_KMEAN);
    LAS float* red = (LAS float*)lds;
    for (int it = bx; it < NB * 8 * 16; it += G) {
        const int blk = it & 15, h = (it >> 4) & 7, b = it >> 7;
        const bf16_t* kp = P + (size_t)(b * SEQ + blk * 256 + w * 32) * PW + 512 + h * 64 + lane;
        float s = 0.f;
#pragma unroll 32
        for (int i = 0; i < 32; ++i) s += bf2f(kp[(size_t)i * PW]);
        red[w * 64 + lane] = s;
        __syncthreads();
        if (w == 0) { float t = 0.f;
#pragma unroll
            for (int i = 0; i < 8; ++i) t += red[i * 64 + lane];
            kmean[((b * 8 + h) * 16 + blk) * 64 + lane] = t * (1.f / 256.f); }
        __syncthreads();
    }
}
__device__ __forceinline__ void ph_attn_even(const Params& p, LAS unsigned char* lds, int lyr, int bx, int G) {
    const int tid = otid(), lane = tid & 63, w = tid >> 6, r = lane & 31, hi = lane >> 5;
    const bf16_t* P = (const bf16_t*)(p.ws + WS_P); const bf16_t* VT = (const bf16_t*)(p.ws + WS_VT);
    const float* kmean = (const float*)(p.ws + WS_KMEAN);
    bf16_t* O = (bf16_t*)(p.ws + WS_O);
    LAS float* kml = (LAS float*)(lds + AT_KM);
    for (int c = bx; c < 256; c += G) {
        const int bh = c & 31, qtp = c >> 5;
#pragma unroll 1
        for (int uu = 0; uu < 4; ++uu) {
            const int kind = uu >> 1, qt = (uu & 1) ? (15 - qtp) : qtp;
            const int b = bh >> 3, hh = bh & 7;
            const int qpos = qt * 256 + w * 32 + r;
            const size_t tok = (size_t)b * SEQ + qpos;
            if (kind == 0) {
                const bf16_t* qp = P + tok * PW + hh * 64 + hi * 8;
                bf16x8 qf[4];
#pragma unroll
                for (int ks = 0; ks < 4; ++ks) qf[ks] = *(const bf16x8*)(qp + ks * 16);
                __syncthreads();
                for (int i = tid; i < 1024; i += NTHR) kml[i] = kmean[(size_t)(b * 8 + hh) * 1024 + i] * (1.f / 256.f);
                __syncthreads();
                const int own = qt;
                float g0 = NEGBIG, g1 = NEGBIG, g2 = NEGBIG; int i0 = -1, i1 = -1, i2 = -1;
                for (int blk = 0; blk < own; ++blk) {
                    float s = 0.f;
#pragma unroll
                    for (int ks = 0; ks < 4; ++ks)
#pragma unroll
                        for (int e = 0; e < 8; ++e) s += bf2f((bf16_t)qf[ks][e]) * kml[blk * 64 + ks * 16 + hi * 8 + e];
                    s += xchg32(s, lane);
                    if (s > g0) { g2 = g1; i2 = i1; g1 = g0; i1 = i0; g0 = s; i0 = blk; }
                    else if (s > g1) { g2 = g1; i2 = i1; g1 = s; i1 = blk; }
                    else if (s > g2) { g2 = s; i2 = blk; }
                }
                u64 mk = 0xFull << (4 * own);
                if (i0 >= 0) mk |= 0xFull << (4 * i0);
                if (i1 >= 0) mk |= 0xFull << (4 * i1);
                if (i2 >= 0) mk |= 0xFull << (4 * i2);
                f32x16 o[2];
#pragma unroll
                for (int d = 0; d < 2; ++d)
#pragma unroll
                    for (int i = 0; i < 16; ++i) o[d][i] = 0.f;
                float m = NEGBIG, l = 0.f;
                attn_run<2>(lds, P + (size_t)b * SEQ * PW + 512 + hh * 64, PW, VT + (size_t)(hh * 64) * NT + (size_t)b * SEQ, NT,
                            tile_range_mask(0, 4 * qt + 3), mk, qpos, 0, qf, o, m, l);
                l += __shfl_xor(l, 32);
                const float il = l > 0.f ? 1.f / l : 0.f;
                bf16_t* op = O + tok * 1024 + hh * 64 + 4 * hi;
#pragma unroll
                for (int d = 0; d < 2; ++d)
#pragma unroll
                    for (int cc = 0; cc < 4; ++cc) {
                        u32x2 wv; wv.x = cvtpk_s(o[d][4 * cc] * il, o[d][4 * cc + 1] * il); wv.y = cvtpk_s(o[d][4 * cc + 2] * il, o[d][4 * cc + 3] * il);
                        *(u32x2*)(op + 32 * d + 8 * cc) = wv;
                    }
            } else {
                const int bh16 = c & 15, jq = c >> 4, qt2 = (uu & 1) ? (31 - jq) : jq;
                const int b2 = bh16 >> 2, head = bh16 & 3, map = w >> 2;
                const int qpos2 = qt2 * 128 + (w & 3) * 32 + r;
                const size_t tok2 = (size_t)b2 * SEQ + qpos2;
                const bf16_t* qp = P + tok2 * PW + 1024 + (head * 2 + map) * 64 + hi * 8;
                bf16x8 qf[4];
#pragma unroll
                for (int ks = 0; ks < 4; ++ks) qf[ks] = *(const bf16x8*)(qp + ks * 16);
                f32x16 o[4];
#pragma unroll
                for (int d = 0; d < 4; ++d)
#pragma unroll
                    for (int i = 0; i < 16; ++i) o[d][i] = 0.f;
                float m = NEGBIG, l = 0.f;
                attn_run<4, true>(lds, P + (size_t)b2 * SEQ * PW + 1536 + head * 128, PW, VT + (size_t)(512 + head * 128) * NT + (size_t)b2 * SEQ, NT,
                                  tile_range_mask(0, 2 * qt2 + 1), ~0ull, qpos2, 0, qf, o, m, l);
                l += __shfl_xor(l, 32);
                const float il = l > 0.f ? 1.f / l : 0.f;
                LAS float* xb = (LAS float*)lds + (w & 3) * 4096 + r;
                if (map == 1) {
#pragma unroll
                    for (int d = 0; d < 4; ++d)
#pragma unroll
                        for (int i = 0; i < 16; ++i) xb[(32 * d + (i & 3) + 8 * (i >> 2) + 4 * hi) * 32] = o[d][i] * il;
                }
                __syncthreads();
                if (map == 0) {
                    const int li = lyr >> 1;
                    const float lam = ((const float*)(p.ws + WS_MISC))[li], linit = li == 0 ? LINIT0 : LINIT1;
                    float ss = 0.f;
#pragma unroll
                    for (int d = 0; d < 4; ++d)
#pragma unroll
                        for (int i = 0; i < 16; ++i) { const float v = o[d][i] * il - lam * xb[(32 * d + (i & 3) + 8 * (i >> 2) + 4 * hi) * 32]; o[d][i] = v; ss += v * v; }
                    ss += __shfl_xor(ss, 32);
                    const float rs = rsqrtf(ss * (1.f / 128.f) + 1e-6f) * (1.f - linit);
                    const float* subg = p.in[10] + li * 128 + 4 * hi;
                    bf16_t* op = O + tok2 * 1024 + 512 + head * 128 + 4 * hi;
#pragma unroll
                    for (int d = 0; d < 4; ++d)
#pragma unroll
                        for (int cc = 0; cc < 4; ++cc) {
                            const f32x4 sg = *(const f32x4*)(subg + 32 * d + 8 * cc);
                            u32x2 wv; wv.x = cvtpk_s(o[d][4 * cc] * rs * sg[0], o[d][4 * cc + 1] * rs * sg[1]); wv.y = cvtpk_s(o[d][4 * cc + 2] * rs * sg[2], o[d][4 * cc + 3] * rs * sg[3]);
                            *(u32x2*)(op + 32 * d + 8 * cc) = wv;
                        }
                }
                __syncthreads();
            }
        }
    }
}

__device__ __forceinline__ void ph_misc(const Params& p, LAS unsigned char* lds, int bx, int G) {
    const int tid = otid();
    float* misc = (float*)(p.ws + WS_MISC); float* fold = (float*)(p.ws + WS_FOLD);
    if (bx == 0 && tid < 64) {
        for (int i = 0; i < 2; ++i) { const float* lp = p.in[9] + i * 256;
            const float s1 = wave_sum(lp[tid] * lp[64 + tid]), s2 = wave_sum(lp[128 + tid] * lp[192 + tid]);
            if (tid == 0) misc[i] = expf(s1) - expf(s2) + (i == 0 ? LINIT0 : LINIT1); }
    }
    {
        LAS float* red = (LAS float*)lds;
        for (int it = bx; it < 64; it += G) {
            const int lb = it >> 4, f = (it & 15) * 16 + (tid & 15), ch = tid >> 4;
            const float* pos = p.in[13] + (size_t)lb * 2048 + ch * 64; const float* w1 = p.in[14] + (size_t)lb * 2048 * 256 + (size_t)(ch * 64) * 256 + f;
            float s0 = 0.f;
#pragma unroll 16
            for (int i = 0; i < 64; ++i) s0 += pos[i] * w1[(size_t)i * 256];
            red[tid] = s0;
            __syncthreads();
            if (tid < 16) { float t = p.in[15][lb * 256 + f]; for (int k = 0; k < 32; ++k) t += red[k * 16 + tid]; fold[lb * 256 + f] = t; }
            __syncthreads();
        }
    }
}
__device__ __forceinline__ void ph_compress2(const Params& p, LAS unsigned char* lds, int l, int bx, int G) {
    const int tid = otid(), lane = tid & 63, w = tid >> 6, li = l >> 1;
    const float* CHP = (const float*)(p.ws + WS_DT); bf16_t* KCMP = (bf16_t*)(p.ws + WS_KCMP); bf16_t* VCX = (bf16_t*)(p.ws + WS_VCX);
    LAS float* w2s = (LAS float*)lds;
    const int ipb = 8192 / G, it0 = bx * ipb, br = it0 >> 12;
    {
        const float* w2 = p.in[16] + (size_t)(li * 2 + br) * 256 * 64;
        for (int i = tid; i < 4096; i += NTHR) ((LAS f32x4*)w2s)[i] = *(const f32x4*)(w2 + i * 4);
    }
    __syncthreads();
    const float bias = p.in[17][(li * 2 + br) * 64 + lane];
    const f32x4 foldv = *(const f32x4*)((const float*)(p.ws + WS_FOLD) + li * 512 + br * 256 + lane * 4);
    LAS float* hrow4 = (LAS float*)(lds + 65536) + w * 1024;
    for (int k0 = w; k0 < ipb; k0 += 4 * NWAVES) {
#pragma unroll
        for (int q = 0; q < 4; ++q) { const int it = it0 + ((k0 + q * NWAVES < ipb) ? k0 + q * NWAVES : k0);
            const f32x4 pa = *(const f32x4*)(CHP + (size_t)it * 256 + lane * 4), pb = *(const f32x4*)(CHP + ((size_t)8192 + it) * 256 + lane * 4);
            const f32x4 hs = pa + pb + foldv;
            *(LAS f32x4*)(hrow4 + q * 256 + lane * 4) = (f32x4){gelu_tanh_fast(hs[0]), gelu_tanh_fast(hs[1]), gelu_tanh_fast(hs[2]), gelu_tanh_fast(hs[3])}; }
        asm volatile("s_waitcnt lgkmcnt(0)" ::: "memory");
        float s[4][4];
#pragma unroll
        for (int q = 0; q < 4; ++q)
#pragma unroll
            for (int j = 0; j < 4; ++j) s[q][j] = 0.f;
#pragma unroll 4
        for (int f = 0; f < 256; f += 4) {
            const float w0 = w2s[(f + 0) * 64 + lane], w1 = w2s[(f + 1) * 64 + lane], w2v = w2s[(f + 2) * 64 + lane], w3 = w2s[(f + 3) * 64 + lane];
#pragma unroll
            for (int q = 0; q < 4; ++q) { const f32x4 h4 = *(const LAS f32x4*)(hrow4 + q * 256 + f);
                s[q][0] += h4[0] * w0; s[q][1] += h4[1] * w1; s[q][2] += h4[2] * w2v; s[q][3] += h4[3] * w3; }
        }
#pragma unroll
        for (int q = 0; q < 4; ++q) { const int it = it0 + ((k0 + q * NWAVES < ipb) ? k0 + q * NWAVES : k0), r = it & 1023, g = (it >> 10) & 3, b = r >> 8, n = r & 255;
            float sum = (s[q][0] + s[q][1]) + (s[q][2] + s[q][3]) + bias;
            if (n == 255) sum = 0.f;
            if (br == 0) KCMP[((size_t)(b * 4 + g) * 256 + n) * 64 + lane] = f2bf(sum);
            else VCX[((size_t)(b * 4 + g) * 128 + lane) * 256 + n] = f2bf(sum); }
        asm volatile("s_waitcnt lgkmcnt(0)" ::: "memory");
    }
    int gstride = G * NTHR; asm volatile("" : "+s"(gstride));
    for (int i = bx * NTHR + tid; i < 16 * 64 * 256; i += gstride) {
        const int n = i & 255, j = (i >> 8) & 63, bg = i >> 14;
        const bool ov = (n < 255) && (n >= 4 * j - 1) && (n <= 4 * j + 3);
        VCX[((size_t)bg * 128 + 64 + j) * 256 + n] = ov ? (bf16_t)0x3F80 : (bf16_t)0;
    }
    __syncthreads();
}
__device__ __forceinline__ void ph_attn_odd(const Params& p, LAS unsigned char* lds, int bx, int G) {
    const int tid = otid(), lane = tid & 63, w = tid >> 6, r = lane & 31, hi = lane >> 5;
    const bf16_t* P = (const bf16_t*)(p.ws + WS_P); const bf16_t* VT = (const bf16_t*)(p.ws + WS_VT);
    const bf16_t* KCMP = (const bf16_t*)(p.ws + WS_KCMP); const bf16_t* VCX = (const bf16_t*)(p.ws + WS_VCX);
    bf16_t* O = (bf16_t*)(p.ws + WS_O);
    LAS float* imp = (LAS float*)(lds + AT_IMP);
    LAS u64* mks = (LAS u64*)(lds + AT_MASK);
    LAS u64* red = (LAS u64*)(lds + AT_RED);
    for (int c = bx; c < 256; c += G) {
        const int bg = c & 15, qp = c >> 4, b = bg >> 2, g = bg & 3;
#pragma unroll 1
        for (int uu = 0; uu < 4; ++uu) {
            const int qt = uu == 0 ? qp : (uu == 1 ? 31 - qp : (uu == 2 ? 32 + qp : 63 - qp));
            const int head = 4 * g + (w >> 1), qloc = (w & 1) * 32 + r, qpos = qt * 64 + qloc;
            const size_t tok = (size_t)b * SEQ + qpos;
            const bf16_t* qptr = P + tok * PW + head * 64 + hi * 8;
            bf16x8 qf[4];
#pragma unroll
            for (int ks = 0; ks < 4; ++ks) qf[ks] = *(const bf16x8*)(qptr + ks * 16);
            float gt[3];
#pragma unroll
            for (int j = 0; j < 3; ++j) { const float gl = bf2f(VT[(size_t)(512 + head * 3 + j) * NT + tok]); gt[j] = 1.f / (1.f + __expf(-gl)); }
            f32x16 acc[2];
            {
                f32x16 o4[4];
#pragma unroll
                for (int d = 0; d < 4; ++d)
#pragma unroll
                    for (int i = 0; i < 16; ++i) o4[d][i] = 0.f;
                float m = NEGBIG, l = 0.f;
                const int klim = qpos >= 31 ? ((qpos - 31) >> 4) : -1;
                attn_run<4>(lds, KCMP + (size_t)bg * 256 * 64, 64, VCX + (size_t)bg * 128 * 256, 256, tile_range_mask(0, (4 * qt + 2) >> 6), ~0ull, klim, 0, qf, o4, m, l);
                l += __shfl_xor(l, 32);
                const float il = l > 0.f ? 1.f / l : 0.f;
#pragma unroll
                for (int d = 0; d < 2; ++d) acc[d] = o4[d] * (gt[0] * il);
                LAS float* ip = imp + ((w >> 1) * 64 + qloc) * 65 + 4 * hi;
#pragma unroll
                for (int d = 0; d < 2; ++d)
#pragma unroll
                    for (int i = 0; i < 16; ++i) ip[32 * d + (i & 3) + 8 * (i >> 2)] = o4[2 + d][i] * il;
            }
            __syncthreads();
            {
                const int q = tid >> 3, pt = tid & 7, own = qt;
                LAS float* iq = imp + q * 65;
                unsigned vj[8];
#pragma unroll
                for (int k = 0; k < 8; ++k) { const int j = pt * 8 + k;
                    float v = (iq[j] + iq[64 * 65 + j]) + (iq[2 * 64 * 65 + j] + iq[3 * 64 * 65 + j]);
                    if (j == 0 || j == own || j == own - 1) v = 1e6f;
                    vj[k] = (j > own) ? 0u : ((__float_as_uint(fmaxf(v, 0.f)) & ~63u) | (unsigned)(63 - j)); }
                __syncthreads();
                LAS unsigned* iqu = (LAS unsigned*)iq;
#pragma unroll
                for (int k = 0; k < 8; ++k) iqu[pt * 8 + k] = vj[k];
                __syncthreads();
                int cnt[8];
#pragma unroll
                for (int k = 0; k < 8; ++k) cnt[k] = 0;
#pragma unroll 4
                for (int jj = 0; jj <= own; ++jj) { const unsigned u = iqu[jj];
#pragma unroll
                    for (int k = 0; k < 8; ++k) cnt[k] += (u > vj[k]) ? 1 : 0; }
                unsigned bits = 0u;
#pragma unroll
                for (int k = 0; k < 8; ++k) bits |= (cnt[k] < 16) ? (1u << k) : 0u;
                unsigned lo = (pt < 4) ? (bits << (8 * pt)) : 0u, hh = (pt >= 4) ? (bits << (8 * (pt - 4))) : 0u;
#pragma unroll
                for (int off = 1; off <= 4; off <<= 1) { lo |= __shfl_xor(lo, off); hh |= __shfl_xor(hh, off); }
                if (pt == 0) mks[q] = ((u64)hh << 32) | lo;
#pragma unroll
                for (int off = 8; off <= 32; off <<= 1) { lo |= __shfl_xor(lo, off); hh |= __shfl_xor(hh, off); }
                if (lane == 0) red[1 + w] = ((u64)hh << 32) | lo;
            }
            __syncthreads();
            u64 tall = 0ull;
#pragma unroll
            for (int k = 0; k < 8; ++k) tall |= red[1 + k];
            const u64 mymask = mks[qloc];
            const u64 tm_sel = tall & tile_range_mask(0, qt);
#pragma unroll 1
            for (int br = 0; br < 2; ++br) {
                f32x16 o2[2];
#pragma unroll
                for (int d = 0; d < 2; ++d)
#pragma unroll
                    for (int i = 0; i < 16; ++i) o2[d][i] = 0.f;
                float m = NEGBIG, l = 0.f;
                const bf16_t* Kg = P + (size_t)b * SEQ * PW + (br == 0 ? 1280 : 1536) + g * 64;
                const bf16_t* Vg = VT + (size_t)((br == 0 ? 0 : 256) + g * 64) * NT + (size_t)b * SEQ;
                const u64 tm = br == 0 ? tm_sel : tile_range_mask(qt >= 8 ? qt - 8 : 0, qt);
                attn_run<2>(lds, Kg, PW, Vg, NT, tm, br == 0 ? mymask : ~0ull, qpos, br == 0 ? 0 : qpos - 511, qf, o2, m, l);
                l += __shfl_xor(l, 32);
                const float sc = (l > 0.f ? 1.f / l : 0.f) * (br == 0 ? gt[1] : gt[2]);
#pragma unroll
                for (int d = 0; d < 2; ++d) acc[d] = acc[d] + o2[d] * sc;
            }
            bf16_t* op = O + tok * 1024 + head * 64 + 4 * hi;
#pragma unroll
            for (int d = 0; d < 2; ++d)
#pragma unroll
                for (int cc = 0; cc < 4; ++cc) {
                    u32x2 wv; wv.x = cvtpk_s(acc[d][4 * cc], acc[d][4 * cc + 1]); wv.y = cvtpk_s(acc[d][4 * cc + 2], acc[d][4 * cc + 3]);
                    *(u32x2*)(op + 32 * d + 8 * cc) = wv;
                }
        }
    }
}


__device__ __forceinline__ float red4(const f32x4& a, int lane) {
    const bool h5 = (lane & 32) != 0, h4 = (lane & 16) != 0;
    float k0 = h5 ? a[2] : a[0], k1 = h5 ? a[3] : a[1]; const float s0 = h5 ? a[0] : a[2], s1 = h5 ? a[1] : a[3];
    k0 += xchg32(s0, lane); k1 += xchg32(s1, lane);
    float k = h4 ? k1 : k0; const float s = h4 ? k0 : k1;
    k += xchg16(s, lane);
    return row_sum16(k);
}
template <int MODE>
__device__ __forceinline__ void ph_norm(const Params& p, LAS unsigned char* lds, int l, int bx, int G) {
    const int tid = otid(), lane = tid & 63, w = tid >> 6;
    LAS f32x4* rw = (LAS f32x4*)lds;
    LAS int* ent = (LAS int*)(lds + 81920);
    const int TPB = NT / G;
    bf16_t* X = (bf16_t*)(p.ws + WS_X); bf16_t* H = (bf16_t*)(p.ws + WS_H);
    const float* mod = (const float*)(p.ws + WS_MOD);
    const bf16_t* Y = (const bf16_t*)(p.ws + WS_Y); const int* POS = (const int*)(p.ws + WS_POS);
    int* tok_e = (int*)(p.ws + WS_ROUTE); float* tok_w = (float*)(p.ws + WS_ROUTE + 131072); int* tok_rank = (int*)(p.ws + WS_ROUTE + 262144);
    const bool comb = (MODE == 2) || (MODE == 0 && l > 0);
    const int lc = (MODE == 2) ? DEPTH - 1 : l - 1;
    const bool xf32 = (MODE == 0 && l == 0);
    const float* xin = p.in[0];
    const float* gsrc = (MODE == 0) ? p.in[2] + l * DM : (MODE == 1 ? p.in[3] + l * DM : p.in[4]);
    const int scc = (MODE == 0) ? 1 : 4, shc = (MODE == 0) ? 0 : 3;
    const int nit = TPB / NWAVES, tbase = bx * TPB + w * nit, b = (bx * TPB) / SEQ;
    f32x4 gv[4], scv[4], shv[4], g2v[4];
#pragma unroll
    for (int i = 0; i < 4; ++i) {
        const int idx = i * 256 + lane * 4;
        gv[i] = *(const f32x4*)(gsrc + idx);
        if (MODE != 2) { scv[i] = *(const f32x4*)(mod + (size_t)(l * 4 + b) * 6144 + scc * 1024 + idx) + 1.f; shv[i] = *(const f32x4*)(mod + (size_t)(l * 4 + b) * 6144 + shc * 1024 + idx); }
        if (comb) g2v[i] = *(const f32x4*)(mod + (size_t)(lc * 4 + b) * 6144 + 5 * 1024 + idx);
    }
    u32x4 xn[4]; u32x2 yan[4], ybn[4];
#pragma unroll
    for (int i = 0; i < 4; ++i) { const int idx = i * 256 + lane * 4;
        if (xf32) xn[i] = *(const u32x4*)(xin + (size_t)tbase * DM + idx); else { const u32x2 t2 = *(const u32x2*)(X + (size_t)tbase * DM + idx); xn[i].x = t2.x; xn[i].y = t2.y; } }
    int te_ = 0, tr_ = 0;
    if (comb) { const int it = tbase * 2 + (lane < nit * 2 ? lane : 0); te_ = tok_e[it]; tr_ = tok_rank[it]; }
    if (MODE == 1) {
        const float* wg = p.in[18] + (size_t)l * 1024 * 4; const float* we = p.in[20] + (size_t)l * 1024 * 16;
        for (int s = tid; s < 16 * 5 * 64; s += NTHR) {
            const int ln = s & 63, r = s >> 6, q = r % 5, ie = r / 5, idx = (ie >> 2) * 256 + ln * 4 + (ie & 3);
            rw[s] = (q == 0) ? *(const f32x4*)(wg + idx * 4) : *(const f32x4*)(we + idx * 16 + (q - 1) * 4);
        }
        if (tid < 16) ((LAS float*)(lds + 83456))[tid] = p.in[21][l * 16 + tid];
        __syncthreads();
    }
    int posv = 0;
    if (comb) {
        LAS int* bpart = (LAS int*)lds;
        const int* bcnt = (const int*)(p.ws + WS_BCNT);
        { const int e = tid & 15, pr = tid >> 4; int tot = 0, prb = 0;
#pragma unroll
          for (int k = 0; k < 8; ++k) { const int bb = pr * 8 + k; const int c = bcnt[bb * 16 + e]; tot += c; prb += (bb < bx) ? c : 0; }
          bpart[pr * 16 + e] = tot; bpart[512 + pr * 16 + e] = prb; }
        __syncthreads();
        if (tid < 16) { int tot = 0, prb = 0; for (int k = 0; k < 32; ++k) { tot += bpart[k * 16 + tid]; prb += bpart[512 + k * 16 + tid]; } bpart[1040 + tid] = tot; bpart[1056 + tid] = prb; }
        __syncthreads();
        if (tid == 0) { int off = 0; for (int e = 0; e < 16; ++e) { bpart[1024 + e] = off + bpart[1056 + e]; off += (bpart[1040 + e] + 255) & ~255; } }
        __syncthreads();
        posv = bpart[1024 + te_] + tr_;
        __syncthreads();
    }
    {
        const int p0 = comb ? __builtin_amdgcn_readlane(posv, 0) : 0, p1 = comb ? __builtin_amdgcn_readlane(posv, 1) : 0;
#pragma unroll
        for (int i = 0; i < 4; ++i) { const int idx = i * 256 + lane * 4;
            if (comb) { yan[i] = *(const u32x2*)(Y + (size_t)p0 * DM + idx); ybn[i] = *(const u32x2*)(Y + (size_t)p1 * DM + idx); } }
    }
    float bgv[4] = {0.f, 0.f, 0.f, 0.f};
    f32x4 wgr[16];
    if (MODE == 1) {
#pragma unroll
        for (int i = 0; i < 16; ++i) wgr[i] = rw[(i * 5) * 64 + lane];
#pragma unroll
        for (int j = 0; j < 4; ++j) bgv[j] = p.in[19][l * 4 + j];
    }
    for (int itn = 0; itn < nit; ++itn) {
        const int t = tbase + itn;
        f32x4 xv[4]; u32x2 ya[4], yb[4];
#pragma unroll
        for (int i = 0; i < 4; ++i) {
            if (xf32) { xv[i][0] = __uint_as_float(xn[i].x); xv[i][1] = __uint_as_float(xn[i].y); xv[i][2] = __uint_as_float(xn[i].z); xv[i][3] = __uint_as_float(xn[i].w); }
            else { xv[i][0] = __uint_as_float(xn[i].x << 16); xv[i][1] = __uint_as_float(xn[i].x & 0xffff0000u); xv[i][2] = __uint_as_float(xn[i].y << 16); xv[i][3] = __uint_as_float(xn[i].y & 0xffff0000u); }
            if (comb) { ya[i] = yan[i]; yb[i] = ybn[i]; } }
        {
            const int nx = (itn + 1 < nit) ? itn + 1 : itn;
            const int p0 = comb ? __builtin_amdgcn_readlane(posv, 2 * nx) : 0, p1 = comb ? __builtin_amdgcn_readlane(posv, 2 * nx + 1) : 0;
#pragma unroll
            for (int i = 0; i < 4; ++i) { const int idx = i * 256 + lane * 4;
                if (xf32) xn[i] = *(const u32x4*)(xin + (size_t)(tbase + nx) * DM + idx); else { const u32x2 t2 = *(const u32x2*)(X + (size_t)(tbase + nx) * DM + idx); xn[i].x = t2.x; xn[i].y = t2.y; }
                if (comb) { yan[i] = *(const u32x2*)(Y + (size_t)p0 * DM + idx); ybn[i] = *(const u32x2*)(Y + (size_t)p1 * DM + idx); } }
        }
        float ss = 0.f;
#pragma unroll
        for (int i = 0; i < 4; ++i) {
            const int idx = i * 256 + lane * 4;
            if (comb) {
                f32x4 ys; ys[0] = bf2f((bf16_t)(ya[i].x & 0xffff)) + bf2f((bf16_t)(yb[i].x & 0xffff)); ys[1] = bf2f((bf16_t)(ya[i].x >> 16)) + bf2f((bf16_t)(yb[i].x >> 16));
                ys[2] = bf2f((bf16_t)(ya[i].y & 0xffff)) + bf2f((bf16_t)(yb[i].y & 0xffff)); ys[3] = bf2f((bf16_t)(ya[i].y >> 16)) + bf2f((bf16_t)(yb[i].y >> 16));
                xv[i] = xv[i] + g2v[i] * ys;
                if (MODE == 0) { u32x2 xo; xo.x = cvt_pk_bf16(xv[i][0], xv[i][1]); xo.y = cvt_pk_bf16(xv[i][2], xv[i][3]); *(u32x2*)(X + (size_t)t * DM + idx) = xo; }
            }
            ss += xv[i][0] * xv[i][0] + xv[i][1] * xv[i][1] + xv[i][2] * xv[i][2] + xv[i][3] * xv[i][3];
        }
        ss = wave_sum(ss);
        const float rs = rsqrtf(ss * (1.f / DM) + 1e-6f);
        float hv[4][4];
#pragma unroll
        for (int i = 0; i < 4; ++i) {
            const int idx = i * 256 + lane * 4;
            f32x4 y = xv[i] * rs * gv[i];
            if (MODE == 2) { *(f32x4*)(p.out + (size_t)t * DM + idx) = y; }
            else {
                y = y * scv[i] + shv[i];
                hv[i][0] = y[0]; hv[i][1] = y[1]; hv[i][2] = y[2]; hv[i][3] = y[3];
                u32x2 o; o.x = pk2(y[0], y[1]); o.y = pk2(y[2], y[3]);
                if (MODE == 0) asm volatile("global_store_dwordx2 %0, %1, off sc0 sc1" :: "v"(H + (size_t)t * DM + idx), "v"(o) : "memory");
                else *(u32x2*)(H + (size_t)t * DM + idx) = o;
            }
        }
        if (MODE == 1) {
            f32x4 ag = {0.f, 0.f, 0.f, 0.f};
#pragma unroll
            for (int i = 0; i < 4; ++i)
#pragma unroll
                for (int e = 0; e < 4; ++e) ag = ag + wgr[i * 4 + e] * hv[i][e];
            const float rg = red4(ag, lane);
            f32x4 gl4; gl4[0] = __uint_as_float(__builtin_amdgcn_readlane(__float_as_uint(rg), 0)) + bgv[0]; gl4[1] = __uint_as_float(__builtin_amdgcn_readlane(__float_as_uint(rg), 16)) + bgv[1]; gl4[2] = __uint_as_float(__builtin_amdgcn_readlane(__float_as_uint(rg), 32)) + bgv[2]; gl4[3] = __uint_as_float(__builtin_amdgcn_readlane(__float_as_uint(rg), 48)) + bgv[3];
            int gs = 0; { float gm = gl4[0];
#pragma unroll
                for (int j = 1; j < 4; ++j) if (gl4[j] > gm) { gm = gl4[j]; gs = j; } }
            gs = __builtin_amdgcn_readfirstlane(gs);
            f32x4 ae = {0.f, 0.f, 0.f, 0.f};
            const LAS f32x4* rwe = rw + (1 + gs) * 64 + lane;
#pragma unroll
            for (int i = 0; i < 4; ++i)
#pragma unroll
                for (int e = 0; e < 4; ++e) { const f32x4 w4 = rwe[((i * 4 + e) * 5) * 64]; ae = ae + w4 * hv[i][e]; }
            const float re = red4(ae, lane);
            f32x4 el4; el4[0] = __uint_as_float(__builtin_amdgcn_readlane(__float_as_uint(re), 0)); el4[1] = __uint_as_float(__builtin_amdgcn_readlane(__float_as_uint(re), 16)); el4[2] = __uint_as_float(__builtin_amdgcn_readlane(__float_as_uint(re), 32)); el4[3] = __uint_as_float(__builtin_amdgcn_readlane(__float_as_uint(re), 48));
            LAS float* lres = (LAS float*)(lds + 83968) + w * 256 + itn * 32;
            if (lane == 0) { *(LAS f32x4*)lres = gl4; *(LAS f32x4*)(lres + 4) = el4; }
        }
    }
    if (MODE == 0 && G == 256) {
        asm volatile("s_waitcnt vmcnt(0)" ::: "memory"); __syncthreads();
        if (tid == 0) (void)xb_add((unsigned*)(p.ws + WS_CTL) + CW_RDH + l * 64 + (bx >> 2), 1u);
    }
    if (MODE == 1) {
        asm volatile("s_waitcnt lgkmcnt(0)" ::: "memory");
        if (lane < nit) {
            const int t = tbase + lane;
            const LAS float* lr = (const LAS float*)(lds + 83968) + w * 256 + lane * 32;
            float gl[4];
#pragma unroll
            for (int j = 0; j < 4; ++j) gl[j] = lr[j];
            int gs = 0; float gm = gl[0];
#pragma unroll
            for (int j = 1; j < 4; ++j) if (gl[j] > gm) { gm = gl[j]; gs = j; }
            float den = 0.f;
#pragma unroll
            for (int j = 0; j < 4; ++j) den += expf(gl[j] - gm);
            const float gw = 1.f / den;
            float el[4];
            { const LAS float* bl = (const LAS float*)(lds + 83456) + gs * 4;
#pragma unroll
              for (int j = 0; j < 4; ++j) el[j] = lr[4 + j] + bl[j]; }
            int i1 = 0; float v1 = el[0];
#pragma unroll
            for (int j = 1; j < 4; ++j) if (el[j] > v1) { v1 = el[j]; i1 = j; }
            int i2 = -1; float v2 = -3.0e38f;
#pragma unroll
            for (int j = 0; j < 4; ++j) if (j != i1 && el[j] > v2) { v2 = el[j]; i2 = j; }
            const float t1 = 1.f / (1.f + expf(v2 - v1)), t2 = 1.f - t1;
            const int e1 = gs * 4 + i1, e2 = gs * 4 + i2;
            tok_e[t * 2] = e1; tok_e[t * 2 + 1] = e2; tok_w[t * 2] = gw * t1; tok_w[t * 2 + 1] = gw * t2;
            const int lt = t - bx * TPB; ent[lt * 2] = e1; ent[lt * 2 + 1] = e2;
            LAS float* entw = (LAS float*)(lds + 82432); entw[lt * 2] = gw * t1; entw[lt * 2 + 1] = gw * t2;
        }
        __syncthreads();
        const int NE = TPB * 2;
        if (NE == 128) {
            LAS int* wc = (LAS int*)(lds + 83200);
            int e = 0, rk = 0, cw = 0;
            if (tid < 128) {
                e = ent[tid]; u64 mym = 0ull;
#pragma unroll
                for (int x = 0; x < 16; ++x) { const u64 mx = __ballot(e == x); mym = (e == x) ? mx : mym; cw = (lane == x) ? __popcll(mx) : cw; }
                rk = (int)__builtin_amdgcn_mbcnt_hi((unsigned)(mym >> 32), __builtin_amdgcn_mbcnt_lo((unsigned)mym, 0u));
                if (tid < 16) wc[tid] = cw;
            }
            __syncthreads();
            if (tid < 128) {
                if (tid >= 64) rk += wc[e];
                tok_rank[bx * NE + tid] = rk;
                const size_t li_ = (size_t)(bx * 16 + e) * 128 + rk; ((int*)(p.ws + WS_BLTOK))[li_] = (bx * NE + tid) >> 1; ((float*)(p.ws + WS_BLW))[li_] = ((LAS float*)(lds + 82432))[tid];
                if (tid >= 64 && tid < 80) ((int*)(p.ws + WS_BCNT))[bx * 16 + tid - 64] = wc[tid - 64] + cw;
            }
        } else {
        for (int j = tid; j < NE; j += NTHR) { const int e = ent[j]; int rk = 0; for (int k = 0; k < j; ++k) rk += (ent[k] == e) ? 1 : 0; tok_rank[bx * NE + j] = rk;
            const size_t li_ = (size_t)(bx * 16 + e) * 128 + rk; ((int*)(p.ws + WS_BLTOK))[li_] = (bx * NE + j) >> 1; ((float*)(p.ws + WS_BLW))[li_] = ((LAS float*)(lds + 82432))[j]; }
        if (tid < 16) { int c = 0; for (int k = 0; k < NE; ++k) c += (ent[k] == tid) ? 1 : 0; ((int*)(p.ws + WS_BCNT))[bx * 16 + tid] = c; }
        }
    }
}
__device__ __forceinline__ void moe_setup(const Params& p, LAS unsigned char* lds, int bx, int G) {
    const int tid = otid(), lane = tid & 63, w = tid >> 6;
    float* wperm = (float*)(p.ws + WS_WPERM); int* tilex = (int*)(p.ws + WS_TILEX);
    const int* bcnt = (const int*)(p.ws + WS_BCNT); const int* bltok = (const int*)(p.ws + WS_BLTOK); const float* blw = (const float*)(p.ws + WS_BLW);
    LAS int* bc = (LAS int*)lds;
    LAS int* part = (LAS int*)(lds + 16384);
    LAS int* offs = (LAS int*)(lds + 18432);
    LAS int* pre = (LAS int*)(lds + 20480);
    { const u32x4 v0 = *(const u32x4*)(bcnt + tid * 8), v1 = *(const u32x4*)(bcnt + tid * 8 + 4); *(LAS u32x4*)(bc + tid * 8) = v0; *(LAS u32x4*)(bc + tid * 8 + 4) = v1; }
    __syncthreads();
    { const int e = tid & 15, pr = tid >> 4; int s = 0;
#pragma unroll
      for (int k = 0; k < 8; ++k) s += bc[(pr * 8 + k) * 16 + e];
      part[pr * 16 + e] = s; }
    __syncthreads();
    if (tid < 16) { int tot = 0; for (int k = 0; k < 32; ++k) tot += part[k * 16 + tid]; offs[32 + tid] = tot; }
    __syncthreads();
    if (tid == 0) { int off = 0; for (int e = 0; e < 16; ++e) { offs[e] = off; off += (offs[32 + e] + 255) & ~255; } offs[16] = off; }
    __syncthreads();
    const int ntiles = offs[16] >> 8;
    if (tid == 0) tilex[0] = ntiles;
    if (tid < ntiles) { int ex = 0; for (int e = 1; e < 16; ++e) ex = (tid * 256 >= offs[e]) ? e : ex; tilex[1 + tid] = ex; }
#pragma unroll 1
    for (int i = 0; i < 2; ++i) {
        int L = i * G + bx; if (L >= 2 * ntiles) break;
        if (G == 256 && L < 256) L = ((L & 7) << 5) | (L >> 3);
        const int rt = L >> 1; int e = 0; for (int k = 1; k < 16; ++k) e = (rt * 256 >= offs[k]) ? k : e;
        const int r0 = rt * 256 - offs[e], tot = offs[32 + e];
        int cntb = 0, inc = 0;
        if (tid < 256) { cntb = bc[tid * 16 + e]; inc = cntb;
#pragma unroll
            for (int d = 1; d < 64; d <<= 1) { const int up = __shfl_up(inc, d); inc += (lane >= d) ? up : 0; }
            if (lane == 63) pre[260 + w] = inc; }
        __syncthreads();
        if (tid < 256) { int wo = 0; for (int k = 0; k < w; ++k) wo += pre[260 + k]; pre[tid] = wo + inc - cntb; }
        if (tid == 0) pre[256] = tot;
        __syncthreads();
        if (tid < 256) {
            const int row = r0 + tid; int tk = 0; float wt = 0.f;
            if (row < tot) {
                int lo = 0;
#pragma unroll
                for (int st = 128; st >= 1; st >>= 1) lo = (pre[lo + st] <= row) ? lo + st : lo;
                const size_t li_ = (size_t)(lo * 16 + e) * 128 + (row - pre[lo]);
                tk = bltok[li_]; wt = blw[li_];
            }
            ((LAS int*)(lds + 131072))[i * 256 + tid] = tk; wperm[rt * 256 + tid] = wt;
        }
        __syncthreads();
    }
    asm volatile("s_waitcnt vmcnt(0)" ::: "memory");
    __syncthreads();
}
template <bool GA>
struct MoeOrderT {
    static constexpr bool GATHER = GA, SIGNAL = GA;
    int G, c, nct; const int* tilex; const int* rowtok;
    int mode, k, m;
    unsigned* ready;
    __device__ bool next(int i, pg8::Unit& u) const {
        const int nt = tilex[0]; int L;
        if (mode == 0) { L = i * G + c; if (L >= nt * nct) return false;
            if (GA && G == 256 && L < 256) L = ((L & 7) << 5) | (L >> 3); }
        else if (mode == 1) {
            const int x = c & 7, n2 = 256 - m, first = n2 > x ? (n2 - x + 7) >> 3 : 0, uq = ((c >> 3) - first) + i * (32 - first); if (uq >= 64) return false; L = x * 64 + uq; }
        else { const int q = m - 1 - k; if (i > 0 || q >= 4 * (nt - 128)) return false; L = 512 + q; }
        const int rt = L / nct, ct = L - rt * nct; u.pm = rt; u.pn = tilex[1 + rt] * nct + ct; return true;
    }
    __device__ size_t aoff(const pg8::Unit& u, size_t tstepA) const { return (size_t)u.pm * tstepA; }
    __device__ size_t boff(const pg8::Unit&) const { return 0; }
};
struct EpiMoeH {
    bf16_t* HID; const float* wperm;
    __device__ __forceinline__ void operator()(const AccT& acc, const pg8::Unit& u, int wr, int wc, int fr, int fq) const {
        const int row0 = u.pm * 256 + wr * 64 + fr, f0 = (u.pn & 1) * 128 + wc * 16 + 4 * fq;
#pragma unroll
        for (int ai = 0; ai < 2; ++ai)
#pragma unroll
            for (int m = 0; m < 4; ++m) {
                const int row = row0 + ai * 128 + m * 16; const float wt = wperm[row];
#pragma unroll
                for (int bj = 0; bj < 2; ++bj) {
                    const f32x4 v0 = acc[ai][bj][m][0], v1 = acc[ai][bj][m][1];
                    const float h0 = v0[0] * __builtin_amdgcn_rcpf(1.f + __expf(-v0[0])) * v0[1] * wt, h1 = v0[2] * __builtin_amdgcn_rcpf(1.f + __expf(-v0[2])) * v0[3] * wt;
                    const float h2 = v1[0] * __builtin_amdgcn_rcpf(1.f + __expf(-v1[0])) * v1[1] * wt, h3 = v1[2] * __builtin_amdgcn_rcpf(1.f + __expf(-v1[2])) * v1[3] * wt;
                    u32x2 o; o.x = cvt_pk_bf16(h0, h1); o.y = cvt_pk_bf16(h2, h3);
                    asm volatile("global_store_dwordx2 %0, %1, off sc0 sc1" :: "v"(HID + (size_t)row * 256 + f0 + bj * 64), "v"(o) : "memory");
                }
            }
    }
};
__device__ __forceinline__ void ph_moe_gemm1(const Params& p, LAS unsigned char* lds, int l, int bx, int G) {
    moe_setup(p, lds, bx, G);
    pg8::Gemm g{(const bf16_t*)(p.ws + WS_H), (const bf16_t*)(p.ws + WS_WGU), 1024, 2048u, 128u, 1024};
    MoeOrderT<true> S{G, bx, 2, (const int*)(p.ws + WS_TILEX), (const int*)nullptr, 0, 0, 0, (unsigned*)(p.ws + WS_CTL) + CW_RDY + l * 256};
    EpiMoeH E{(bf16_t*)(p.ws + WS_HIDP), (const float*)(p.ws + WS_WPERM)};
    pg8::gemm_phase<EpiMoeH, MoeOrderT<true>>(lds, g, S, E);
}
__device__ __forceinline__ void ph_moe_gemm2(const Params& p, LAS unsigned char* lds, int l, int bx, int G, bool fused) {
    pg8::Gemm g{(const bf16_t*)(p.ws + WS_HIDP), (const bf16_t*)(p.ws + WS_WD), 256, 512u, 128u, 256};
    EpiBf16 E{(bf16_t*)(p.ws + WS_Y), 1024, 3};
    const int* tilex = (const int*)(p.ws + WS_TILEX);
    unsigned* ready = (unsigned*)(p.ws + WS_CTL) + CW_RDY + l * 256;
    int n2 = 2 * tilex[0] - 256; n2 = n2 < 0 ? 0 : n2;
    const int m = 256 - n2, k = bx - n2;
    if (fused && k < 0) return;
#pragma unroll 1
    for (int part = fused ? 1 : 0; part < (fused ? 3 : 1); ++part) {
        MoeOrderT<false> S{G, bx, 4, tilex, (const int*)nullptr, part, k, m, ready};
        pg8::Unit u0;
        if (!S.next(0, u0)) continue;
        if (fused) {
            if (otid() == 0) {
                unsigned* bar = (unsigned*)(p.ws + WS_CTL) + CW_BAR; pg8::Unit u;
                for (int i = 0; S.next(i, u); ++i) XB_SPIN(xb_ld(&ready[u.pm]) < 2u, bar);
                __builtin_amdgcn_fence(__ATOMIC_ACQUIRE, "agent");
                asm volatile("s_waitcnt vmcnt(0)" ::: "memory");
            }
            __syncthreads();
        }
        pg8::gemm_phase<EpiBf16, MoeOrderT<false>>(lds, g, S, E);
    }
}


__device__ __forceinline__ void ph_mod(const Params& p, LAS unsigned char* lds, int bx, int G) {
    const int tid = otid();
    LAS float* cs = (LAS float*)lds;
    LAS float* red = (LAS float*)(lds + 16384);
    float* mod = (float*)(p.ws + WS_MOD);
    for (int i = tid; i < 4096; i += NTHR) { const float v = p.in[1][i]; cs[i] = v / (1.f + expf(-v)); }
    __syncthreads();
    const int c4 = tid & 31, rc = tid >> 5;
    for (int it = bx; it < 4 * 48; it += G) {
        const int l = it / 48, j0 = (it % 48) * 128;
        const float* w = p.in[5] + (size_t)l * 1024 * 6144 + (size_t)(rc * 64) * 6144 + j0 + c4 * 4;
        f32x4 a0 = {0.f, 0.f, 0.f, 0.f}, a1 = a0, a2 = a0, a3 = a0;
#pragma unroll 16
        for (int i = 0; i < 64; ++i) { const f32x4 wv = *(const f32x4*)(w + (size_t)i * 6144); const int ii = rc * 64 + i; a0 = a0 + wv * cs[ii]; a1 = a1 + wv * cs[1024 + ii]; a2 = a2 + wv * cs[2048 + ii]; a3 = a3 + wv * cs[3072 + ii]; }
        *(LAS f32x4*)(red + (rc * 4 + 0) * 128 + c4 * 4) = a0; *(LAS f32x4*)(red + (rc * 4 + 1) * 128 + c4 * 4) = a1; *(LAS f32x4*)(red + (rc * 4 + 2) * 128 + c4 * 4) = a2; *(LAS f32x4*)(red + (rc * 4 + 3) * 128 + c4 * 4) = a3;
        __syncthreads();
        {
            const int b = tid >> 7, col = tid & 127; float sum = 0.f;
#pragma unroll
            for (int k = 0; k < 16; ++k) sum += red[(k * 4 + b) * 128 + col];
            mod[(size_t)(l * 4 + b) * 6144 + j0 + col] = sum + p.in[6][l * 6144 + j0 + col];
        }
        __syncthreads();
    }
}
__device__ __forceinline__ void ph_rope(const Params& p, int bx, int G) {
    float* tab = (float*)(p.ws + WS_ROPE);
    for (int i = bx * NTHR + otid(); i < SEQ * 8; i += G * NTHR) {
        const int pos = i >> 3, j = i & 7;
        const float inv = (float)pow(500000.0, -(double)j / 8.0);
        const float ang = (float)pos * inv;
        tab[i] = (float)cos((double)ang); tab[SEQ * 8 + i] = (float)sin((double)ang);
    }
}

struct XcdBarrier { unsigned* bar; unsigned x; volatile LAS unsigned* st; };
__device__ __forceinline__ XcdBarrier xcd_barrier_post(unsigned* bar, volatile LAS unsigned* st) {
    XcdBarrier b; b.bar = bar; b.x = xb_xcc_id(); b.st = st;
    if (threadIdx.x == 0) (void)xb_add(&bar[XB_XCNT(b.x)], 1u);
    return b;
}
__device__ __forceinline__ void xcd_barrier_complete(unsigned* bar, unsigned x, unsigned& nloc, unsigned& nx) {
    const unsigned G = gridDim.x * gridDim.y * gridDim.z;
    unsigned sum, cnt, mine, sp = 0u;
    for (;;) {
        sum = 0u; cnt = 0u; mine = 0u;
#pragma unroll
        for (unsigned j = 0; j < 16; ++j) { const unsigned c = xb_ld(&bar[XB_XCNT(j)]); sum += c; cnt += (c > 0u) ? 1u : 0u; mine = (j == x) ? c : mine; }
        if (sum == G) break;
        __builtin_amdgcn_s_sleep(1);
        if ((++sp & 255u) == 0u) { if (xb_ld(&bar[XB_TMO])) break; if (sp > XB_SPIN_CAP) { atomicAdd(&bar[XB_TMO], 1u); break; } }
    }
    nloc = mine > 0u ? mine : 1u; nx = cnt > 0u ? cnt : 1u;
}
__device__ __forceinline__ void xcd_barrier(const XcdBarrier& b) {
    asm volatile("s_waitcnt vmcnt(0)" ::: "memory");
    __syncthreads();
    if (threadIdx.x == 0) {
        unsigned* bar = b.bar;
        __builtin_amdgcn_s_waitcnt(0);
        unsigned nloc = b.st[0], nx = b.st[1];
        if (nloc == 0u) { xcd_barrier_complete(bar, b.x, nloc, nx); b.st[0] = nloc; b.st[1] = nx; }
        const unsigned old = xb_add(&bar[XB_XSUB(b.x)], 1u);
        const unsigned gen = old / nloc;
        if (old + 1u == (gen + 1u) * nloc) {
            __builtin_amdgcn_fence(__ATOMIC_RELEASE, "agent");
            asm volatile("s_waitcnt vmcnt(0)" ::: "memory");
            const unsigned og = xb_add(&bar[XB_TOP], 1u);
            const unsigned tg = og / nx;
            if (og + 1u == (tg + 1u) * nx) xb_add(&bar[XB_TOPGEN], 1u);
            else XB_SPIN(xb_ld(&bar[XB_TOPGEN]) == tg, bar);
            __builtin_amdgcn_fence(__ATOMIC_ACQUIRE, "agent");
            xb_add(&bar[XB_XGEN(b.x)], 1u);
            asm volatile("s_waitcnt vmcnt(0)" ::: "memory");
        } else {
            XB_SPIN(xb_ld(&bar[XB_XGEN(b.x)]) == gen, bar);
            __builtin_amdgcn_fence(__ATOMIC_ACQUIRE, "agent");
            asm volatile("s_waitcnt vmcnt(0)" ::: "memory");
        }
    }
    __syncthreads();
}
constexpr int LDS_XB = 147200;

#ifndef REP_P
#define REP_P 1
#endif
#ifndef REP_T
#define REP_T 1
#endif
#ifndef REP_B
#define REP_B 0
#endif
#ifndef REP_N
#define REP_N 1
#endif
#ifndef REP_O
#define REP_O 1
#endif
#ifndef REP_N1
#define REP_N1 1
#endif
#ifndef REP_AE
#define REP_AE 1
#endif
#ifndef REP_AO
#define REP_AO 1
#endif
#ifndef REP_G
#define REP_G 1
#endif
__global__ void __launch_bounds__(NTHR, 2) mega_fwd(Params p) {
    extern __shared__ __attribute__((aligned(16))) unsigned char lds_raw[];
    LAS unsigned char* lds = (LAS unsigned char*)lds_raw;
    const int bx = blockIdx.x, G = gridDim.x;
    typedef const Params __attribute__((address_space(4)))* CP;
    CP kp = (CP)__builtin_amdgcn_kernarg_segment_ptr();
#define LP() ({ CP q_ = kp; asm volatile("" : "+s"(q_)); Params r_; _Pragma("unroll") for (int i_ = 0; i_ < 25; ++i_) r_.in[i_] = q_->in[i_]; r_.out = q_->out; r_.ws = q_->ws; r_; })
    if (threadIdx.x < 4) ((LAS unsigned*)(lds + LDS_XB))[threadIdx.x] = 0u;
    if (threadIdx.x == 0) *(LAS unsigned*)(lds + LDS_TACC) = 0u;
    __syncthreads();
    const XcdBarrier bar = xcd_barrier_post((unsigned*)(kp->ws + WS_CTL) + CW_BAR, (volatile LAS unsigned*)(lds + LDS_XB));
#define GRID_BAR() do { TSTART(10) XcdBarrier b2_ = bar; asm volatile("" : "+s"(b2_.bar), "+s"(b2_.x)); xcd_barrier(b2_); TSTOP(10) } while (0)
    for (int rep = 0; rep < REP_P; ++rep) {
    { TSTART(15) { const Params pp = LP(); ph_conv_static(pp, lds, bx, G); } TSTOP(15) }
    __syncthreads();
    { TSTART(15) { const Params pp = LP(); ph_mod(pp, lds, bx, G); } TSTOP(15) }
    { TSTART(15) { const Params pp = LP(); ph_rope(pp, bx, G); } TSTOP(15) }
    { TSTART(15) { const Params pp = LP(); ph_misc(pp, lds, bx, G); } TSTOP(15) }
    { const Params pp = LP(); ph_zero_kmsum(pp, bx, G); }
    __syncthreads();
    }
    GRID_BAR();
#pragma unroll 1
    for (int l = 0; l < DEPTH; ++l) {
        { TSTART(11) { const Params pp = LP(); ph_norm<0>(pp, lds, l, bx, G); } TSTOP(11) }
        for (int rep = 0; rep < REP_T; ++rep) { TSTART(16) { const Params pp = LP(); ph_conv_moe(pp, lds, l, bx, G); } TSTOP(16) }
        if ((l & 1) == 1 && l + 1 < DEPTH) { const Params pp = LP(); ph_zero_kmsum(pp, bx, G); }
        if (G != 256) GRID_BAR();
#pragma unroll 1
        for (int si = 0; si < ((l & 1) ? 2 : 1); ++si) {
            { TSTART(13) { const Params pp = LP(); ph_inproj(pp, lds, l, bx, G, (l & 1) ? 1 + si : 0); } TSTOP(13) }
            GRID_BAR();
        }
        if ((l & 1) == 0) {
            for (int rep = 0; rep < REP_AE; ++rep) { TSTART(14) { const Params pp = LP(); ph_attn_even(pp, lds, l, bx, G); } TSTOP(14) }
            GRID_BAR();
        } else {
            for (int rep = 0; rep < REP_T; ++rep) { TSTART(12) { const Params pp = LP(); ph_compress2(pp, lds, l, bx, G); } TSTOP(12) }
            GRID_BAR();
            for (int rep = 0; rep < REP_AO; ++rep) { TSTART(14) { const Params pp = LP(); ph_attn_odd(pp, lds, bx, G); } TSTOP(14) }
            GRID_BAR();
        }
        { TSTART(13) { const Params pp = LP(); ph_outproj(pp, lds, l, bx, G); } TSTOP(13) }
        if (G != 256) GRID_BAR();
        for (int rep = 0; rep < REP_N1; ++rep) { TSTART(18) { const Params pp = LP(); if (G == 256) WAIT_COUNTER(pp.ws, CW_RDX + l * 64 + (bx >> 2), 4);
                      ph_norm<1>(pp, lds, l, bx, G); __syncthreads(); } TSTOP(18) }
        GRID_BAR();
        { TSTART(20) { const Params pp = LP(); ph_moe_gemm1(pp, lds, l, bx, G); } TSTOP(20) }
        if (G != 256) GRID_BAR();
        { TSTART(21) { const Params pp = LP(); ph_moe_gemm2(pp, lds, l, bx, G, G == 256); } TSTOP(21) }
        GRID_BAR();
    }
    for (int rep = 0; rep < REP_B; ++rep) GRID_BAR();
    for (int rep = 0; rep < REP_N; ++rep) { TSTART(11) { const Params pp = LP(); ph_norm<2>(pp, lds, 0, bx, G); } TSTOP(11) }
#undef GRID_BAR
    if (TSEL != 0 && blockIdx.x == 0 && threadIdx.x == 0) {
        const unsigned long long t0 = __builtin_amdgcn_s_memrealtime(); const unsigned long long dt = *(LAS unsigned*)(lds + LDS_TACC);
        while (__builtin_amdgcn_s_memrealtime() - t0 < dt) __builtin_amdgcn_s_sleep(8);
    }
}

extern "C" void kernel_launch(void* const* d_in, const int* in_sizes, int n_in, void* d_out, int out_size, void* d_ws, size_t ws_size, hipStream_t stream) {
    static int grid = 0;
    if (grid == 0) {
        if (n_in != 25 || out_size != NT * DM || ws_size < WS_END2) { fprintf(stderr, "kernel_launch: unexpected shapes / workspace (n_in %d out %d ws %zu, need %zu)\n", n_in, out_size, ws_size, (size_t)WS_END2); grid = -1; return; }
        int dev = 0, cus = 0;
        if (hipGetDevice(&dev) != hipSuccess || hipDeviceGetAttribute(&cus, hipDeviceAttributeMultiprocessorCount, dev) != hipSuccess) { grid = -1; return; }
        if (hipFuncSetAttribute((const void*)mega_fwd, hipFuncAttributeMaxDynamicSharedMemorySize, LDS_BYTES) != hipSuccess) { fprintf(stderr, "kernel_launch: hipFuncSetAttribute failed\n"); grid = -1; return; }
        int per_cu = 0;
        if (hipOccupancyMaxActiveBlocksPerMultiprocessor(&per_cu, (const void*)mega_fwd, NTHR, LDS_BYTES) != hipSuccess || per_cu < 1) { fprintf(stderr, "kernel_launch: occupancy query says %d\n", per_cu); }
        (void)hipGetLastError();
        grid = cus < 256 ? cus : 256;
    }
    if (grid < 0) return;
    Params prm; memset(&prm, 0, sizeof(prm)); for (int i = 0; i < 25; ++i) prm.in[i] = (const float*)d_in[i]; prm.out = (float*)d_out; prm.ws = (unsigned char*)d_ws;
    (void)hipMemsetAsync(d_ws, 0, 1 * MiB, stream);
    mega_fwd<<<grid, NTHR, LDS_BYTES, stream>>>(prm);
}
```
